# Optimizing an MI355X kernel written in HIP

```python
import math
import jax
import jax.numpy as jnp
from jax import lax
import numpy as np

D_MODEL = 1024
BATCH = 4
SEQ = 8192
DEPTH = 2

HEAD_DIM = 64
GRID_W = 64
NEG_INF = -1e30

MLA_HEADS = 4
MLA_NOPE = 64
MLA_ROPE = 32
MLA_V = 64
Q_LORA = 256
KV_LORA = 128
ROPE_THETA = 10000.0
Q_BLOCK = 128

SWA_HEADS = 4
SWA_KV_HEADS = 2
SWA_HALF = 128

NA_HEADS = 4
NA_KH_MAX = 8
NA_KW = 16

DIL_CONFIGS = ((128, 1), (512, 4), (2048, 16))
DIL_GROUPS = 3
DIL_HEADS = 4

T5_BUCKETS = 32
T5_MAX_DIST = 1024
T5_HEADS = SWA_HEADS + DIL_GROUPS * DIL_HEADS

N_BRANCH = 4
BRANCH_W = 256
D_FF = 4 * D_MODEL
PLE_DIM = 256

SPLIT_WIDTHS = (Q_LORA, KV_LORA, MLA_ROPE,
                SWA_HEADS * HEAD_DIM, SWA_KV_HEADS * HEAD_DIM, SWA_KV_HEADS * HEAD_DIM,
                3 * NA_HEADS * HEAD_DIM, 3 * DIL_GROUPS * DIL_HEADS * HEAD_DIM,
                N_BRANCH * D_MODEL)
IN_COLS = sum(SPLIT_WIDTHS)

kernel_name = 'hybrid_gated_parallel_encoder'


def layer_norm(x, g, b, eps=1e-5):
    xf = x.astype(jnp.float32)
    mu = xf.mean(-1, keepdims=True)
    var = jnp.square(xf - mu).mean(-1, keepdims=True)
    y = (xf - mu) * lax.rsqrt(var + eps) * g.astype(jnp.float32) + b.astype(jnp.float32)
    return y.astype(x.dtype)


def rms_norm(x, g, eps=1e-6):
    xf = x.astype(jnp.float32)
    y = xf * lax.rsqrt(jnp.mean(jnp.square(xf), -1, keepdims=True) + eps) * g.astype(jnp.float32)
    return y.astype(x.dtype)


def rope(x, positions):
    half = x.shape[-1] // 2
    inv = ROPE_THETA ** (-jnp.arange(half, dtype=jnp.float32) / half)
    ang = positions.astype(jnp.float32)[:, None] * inv[None, :]
    shape = (ang.shape[0],) + (1,) * (x.ndim - 3) + (half,)
    cos, sin = jnp.cos(ang).reshape(shape), jnp.sin(ang).reshape(shape)
    x1, x2 = x[..., :half].astype(jnp.float32), x[..., half:].astype(jnp.float32)
    return jnp.concatenate([x1 * cos - x2 * sin, x1 * sin + x2 * cos], -1).astype(x.dtype)


def t5_bucket(rel):
    nb = T5_BUCKETS // 2
    max_exact = nb // 2
    n = jnp.abs(rel)
    large = max_exact + (jnp.log(jnp.maximum(n, 1).astype(jnp.float32) / max_exact)
                         / math.log(T5_MAX_DIST / max_exact) * (nb - max_exact)).astype(jnp.int32)
    large = jnp.minimum(large, nb - 1)
    return jnp.where(rel > 0, nb, 0) + jnp.where(n < max_exact, n, large)


def band_offsets(half):
    return jnp.arange(3 * half)[None, :] - half - jnp.arange(half)[:, None]


def banded_attention(q, k, v, half, bias, sink=None):
    bsz, L, hk, g, dh = q.shape
    nb = -(-L // half)
    lp = nb * half
    q = jnp.pad(q, ((0, 0), (0, lp - L), (0, 0), (0, 0), (0, 0)))
    kv_pad = ((0, 0), (half, lp - L + half), (0, 0), (0, 0))

    def windows(t):
        tb = jnp.pad(t, kv_pad).reshape(bsz, nb + 2, half, hk, dh)
        return jnp.concatenate([tb[:, :-2], tb[:, 1:-1], tb[:, 2:]], axis=2)

    kw, vw = windows(k), windows(v)
    qb = q.reshape(bsz, nb, half, hk, g, dh)
    s = jnp.einsum('bnqhgd,bnkhd->bnhgqk', qb, kw).astype(jnp.float32) * dh ** -0.5
    s = s + bias.astype(jnp.float32)
    rel = band_offsets(half)
    kpos = jnp.arange(nb)[:, None] * half - half + jnp.arange(3 * half)[None, :]
    mask = (jnp.abs(rel) <= half)[None] & ((kpos >= 0) & (kpos < L))[:, None, :]
    s = jnp.where(mask[None, :, None, None], s, NEG_INF)
    m = s.max(-1)
    if sink is not None:
        sk = sink.astype(jnp.float32)[:, :, None]
        m = jnp.maximum(m, sk)
    e = jnp.exp(s - m[..., None])
    den = e.sum(-1)
    if sink is not None:
        den = den + jnp.exp(sk - m)
    pr = (e / den[..., None]).astype(v.dtype)
    o = jnp.einsum('bnhgqk,bnkhd->bnqhgd', pr, vw).reshape(bsz, lp, hk, g, dh)[:, :L]
    lse = (m + jnp.log(den)).transpose(0, 1, 4, 2, 3).reshape(bsz, lp, hk, g)[:, :L]
    return o, lse


def mla_attention(cq_in, ckv_in, kr_in, g_q, w_uq, g_kv, w_ukv, positions):
    bsz, S, _ = cq_in.shape
    q = (rms_norm(cq_in, g_q) @ w_uq).reshape(bsz, S, MLA_HEADS, MLA_NOPE + MLA_ROPE)
    q_nope, q_rope = q[..., :MLA_NOPE], rope(q[..., MLA_NOPE:], positions)
    kv = (rms_norm(ckv_in, g_kv) @ w_ukv).reshape(bsz, S, MLA_HEADS, MLA_NOPE + MLA_V)
    k_nope, v = kv[..., :MLA_NOPE], kv[..., MLA_NOPE:]
    k_rope = rope(kr_in, positions)
    scale = (MLA_NOPE + MLA_ROPE) ** -0.5
    nq = S // Q_BLOCK

    def to_blocks(t):
        return jnp.moveaxis(t.reshape(bsz, nq, Q_BLOCK, *t.shape[2:]), 1, 0)

    def block(args):
        qn, qr = args
        s = (jnp.einsum('bqhd,bkhd->bhqk', qn, k_nope)
             + jnp.einsum('bqhr,bkr->bhqk', qr, k_rope)).astype(jnp.float32) * scale
        pr = jax.nn.softmax(s, axis=-1).astype(v.dtype)
        return jnp.einsum('bhqk,bkhd->bqhd', pr, v)

    o = lax.map(block, (to_blocks(q_nope), to_blocks(q_rope)))
    return jnp.moveaxis(o, 0, 1).reshape(bsz, S, MLA_HEADS * MLA_V)


def neighborhood_attention(q, k, v, rpb):
    bsz, S, H, dh = q.shape
    rows = S // GRID_W
    kh = min(NA_KH_MAX, rows)
    q = q.reshape(bsz, rows, GRID_W, H, dh)
    k = k.reshape(bsz, rows, GRID_W, H, dh)
    v = v.reshape(bsz, rows, GRID_W, H, dh)
    r = jnp.arange(rows)
    row_idx = jnp.clip(r - kh // 2, 0, rows - kh)[:, None] + jnp.arange(kh)[None, :]
    kr = jnp.take(k, row_idx, axis=1)
    vr = jnp.take(v, row_idx, axis=1)
    c = jnp.arange(GRID_W)
    col_start = jnp.clip(c - NA_KW // 2, 0, GRID_W - NA_KW)
    col_ok = (c[None, :] >= col_start[:, None]) & (c[None, :] < col_start[:, None] + NA_KW)
    dr = row_idx - r[:, None] + (NA_KH_MAX - 1)
    dc = jnp.clip(c[None, :] - c[:, None], -(NA_KW - 1), NA_KW - 1) + (NA_KW - 1)
    bias = rpb[:, dr[:, None, :, None], dc[None, :, None, :]]
    s = jnp.einsum('brchd,brawhd->brhcaw', q, kr).astype(jnp.float32) * dh ** -0.5
    s = s + bias.astype(jnp.float32).transpose(1, 0, 2, 3, 4)[None]
    s = jnp.where(col_ok[:, None, :], s, NEG_INF)
    pr = jax.nn.softmax(s.reshape(bsz, rows, H, GRID_W, kh * GRID_W), axis=-1)
    pr = pr.reshape(s.shape).astype(v.dtype)
    o = jnp.einsum('brhcaw,brawhd->brchd', pr, vr)
    return o.reshape(bsz, S, H * dh)


def dilated_attention(q, k, v, rel_bias):
    bsz, S, _, H, dh = q.shape
    outs, lses = [], []
    for g, (window, r) in enumerate(DIL_CONFIGS):
        half = window // (2 * r)
        L = S // r

        def fold(t):
            return t.reshape(bsz, L, r, *t.shape[2:]).swapaxes(1, 2).reshape(bsz * r, L, *t.shape[2:])

        def unfold(t):
            return t.reshape(bsz, r, L, *t.shape[2:]).swapaxes(1, 2).reshape(bsz, S, *t.shape[2:])

        lo = SWA_HEADS + g * DIL_HEADS
        bias = rel_bias[t5_bucket(band_offsets(half) * r)][..., lo:lo + DIL_HEADS]
        bias = bias.transpose(2, 0, 1)[:, None]
        o, lse = banded_attention(fold(q[:, :, g])[:, :, :, None], fold(k[:, :, g]),
                                  fold(v[:, :, g]), half, bias)
        outs.append(unfold(o[:, :, :, 0]))
        lses.append(unfold(lse[:, :, :, 0]))
    w = jax.nn.softmax(jnp.stack(lses), axis=0)
    o = jnp.einsum('gbsh,gbshd->bshd', w, jnp.stack(outs).astype(jnp.float32))
    return o.reshape(bsz, S, H * dh).astype(q.dtype)


def setup_inputs(seed: int = 0) -> dict:
    key = jax.random.key(seed)
    ks = jax.random.split(key, 22)
    beta = (8 * DEPTH) ** -0.25

    def nrm(k, shape, scale):
        return jax.random.normal(k, shape, jnp.float32) * scale

    L = DEPTH
    return {
        'x': nrm(ks[0], (BATCH, SEQ, D_MODEL), 1.0),
        'p': nrm(ks[1], (DEPTH, BATCH, SEQ, PLE_DIM), 1.0),
        'ln_emb_g': 1.0 + nrm(ks[2], (D_MODEL,), 0.02),
        'ln_emb_b': nrm(ks[3], (D_MODEL,), 0.02),
        'rel_bias': nrm(ks[4], (T5_BUCKETS, T5_HEADS), 0.2),
        'w_in': nrm(ks[5], (L, D_MODEL, IN_COLS), D_MODEL ** -0.5),
        'mla_q_norm': 1.0 + nrm(ks[6], (L, Q_LORA), 0.02),
        'mla_w_uq': nrm(ks[7], (L, Q_LORA, MLA_HEADS * (MLA_NOPE + MLA_ROPE)), Q_LORA ** -0.5),
        'mla_kv_norm': 1.0 + nrm(ks[8], (L, KV_LORA), 0.02),
        'mla_w_ukv': nrm(ks[9], (L, KV_LORA, MLA_HEADS * (MLA_NOPE + MLA_V)), KV_LORA ** -0.5),
        'swa_sink': nrm(ks[10], (L, SWA_HEADS), 1.0),
        'na_rpb': nrm(ks[11], (L, NA_HEADS, 2 * NA_KH_MAX - 1, 2 * NA_KW - 1), 0.2),
        'w_branch': nrm(ks[12], (L, N_BRANCH, BRANCH_W, D_MODEL), BRANCH_W ** -0.5),
        'w_out': nrm(ks[13], (L, D_MODEL, D_MODEL), beta * D_MODEL ** -0.5),
        'ln1_g': 1.0 + nrm(ks[14], (L, D_MODEL), 0.02),
        'ln1_b': nrm(ks[15], (L, D_MODEL), 0.02),
        'w_ff1': nrm(ks[16], (L, D_MODEL, D_FF), beta * D_MODEL ** -0.5),
        'w_ff2': nrm(ks[17], (L, D_FF, D_MODEL), beta * D_FF ** -0.5),
        'w_ple': nrm(ks[18], (L, PLE_DIM, D_MODEL), beta * PLE_DIM ** -0.5),
        'w_ple_gate': nrm(ks[19], (L, D_MODEL, D_MODEL), D_MODEL ** -0.5),
        'ln2_g': 1.0 + nrm(ks[20], (L, D_MODEL), 0.02),
        'ln2_b': nrm(ks[21], (L, D_MODEL), 0.02),
    }


def reference(x, p, ln_emb_g, ln_emb_b, rel_bias, w_in, mla_q_norm, mla_w_uq, mla_kv_norm,
              mla_w_ukv, swa_sink, na_rpb, w_branch, w_out, ln1_g, ln1_b, w_ff1, w_ff2,
              w_ple, w_ple_gate, ln2_g, ln2_b):
    bsz, S, _ = x.shape
    positions = jnp.arange(S)
    alpha = (2 * DEPTH) ** 0.25
    offsets = [int(o) for o in np.cumsum(SPLIT_WIDTHS[:-1])]
    g_swa = SWA_HEADS // SWA_KV_HEADS
    bias_swa = rel_bias[t5_bucket(band_offsets(SWA_HALF))][..., :SWA_HEADS]
    bias_swa = bias_swa.transpose(2, 0, 1).reshape(SWA_KV_HEADS, g_swa, SWA_HALF, 3 * SWA_HALF)

    h = layer_norm(x, ln_emb_g, ln_emb_b)
    for i in range(DEPTH):
        z = h @ w_in[i]
        a_q, a_kv, a_kr, b_q, b_k, b_v, c_qkv, d_qkv, gates = jnp.split(z, offsets, axis=-1)
        y_a = mla_attention(a_q, a_kv, a_kr, mla_q_norm[i], mla_w_uq[i], mla_kv_norm[i],
                            mla_w_ukv[i], positions)
        o_b, _ = banded_attention(b_q.reshape(bsz, S, SWA_KV_HEADS, g_swa, HEAD_DIM),
                                  b_k.reshape(bsz, S, SWA_KV_HEADS, HEAD_DIM),
                                  b_v.reshape(bsz, S, SWA_KV_HEADS, HEAD_DIM),
                                  SWA_HALF, bias_swa, swa_sink[i].reshape(SWA_KV_HEADS, g_swa))
        y_b = o_b.reshape(bsz, S, SWA_HEADS * HEAD_DIM)
        c = c_qkv.reshape(bsz, S, 3, NA_HEADS, HEAD_DIM)
        y_c = neighborhood_attention(c[:, :, 0], c[:, :, 1], c[:, :, 2], na_rpb[i])
        d = d_qkv.reshape(bsz, S, 3, DIL_GROUPS, DIL_HEADS, HEAD_DIM)
        y_d = dilated_attention(d[:, :, 0], d[:, :, 1], d[:, :, 2], rel_bias)
        gate = jax.nn.sigmoid(gates.reshape(bsz, S, N_BRANCH, D_MODEL))
        branches = (y_a, y_b, y_c, y_d)
        merged = gate[:, :, 0] * (branches[0] @ w_branch[i, 0])
        for n in range(1, N_BRANCH):
            merged = merged + gate[:, :, n] * (branches[n] @ w_branch[i, n])
        h = layer_norm(alpha * h + merged @ w_out[i], ln1_g[i], ln1_b[i])
        ff = jnp.square(jax.nn.relu(h @ w_ff1[i])) @ w_ff2[i]
        ple = (p[i] @ w_ple[i]) * jax.nn.sigmoid(h @ w_ple_gate[i])
        h = layer_norm(alpha * h + ff + ple, ln2_g[i], ln2_b[i])
    return h
```

```cpp
#include <hip/hip_runtime.h>
#include <hip/hip_cooperative_groups.h>
#include <cstdio>
#include <cstdint>
namespace cg = cooperative_groups;

#define LAS __attribute__((address_space(3)))
#define DI __device__ __forceinline__
typedef unsigned short bf16_t;
typedef short bf16x8 __attribute__((ext_vector_type(8)));
typedef short s16x4 __attribute__((ext_vector_type(4)));
typedef float f32x4 __attribute__((ext_vector_type(4)));
typedef float f32x2 __attribute__((ext_vector_type(2)));
typedef float f32x16 __attribute__((ext_vector_type(16)));
typedef unsigned u32x4 __attribute__((ext_vector_type(4)));
typedef unsigned u32x2 __attribute__((ext_vector_type(2)));
typedef __bf16 bf16x2_t __attribute__((ext_vector_type(2)));

#ifndef N_LAUNCH_MODE
#define N_LAUNCH_MODE 1
#endif

constexpr int T = 32768, S = 8192, DM = 1024, FF = 4096, INC = 8096, ZC = 4096, NL = 2;
constexpr int C_AQ = 0, C_AKV = 256, C_AKR = 384, C_BQ = 416, C_BK = 672, C_BV = 800, C_CQ = 928, C_CK = 1184, C_CV = 1440,
              C_DQ = 1696, C_DK = 2464, C_DV = 3232, C_G = 4000;
constexpr float LOG2E = 1.4426950408889634f;
constexpr float ALPHA = 1.4142135623730951f;

constexpr size_t MiB = 1u << 20;
constexpr size_t WS_RSTD = 64 * 1024, WS_LUTS = 320 * 1024, WS_LUTD = 328 * 1024, WS_LSE = 512 * 1024;
constexpr size_t WS_W = 2 * MiB;
constexpr size_t W_QKV = WS_W, W_G = WS_W + 8 * MiB, W_FF1 = WS_W + 16 * MiB, W_FF2 = WS_W + 24 * MiB, W_B = WS_W + 32 * MiB, W_OUT = WS_W + 34 * MiB,
                 W_PG = WS_W + 36 * MiB, W_PLE = WS_W + 38 * MiB, W_UQ = WS_W + 38 * MiB + 512 * 1024, W_UKV = WS_W + 38 * MiB + 768 * 1024;
constexpr size_t WS_ROPE = 41 * MiB, WS_PB = 42 * MiB, WS_HB = 58 * MiB, WS_Z = 122 * MiB, WS_Y = 378 * MiB, WS_M = 442 * MiB;
constexpr size_t WS_QM = WS_M, WS_KVM = WS_M + 24 * MiB, WS_KR = WS_M + 56 * MiB, WS_MG = WS_M;
constexpr size_t WS_STATS = 506 * MiB;
constexpr size_t WS_END = 512 * MiB;

constexpr int STG_OFF = 135168;
constexpr int LDS_BYTES = 153600;

DI unsigned cvt_pk(float lo, float hi) { f32x2 v = {lo, hi}; bf16x2_t b = __builtin_convertvector(v, bf16x2_t); return __builtin_bit_cast(unsigned, b); }
DI float bf_lo(unsigned u) { return __uint_as_float(u << 16); }
DI float bf_hi(unsigned u) { return __uint_as_float(u & 0xffff0000u); }
DI float xhalf_max(float m) { auto rr = __builtin_amdgcn_permlane32_swap(__float_as_uint(m), __float_as_uint(m), false, false); return fmaxf(__uint_as_float(rr[0]), __uint_as_float(rr[1])); }
DI float xhalf_sum(float m) { auto rr = __builtin_amdgcn_permlane32_swap(__float_as_uint(m), __float_as_uint(m), false, false); return __uint_as_float(rr[0]) + __uint_as_float(rr[1]); }
template <int O> DI float shx(float v) { return __int_as_float(__builtin_amdgcn_ds_swizzle(__float_as_int(v), (O << 10) | 0x1f)); }
DI float wave_sum(float v) {
    v += shx<1>(v); v += shx<2>(v); v += shx<4>(v); v += shx<8>(v); v += shx<16>(v); v = xhalf_sum(v);
    return v;
}
DI float sigmoid_f(float x) { return __builtin_amdgcn_rcpf(1.0f + __builtin_amdgcn_exp2f(-x * LOG2E)); }
DI int lane_id() { int l; asm volatile("v_mbcnt_lo_u32_b32 %0, -1, 0\n\tv_mbcnt_hi_u32_b32 %0, -1, %0" : "=v"(l)); return l; }
DI int crow(int r, int hi) { return (r & 3) + 8 * (r >> 2) + 4 * hi; }

namespace pg8 {
constexpr int BM = 256, BK = 64, HALF = 128, HTB = HALF * BK * 2, STAGE_BYTES = 8 * HTB, NXCD = 8, WGM = 8;
DI int lds_byte(int r, int c) { const int st = (r >> 4) * 2 + (c >> 5), rr = r & 15, cc = c & 31, ob = rr * 64 + cc * 2; return st * 1024 + (ob ^ (((ob >> 9) & 1) << 5)); }
DI void stage_rc(int b, int& R, int& C) { const int st = b / 1024, sb = b % 1024, swz = sb ^ (((sb >> 9) & 1) << 5); R = (st >> 1) * 16 + swz / 64; C = (st & 1) * 32 + (swz % 64) / 2; }
DI int perm32(int rho) { const int n = rho >> 4, i = rho & 15; return 8 * (i >> 2) + 4 * n + (i & 3); }

struct Unit { int pm, pn, z; };
struct Gemm { const bf16_t* A; const bf16_t* Bt; int lda; int K; };

struct StaticOrder {
    int nM, nN, nwg, G, c;
    DI void init(int M, int N, int G_, int c_) { nM = M / BM; nN = N / BM; nwg = nM * nN; G = G_; c = c_; }
    DI bool tile(int i, Unit& u) const {
        const long L = (long)i * G + c; if (L >= nwg) return false;
        int wgid = (int)L; { const int q = nwg / NXCD, r = nwg % NXCD, xcd = wgid % NXCD, off = wgid / NXCD; wgid = (xcd < r ? xcd * (q + 1) : r * (q + 1) + (xcd - r) * q) + off; }
        const int nig = WGM * nN, gid = wgid / nig, fm = gid * WGM, gsz = (nM - fm) < WGM ? (nM - fm) : WGM;
        u.pm = fm + ((wgid % nig) % gsz); u.pn = (wgid % nig) / gsz; u.z = 0; return true;
    }
    DI bool next(int i, Unit& u) const { return tile(i, u); }
    DI size_t aoff(const Unit& u, const Gemm& g) const { return (size_t)u.pm * BM * g.lda * 2; }
    DI size_t boff(const Unit& u, const Gemm& g) const { return (size_t)u.pn * BM * g.K * 2; }
};
struct MergeOrder {
    StaticOrder s;
    DI bool next(int i, Unit& u) const { if (!s.tile(i >> 2, u)) return false; u.z = i & 3; return true; }
    DI size_t aoff(const Unit& u, const Gemm& g) const { return (size_t)u.pm * BM * g.lda * 2 + (size_t)u.z * 256 * 2; }
    DI size_t boff(const Unit& u, const Gemm& g) const { return (size_t)(u.z * 4 + u.pn) * BM * g.K * 2; }
};

#define EPI_CB(wc, bj) (((wc) >> 1) * HALF + (2 * ((wc) & 1) + (bj)) * 32)
#define EPI_ROWS_BEGIN \
    _Pragma("unroll") for (int ai = 0; ai < 2; ++ai) _Pragma("unroll") for (int m = 0; m < 4; ++m) { const int row = u.pm * BM + ai * HALF + wr * 64 + m * 16 + fr;
#define EPI_COLS_BEGIN \
    _Pragma("unroll") for (int bj = 0; bj < 2; ++bj) { const int col = u.pn * BM + EPI_CB(wc, bj) + 8 * fq; f32x4 v0 = acc[ai][bj][m][0], v1 = acc[ai][bj][m][1];
#define EPI_END } asm volatile("" ::: "memory"); }

template <int ACT  , bool RELAX = true  > struct EpiStore {
    static constexpr int NST = RELAX ? 16 : 0;
    bf16_t* O; int ldc; int ncv; const float* rs; int rss; float cmul; LAS unsigned char* stg;
    DI void operator()(const f32x4 (&acc)[2][2][4][2], const Unit& u, int wr, int wc, int fr, int fq) const {
        const int colw = u.pn * BM + EPI_CB(wc, 0);
        if (colw >= ncv) return;
        float scv[2][4];
#pragma unroll
        for (int ai = 0; ai < 2; ++ai)
#pragma unroll
            for (int m = 0; m < 4; ++m) scv[ai][m] = rs ? rs[(size_t)(u.pm * BM + ai * HALF + wr * 64 + m * 16 + fr) * rss] * cmul : 1.0f;
        LAS unsigned char* sw = stg + (wr * 4 + wc) * 2304;
        const int lane = fq * 16 + fr, orow = lane >> 3, opc = lane & 7;
#pragma unroll
        for (int ai = 0; ai < 2; ++ai)
#pragma unroll
            for (int m = 0; m < 4; ++m) {
                const float sc = scv[ai][m];
#pragma unroll
                for (int bj = 0; bj < 2; ++bj) {
                    f32x4 v0 = acc[ai][bj][m][0] * sc, v1 = acc[ai][bj][m][1] * sc;
                    if (ACT == 1) {
#pragma unroll
                        for (int j = 0; j < 4; ++j) { v0[j] = sigmoid_f(v0[j]); v1[j] = sigmoid_f(v1[j]); }
                    }
                    if (ACT == 2) {
#pragma unroll
                        for (int j = 0; j < 4; ++j) { const float a = fmaxf(v0[j], 0.f), b = fmaxf(v1[j], 0.f); v0[j] = a * a; v1[j] = b * b; }
                    }
                    u32x4 w; w.x = cvt_pk(v0[0], v0[1]); w.y = cvt_pk(v0[2], v0[3]); w.z = cvt_pk(v1[0], v1[1]); w.w = cvt_pk(v1[2], v1[3]);
                    *(LAS u32x4*)(sw + fr * 144 + bj * 64 + fq * 16) = w;
                }
                __builtin_amdgcn_fence(__ATOMIC_RELEASE, "wavefront"); __builtin_amdgcn_wave_barrier(); __builtin_amdgcn_fence(__ATOMIC_ACQUIRE, "wavefront");
                bf16_t* gp = O + (size_t)(u.pm * BM + ai * HALF + wr * 64 + m * 16 + orow) * ldc + colw + opc * 8;
                const u32x4 r0 = *(LAS const u32x4*)(sw + orow * 144 + opc * 16), r1 = *(LAS const u32x4*)(sw + (orow + 8) * 144 + opc * 16);
                *(u32x4*)gp = r0; *(u32x4*)(gp + (size_t)8 * ldc) = r1;
                __builtin_amdgcn_fence(__ATOMIC_RELEASE, "wavefront"); __builtin_amdgcn_wave_barrier(); __builtin_amdgcn_fence(__ATOMIC_ACQUIRE, "wavefront");
            }
    }
};
#define EPI_ROW(ai, m) (u.pm * BM + (ai) * HALF + wr * 64 + (m) * 16 + fr)
#define EPI_COL(bj) (u.pn * BM + EPI_CB(wc, bj) + 8 * fq)
DI void mul_bf8(f32x4& v0, f32x4& v1, const u32x4 g) {
    v0[0] *= bf_lo(g.x); v0[1] *= bf_hi(g.x); v0[2] *= bf_lo(g.y); v0[3] *= bf_hi(g.y); v1[0] *= bf_lo(g.z); v1[1] *= bf_hi(g.z); v1[2] *= bf_lo(g.w); v1[3] *= bf_hi(g.w); }
DI void add_bf8(f32x4& v0, f32x4& v1, const u32x4 g) {
    v0[0] += bf_lo(g.x); v0[1] += bf_hi(g.x); v0[2] += bf_lo(g.y); v0[3] += bf_hi(g.y); v1[0] += bf_lo(g.z); v1[1] += bf_hi(g.z); v1[2] += bf_lo(g.w); v1[3] += bf_hi(g.w); }
DI u32x4 pack_bf8(const f32x4 v0, const f32x4 v1) { u32x4 w; w.x = cvt_pk(v0[0], v0[1]); w.y = cvt_pk(v0[2], v0[3]); w.z = cvt_pk(v1[0], v1[1]); w.w = cvt_pk(v1[2], v1[3]); return w; }
struct EpiMerge {
    static constexpr int NST = 0;
    bf16_t* MG; const bf16_t* GT;
    DI void operator()(const f32x4 (&acc)[2][2][4][2], const Unit& u, int wr, int wc, int fr, int fq) const {
#pragma unroll
        for (int ai = 0; ai < 2; ++ai)
#pragma unroll
            for (int mh = 0; mh < 2; ++mh) {
                u32x4 gv[2][2], ov[2][2];
#pragma unroll
                for (int mm = 0; mm < 2; ++mm)
#pragma unroll
                    for (int bj = 0; bj < 2; ++bj) {
                        const size_t row = EPI_ROW(ai, 2 * mh + mm); const int col = EPI_COL(bj);
                        gv[mm][bj] = *(const u32x4*)(GT + row * ZC + u.z * DM + col);
                        if (u.z != 0) ov[mm][bj] = *(const u32x4*)(MG + row * DM + col);
                    }
#pragma unroll
                for (int mm = 0; mm < 2; ++mm)
#pragma unroll
                    for (int bj = 0; bj < 2; ++bj) {
                        const size_t row = EPI_ROW(ai, 2 * mh + mm); const int col = EPI_COL(bj);
                        f32x4 v0 = acc[ai][bj][2 * mh + mm][0], v1 = acc[ai][bj][2 * mh + mm][1];
                        mul_bf8(v0, v1, gv[mm][bj]);
                        if (u.z != 0) add_bf8(v0, v1, ov[mm][bj]);
                        *(u32x4*)(MG + row * DM + col) = pack_bf8(v0, v1);
                    }
                asm volatile("" ::: "memory");
            }
    }
};
template <bool EXTRA> struct EpiResid {
    static constexpr int NST = 0;
    const float* Xin; float* Xout; const bf16_t* E; const float* stats; const float* gam; const float* bet;
    DI void operator()(const f32x4 (&acc)[2][2][4][2], const Unit& u, int wr, int wc, int fr, int fq) const {
        f32x4 g0[2], g1[2], b0[2], b1[2];
#pragma unroll
        for (int bj = 0; bj < 2; ++bj) { const int col = EPI_COL(bj);
            g0[bj] = *(const f32x4*)(gam + col) * ALPHA; g1[bj] = *(const f32x4*)(gam + col + 4) * ALPHA;
            b0[bj] = *(const f32x4*)(bet + col) * ALPHA; b1[bj] = *(const f32x4*)(bet + col + 4) * ALPHA; }
#pragma unroll
        for (int ai = 0; ai < 2; ++ai)
#pragma unroll
            for (int mh = 0; mh < 2; ++mh) {
                f32x4 x0[2][2], x1[2][2]; u32x4 ev[2][2]; f32x2 st[2];
#pragma unroll
                for (int mm = 0; mm < 2; ++mm) {
                    const size_t row = EPI_ROW(ai, 2 * mh + mm);
                    st[mm] = *(const f32x2*)(stats + row * 2);
#pragma unroll
                    for (int bj = 0; bj < 2; ++bj) {
                        const int col = EPI_COL(bj);
                        x0[mm][bj] = *(const f32x4*)(Xin + row * DM + col); x1[mm][bj] = *(const f32x4*)(Xin + row * DM + col + 4);
                        if (EXTRA) ev[mm][bj] = *(const u32x4*)(E + row * DM + col);
                    }
                }
#pragma unroll
                for (int mm = 0; mm < 2; ++mm)
#pragma unroll
                    for (int bj = 0; bj < 2; ++bj) {
                        const size_t row = EPI_ROW(ai, 2 * mh + mm); const int col = EPI_COL(bj);
                        const float mean = st[mm].x, rstd = st[mm].y;
                        f32x4 v0 = acc[ai][bj][2 * mh + mm][0] + ((x0[mm][bj] - mean) * rstd) * g0[bj] + b0[bj];
                        f32x4 v1 = acc[ai][bj][2 * mh + mm][1] + ((x1[mm][bj] - mean) * rstd) * g1[bj] + b1[bj];
                        if (EXTRA) add_bf8(v0, v1, ev[mm][bj]);
                        *(f32x4*)(Xout + row * DM + col) = v0; *(f32x4*)(Xout + row * DM + col + 4) = v1;
                    }
                asm volatile("" ::: "memory");
            }
    }
};
struct EpiMulInto {
    static constexpr int NST = 0;
    bf16_t* P;
    DI void operator()(const f32x4 (&acc)[2][2][4][2], const Unit& u, int wr, int wc, int fr, int fq) const {
#pragma unroll
        for (int ai = 0; ai < 2; ++ai) {
            u32x4 gv[4][2];
#pragma unroll
            for (int m = 0; m < 4; ++m)
#pragma unroll
                for (int bj = 0; bj < 2; ++bj) gv[m][bj] = *(const u32x4*)(P + (size_t)EPI_ROW(ai, m) * DM + EPI_COL(bj));
#pragma unroll
            for (int m = 0; m < 4; ++m)
#pragma unroll
                for (int bj = 0; bj < 2; ++bj) {
                    f32x4 v0 = acc[ai][bj][m][0], v1 = acc[ai][bj][m][1];
                    mul_bf8(v0, v1, gv[m][bj]);
                    *(u32x4*)(P + (size_t)EPI_ROW(ai, m) * DM + EPI_COL(bj)) = pack_bf8(v0, v1);
                }
            asm volatile("" ::: "memory");
        }
    }
};

template <class Epi, class Sched>
DI void gemm_phase(LAS unsigned char* lds, const Gemm g, const Sched& S_, const Epi& E, const int wave_s) {
    int tid_ = wave_s * 64 + lane_id(); asm volatile("" : "+v"(tid_));
    const int tid = tid_, wid = __builtin_amdgcn_readfirstlane(tid >> 6), lane = tid & 63, wr = wid >> 2, wc = wid & 3, fr = lane & 15, fq = lane >> 4;
    const int K = g.K, nt = K / BK;
    unsigned voffA[2], voffB[2];
#pragma unroll
    for (int i = 0; i < 2; ++i) { int R, C; stage_rc(tid * 16 + i * 8192, R, C); const int Rb = (R & ~31) + perm32(R & 31);
        voffA[i] = (unsigned)(R * g.lda + C) * 2u; voffB[i] = (unsigned)(Rb * K + C) * 2u; }
    const size_t kstep = (size_t)(BK * 2);
    const size_t hstepA = (size_t)HALF * g.lda * 2, hstepB = (size_t)HALF * K * 2;
    const unsigned ldsw = (unsigned)wid * 1024u;
    const int hB = wc >> 1, g0 = 2 * (wc & 1);
    const int aoff = lds_byte(wr * 64 + fr, fq * 8), boff = lds_byte(g0 * 32 + fr, fq * 8) + hB * HTB;
#define PG8_SA(b, h) (((b) * 2 + (h)) * HTB)
#define PG8_SB(b, h) ((4 + (b) * 2 + (h)) * HTB)
#define PG8_STAGE(bufoff, gbase, voff) do { _Pragma("unroll") for (int _i = 0; _i < 2; ++_i) \
        __builtin_amdgcn_global_load_lds((const unsigned*)((const char*)(gbase) + (voff)[_i]), (LAS unsigned*)(lds + (bufoff) + ldsw + _i * 8192), 16, 0, 0); } while (0)
#define PG8_LDA(dst, b, h) do { _Pragma("unroll") for (int m = 0; m < 4; ++m) _Pragma("unroll") for (int k = 0; k < 2; ++k) dst[m][k] = *(const LAS bf16x8*)(lds + PG8_SA(b, h) + aoff + m * 2048 + k * 1024); } while (0)
#define PG8_LDB(dst, b, h) do { _Pragma("unroll") for (int n = 0; n < 2; ++n) _Pragma("unroll") for (int k = 0; k < 2; ++k) dst[n][k] = *(const LAS bf16x8*)(lds + PG8_SB(b, 0) + boff + (h) * 4096 + n * 2048 + k * 1024); } while (0)
#define PG8_MMA(ai, bj, At, Bt) do { __builtin_amdgcn_s_setprio(1); _Pragma("unroll") for (int m = 0; m < 4; ++m) _Pragma("unroll") for (int n = 0; n < 2; ++n) _Pragma("unroll") for (int k = 0; k < 2; ++k) \
        acc[ai][bj][m][n] = __builtin_amdgcn_mfma_f32_16x16x32_bf16(Bt[n][k], At[m][k], acc[ai][bj][m][n], 0, 0, 0); __builtin_amdgcn_s_setprio(0); } while (0)
#define PG8_WAIT_V(n) asm volatile("s_waitcnt vmcnt(" #n ")" ::: "memory")
#define PG8_WAIT_L(n) asm volatile("s_waitcnt lgkmcnt(" #n ")" ::: "memory")
#define PG8_WAIT_VR(rlx) do { if (Epi::NST == 16) asm volatile("s_cmp_eq_u32 %0, 0\n\ts_cbranch_scc1 .Lpg8w8_%=\n\ts_waitcnt vmcnt(24)\n\ts_branch .Lpg8wd_%=\n.Lpg8w8_%=:\n\ts_waitcnt vmcnt(8)\n.Lpg8wd_%=:" :: "s"(rlx) : "memory", "scc"); \
                               else PG8_WAIT_V(8); } while (0)
#define PG8_BAR __builtin_amdgcn_s_barrier()
#define PG8_SCHED __builtin_amdgcn_sched_barrier(0)
    Unit cur, nxt; int ui = 0;
    if (!S_.next(0, cur)) return;
    f32x4 acc[2][2][4][2];
#pragma unroll
    for (int a = 0; a < 2; ++a)
#pragma unroll
        for (int b = 0; b < 2; ++b)
#pragma unroll
            for (int m = 0; m < 4; ++m)
#pragma unroll
                for (int n = 0; n < 2; ++n) acc[a][b][m][n] = (f32x4){0.f, 0.f, 0.f, 0.f};
    bf16x8 At[4][2], B0[2][2], B1[2][2];
    const char* cA = (const char*)g.A + S_.aoff(cur, g); const char* cB = (const char*)g.Bt + S_.boff(cur, g);
    PG8_STAGE(PG8_SB(0, 0), cB, voffB); PG8_STAGE(PG8_SB(0, 1), cB + hstepB, voffB); PG8_STAGE(PG8_SA(0, 0), cA, voffA); PG8_STAGE(PG8_SA(0, 1), cA + hstepA, voffA);
    if (wr == 1) PG8_BAR;
    PG8_WAIT_V(2); PG8_BAR;
    PG8_STAGE(PG8_SB(1, 0), cB + kstep, voffB); PG8_STAGE(PG8_SA(1, 0), cA + kstep, voffA); PG8_STAGE(PG8_SB(1, 1), cB + hstepB + kstep, voffB);
    PG8_WAIT_V(6); PG8_BAR;
    for (;;) {
        const bool has_next = S_.next(ui + 1, nxt);
        const char* nA = has_next ? (const char*)g.A + S_.aoff(nxt, g) : cA; const char* nB = has_next ? (const char*)g.Bt + S_.boff(nxt, g) : cB;
        for (int t = 0; t < nt; t += 2) {
            const bool last = (t == nt - 2);
            const char* a1 = cA + (size_t)(t + 1) * kstep;
            const char* a2 = last ? nA : cA + (size_t)(t + 2) * kstep; const char* b2 = last ? nB : cB + (size_t)(t + 2) * kstep;
            const char* a3 = a2 + kstep; const char* b3 = b2 + kstep;
            const int rlx = __builtin_amdgcn_readfirstlane((ui > 0 && t == 0) ? 1 : 0);
            PG8_LDB(B0, 0, 0); PG8_LDB(B1, 0, 1); PG8_SCHED; PG8_LDA(At, 0, 0); PG8_STAGE(PG8_SA(1, 1), a1 + hstepA, voffA);
            PG8_WAIT_VR(rlx); PG8_WAIT_L(0); PG8_BAR; PG8_MMA(0, 0, At, B0); PG8_MMA(0, 1, At, B1); PG8_BAR; PG8_SCHED;
            PG8_LDA(At, 0, 1); PG8_STAGE(PG8_SB(0, 0), b2, voffB); PG8_STAGE(PG8_SB(0, 1), b2 + hstepB, voffB); PG8_STAGE(PG8_SA(0, 0), a2, voffA);
            PG8_WAIT_VR(rlx); PG8_WAIT_L(0); PG8_BAR; PG8_MMA(1, 0, At, B0); PG8_MMA(1, 1, At, B1); PG8_BAR; PG8_SCHED;
            PG8_LDB(B0, 1, 0); PG8_LDB(B1, 1, 1); PG8_SCHED; PG8_LDA(At, 1, 0); PG8_STAGE(PG8_SA(0, 1), a2 + hstepA, voffA);
            PG8_WAIT_V(8); PG8_WAIT_L(0); PG8_BAR; PG8_MMA(0, 0, At, B0); PG8_MMA(0, 1, At, B1); PG8_BAR; PG8_SCHED;
            PG8_LDA(At, 1, 1); PG8_STAGE(PG8_SB(1, 0), b3, voffB); PG8_STAGE(PG8_SB(1, 1), b3 + hstepB, voffB); PG8_STAGE(PG8_SA(1, 0), a3, voffA);
            PG8_WAIT_V(8); PG8_WAIT_L(0); PG8_BAR; PG8_MMA(1, 0, At, B0); PG8_MMA(1, 1, At, B1); PG8_BAR; PG8_SCHED;
        }
        if (wr == 0) PG8_BAR;
        { const int l2 = lane_id(); E(acc, cur, wr, wc, l2 & 15, l2 >> 4); }
        if (!has_next) break;
#pragma unroll
        for (int a = 0; a < 2; ++a)
#pragma unroll
            for (int b = 0; b < 2; ++b)
#pragma unroll
                for (int m = 0; m < 4; ++m)
#pragma unroll
                    for (int n = 0; n < 2; ++n) acc[a][b][m][n] = (f32x4){0.f, 0.f, 0.f, 0.f};
        cur = nxt; cA = nA; cB = nB; ++ui;
        if (wr == 1) PG8_BAR;
    }
    PG8_WAIT_V(0);
    PG8_BAR;
#undef PG8_SA
#undef PG8_SB
#undef PG8_STAGE
#undef PG8_LDA
#undef PG8_LDB
#undef PG8_MMA
#undef PG8_WAIT_V
#undef PG8_WAIT_L
#undef PG8_WAIT_VR
#undef PG8_BAR
#undef PG8_SCHED
}
}

struct AttnP {
    const bf16_t* ZQ; const bf16_t* QM; const bf16_t* KVM; const bf16_t* KR; bf16_t* Y; bf16_t* ZQw; float* LSE;
    const float* LUTS; const float* LUTD; const float* rpb; const float* sink; const float* COS;
};
constexpr int A_VP = 144, A_LUT = 114688, A_WSF = A_LUT + 2048, A_END = A_WSF + 2048;

template <int VAR> DI void attn_unit(LAS unsigned char* lds, const AttnP& P, const int u, const int wave_s) {
    constexpr int NKS = (VAR == 0) ? 6 : 4, QB = 1, QPW = 32 * QB;
    constexpr int A_TK = (VAR == 0) ? 128 : (VAR == 1 ? 256 : 384), NBUF = (VAR == 0) ? 2 : 1, A_KP = (VAR == 0) ? 208 : 144, NLD = A_TK / 64;
    constexpr int A_KB = 0, A_VB = NBUF * A_TK * A_KP;
    static_assert(A_VB + NBUF * A_TK * A_VP <= A_LUT, "attention tiles vs LDS map");
    int tid_ = wave_s * 64 + lane_id(); asm volatile("" : "+v"(tid_));
    const int tid = tid_, lane = tid & 63, r32 = lane & 31, hi = lane >> 5, w = __builtin_amdgcn_readfirstlane(tid >> 6);
    LAS float* LUT = (LAS float*)(lds + A_LUT);
    LAS float* WSF = (LAS float*)(lds + A_WSF) + w * 64;
    int b, h, qt, g = 0, r = 1, res = 0, L = S, j0 = 0;
    if (VAR == 0) { qt = u & 31; h = (u >> 5) & 3; b = u >> 7; j0 = 256 * qt; }
    else if (VAR == 3) { qt = u & 31; h = (u >> 5) & 3; b = u / 384; g = (u >> 7) % 3; r = (g == 0) ? 1 : (g == 1 ? 4 : 16); L = S / r; const int tpr = 32 / r; res = qt / tpr; j0 = 256 * (qt % tpr); }
    else { qt = u & 31; h = (u >> 5) & 3; b = u >> 7; j0 = 256 * qt; }
    const size_t tb = (size_t)b * S;
    const int qw = j0 + QPW * w;
    if (VAR == 1) { for (int i = tid; i < 257; i += 512) LUT[i] = P.LUTS[h * 260 + i]; }
    if (VAR == 2) { for (int i = tid; i < 465; i += 512) LUT[i] = P.rpb[h * 465 + i] * LOG2E; }
    if (VAR == 3) { for (int i = tid; i < 129; i += 512) LUT[i] = P.LUTD[(g * 4 + h) * 132 + i]; }
    bf16x8 qf[QB][NKS];
#pragma unroll
    for (int qb = 0; qb < QB; ++qb) {
        const int qi = qw + 32 * qb + r32;
        const bf16_t* qp;
        if (VAR == 0) qp = P.QM + (tb + qi) * 384 + h * 96;
        else if (VAR == 1) qp = P.ZQ + (tb + qi) * ZC + C_BQ + h * 64;
        else if (VAR == 2) qp = P.ZQ + (tb + qi) * ZC + C_CQ + h * 64;
        else qp = P.ZQ + (tb + res + (size_t)r * qi) * ZC + C_DQ + g * 256 + h * 64;
#pragma unroll
        for (int ks = 0; ks < NKS; ++ks) qf[qb][ks] = *(const bf16x8*)(qp + 16 * ks + 8 * hi);
        if (VAR == 0) {
            const float* cp = P.COS + qi * 16 + 8 * hi; const float* sp = cp + S * 16;
            const f32x4 c0 = *(const f32x4*)cp, c1 = *(const f32x4*)(cp + 4), s0 = *(const f32x4*)sp, s1 = *(const f32x4*)(sp + 4);
            const u32x4 a4 = __builtin_bit_cast(u32x4, qf[qb][4]), a5 = __builtin_bit_cast(u32x4, qf[qb][5]);
            u32x4 o4, o5;
#define ROPE2(k, ca, cb, sa, sb) { const float x1l = bf_lo(a4[k]), x1h = bf_hi(a4[k]), x2l = bf_lo(a5[k]), x2h = bf_hi(a5[k]); \
                o4[k] = cvt_pk(x1l * ca - x2l * sa, x1h * cb - x2h * sb); o5[k] = cvt_pk(x1l * sa + x2l * ca, x1h * sb + x2h * cb); }
            ROPE2(0, c0[0], c0[1], s0[0], s0[1]) ROPE2(1, c0[2], c0[3], s0[2], s0[3]) ROPE2(2, c1[0], c1[1], s1[0], s1[1]) ROPE2(3, c1[2], c1[3], s1[2], s1[3])
#undef ROPE2
            qf[qb][4] = __builtin_bit_cast(bf16x8, o4); qf[qb][5] = __builtin_bit_cast(bf16x8, o5);
        }
    }
    int NT, kfirst;
    if (VAR == 0) { NT = S / A_TK; kfirst = 0; }
    else if (VAR == 1) { NT = 2; kfirst = j0 - 128; }
    else if (VAR == 2) { const int f = min(max(4 * qt - 4, 0), 120); NT = 2; kfirst = 64 * f; }
    else { NT = 1; kfirst = j0 - 64; }
    float m_run[QB], l_run[QB];
    f32x16 o[QB][2];
#pragma unroll
    for (int qb = 0; qb < QB; ++qb) {
        m_run[qb] = (VAR == 0) ? 0.f : -1e30f; l_run[qb] = 0.f;
        if (VAR == 1) { m_run[qb] = P.sink[h] * LOG2E; l_run[qb] = (hi == 0) ? 1.0f : 0.0f; }
#pragma unroll
        for (int i = 0; i < 16; ++i) { o[qb][0][i] = 0.f; o[qb][1][i] = 0.f; }
    }
    const float c2 = 0.125f * LOG2E;
    const int qrow = (qw >> 6), qc = (qw & 63) + r32;
    const int r0 = min(max(qrow - 4, 0), 120), cs = min(max(qc - 8, 0), 48);
    const int srow = tid >> 3, sch = tid & 7, srow2 = tid >> 2, sch2 = tid & 3;
    u32x4 kreg[NLD], vreg[NLD], rreg;
    auto load_tile = [&](int t) {
#pragma unroll
        for (int i = 0; i < NLD; ++i) {
            const int kidx = kfirst + A_TK * t + srow + 64 * i;
            if (VAR == 0) {
                const bf16_t* kp = P.KVM + (tb + kidx) * 512 + h * 128 + sch * 8;
                kreg[i] = *(const u32x4*)kp; vreg[i] = *(const u32x4*)(kp + 64);
            } else if (VAR == 1) {
                const int kc = min(max(kidx, 0), S - 1); const bf16_t* base = P.ZQ + (tb + kc) * ZC + (h >> 1) * 64 + sch * 8;
                kreg[i] = *(const u32x4*)(base + C_BK); vreg[i] = *(const u32x4*)(base + C_BV);
            } else if (VAR == 2) {
                const int kc = min(kidx, S - 1); const bf16_t* base = P.ZQ + (tb + kc) * ZC + h * 64 + sch * 8;
                kreg[i] = *(const u32x4*)(base + C_CK); vreg[i] = *(const u32x4*)(base + C_CV);
            } else {
                const int kc = min(max(kidx, 0), L - 1); const bf16_t* base = P.ZQ + (tb + res + (size_t)r * kc) * ZC + g * 256 + h * 64 + sch * 8;
                kreg[i] = *(const u32x4*)(base + C_DK); vreg[i] = *(const u32x4*)(base + C_DV);
            }
        }
        if (VAR == 0) rreg = *(const u32x4*)(P.KR + (tb + kfirst + A_TK * t + srow2) * 32 + sch2 * 8);
    };
    auto store_tile = [&](int buf) {
#pragma unroll
        for (int i = 0; i < NLD; ++i) {
            *(LAS u32x4*)(lds + A_KB + buf * A_TK * A_KP + (srow + 64 * i) * A_KP + sch * 16) = kreg[i];
            *(LAS u32x4*)(lds + A_VB + buf * A_TK * A_VP + (srow + 64 * i) * A_VP + sch * 16) = vreg[i];
        }
        if (VAR == 0) *(LAS u32x4*)(lds + A_KB + buf * A_TK * A_KP + srow2 * A_KP + 128 + sch2 * 16) = rreg;
    };
    load_tile(0); store_tile(0);
    __syncthreads();
    const int tq = lane & 15, tq_q = tq >> 2, tq_p = tq & 3, blk = (lane >> 4) & 1;
    float mxt[QB];
    if (VAR == 0) {
#pragma unroll
        for (int qb = 0; qb < QB; ++qb) {
            f32x16 s0;
#pragma unroll
            for (int i = 0; i < 16; ++i) s0[i] = 0.f;
#pragma unroll
            for (int ks = 0; ks < NKS; ++ks) {
                const bf16x8 kf = *(LAS const bf16x8*)(lds + A_KB + r32 * A_KP + (16 * ks + 8 * hi) * 2);
                s0 = __builtin_amdgcn_mfma_f32_32x32x16_bf16(kf, qf[qb][ks], s0, 0, 0, 0);
            }
            float mx = s0[0];
#pragma unroll
            for (int i = 1; i < 16; ++i) mx = fmaxf(mx, s0[i]);
            m_run[qb] = xhalf_max(mx); mxt[qb] = -INFINITY;
        }
    }
    for (int t = 0; t < NT; ++t) {
        if (t + 1 < NT) load_tile(t + 1);
        const int buf = (NBUF == 2) ? (t & 1) : 0;
#pragma unroll (VAR == 0 ? 4 : 2)
        for (int sb = 0; sb < A_TK / 32; ++sb) {
            const int kb = kfirst + A_TK * t + 32 * sb;
            bool act = true;
            if (VAR == 1) act = (kb + 31 >= max(qw - 128, 0)) && (kb <= min(qw + 159, S - 1));
            if (VAR == 2) { const int kr = kb >> 6; act = (kr >= r0) && (kr < r0 + 8); }
            if (VAR == 3) act = (kb + 31 >= max(qw - 64, 0)) && (kb <= min(qw + 95, L - 1));
            if (!act) continue;
            LAS const unsigned char* Kb = lds + A_KB + buf * A_TK * A_KP + (32 * sb) * A_KP;
            LAS const unsigned char* Vb = lds + A_VB + buf * A_TK * A_VP + (32 * sb) * A_VP;
            f32x16 s[QB];
#pragma unroll
            for (int qb = 0; qb < QB; ++qb)
#pragma unroll
                for (int i = 0; i < 16; ++i) s[qb][i] = (VAR == 0) ? -m_run[qb] : 0.f;
#pragma unroll
            for (int ks = 0; ks < NKS; ++ks) {
                const bf16x8 kf = *(LAS const bf16x8*)(Kb + r32 * A_KP + (16 * ks + 8 * hi) * 2);
#pragma unroll
                for (int qb = 0; qb < QB; ++qb) s[qb] = __builtin_amdgcn_mfma_f32_32x32x16_bf16(kf, qf[qb][ks], s[qb], 0, 0, 0);
            }
            bf16x8 pf[QB][2];
#pragma unroll
            for (int qb = 0; qb < QB; ++qb) {
                if (VAR == 1 || VAR == 3) {
                    const int HALFW = (VAR == 1) ? 128 : 64, LL = (VAR == 1) ? S : L;
                    const int qpos = qw + r32;
#pragma unroll
                    for (int i = 0; i < 16; ++i) {
                        const int kp = kb + crow(i, hi), rel = kp - qpos;
                        const bool ok = (rel >= -HALFW) && (rel <= HALFW) && (kp >= 0) && (kp < LL);
                        const int idx = min(max(rel + HALFW, 0), 2 * HALFW);
                        s[qb][i] = ok ? (s[qb][i] * c2 + LUT[idx]) : -INFINITY;
                    }
                }
                if (VAR == 2) {
                    const int dr = (kb >> 6) - qrow + 7;
#pragma unroll
                    for (int i = 0; i < 16; ++i) {
                        const int ck = (kb & 63) + crow(i, hi), d = ck - qc;
                        const bool ok = (ck >= cs) && (ck < cs + 16);
                        const int idx = dr * 31 + min(max(d + 15, 0), 30);
                        s[qb][i] = ok ? (s[qb][i] * c2 + LUT[idx]) : -INFINITY;
                    }
                }
                float mx = s[qb][0];
#pragma unroll
                for (int i = 1; i < 16; ++i) mx = fmaxf(mx, s[qb][i]);
                if (VAR == 0) mxt[qb] = fmaxf(mxt[qb], mx);
                else {
                mx = xhalf_max(mx);
                const float mnew = fmaxf(m_run[qb], mx);
                if (__any(mnew != m_run[qb])) {
                    const float al = __builtin_amdgcn_exp2f(m_run[qb] - mnew);
                    l_run[qb] *= al; m_run[qb] = mnew;
                    if (hi == 0) WSF[32 * qb + r32] = al;
                    __builtin_amdgcn_fence(__ATOMIC_RELEASE, "wavefront"); __builtin_amdgcn_wave_barrier(); __builtin_amdgcn_fence(__ATOMIC_ACQUIRE, "wavefront");
#pragma unroll
                    for (int i = 0; i < 16; ++i) { const float al2 = WSF[32 * qb + crow(i, hi)]; o[qb][0][i] *= al2; o[qb][1][i] *= al2; }
                    __builtin_amdgcn_fence(__ATOMIC_RELEASE, "wavefront"); __builtin_amdgcn_wave_barrier(); __builtin_amdgcn_fence(__ATOMIC_ACQUIRE, "wavefront");
                }
                }
                float ps = 0.f;
#pragma unroll
                for (int i = 0; i < 16; ++i) { s[qb][i] = __builtin_amdgcn_exp2f((VAR == 0) ? s[qb][i] : s[qb][i] - m_run[qb]); ps += s[qb][i]; }
                l_run[qb] += ps;
                u32x4 pw0, pw1;
                pw0.x = cvt_pk(s[qb][0], s[qb][1]); pw0.y = cvt_pk(s[qb][2], s[qb][3]); pw0.z = cvt_pk(s[qb][4], s[qb][5]); pw0.w = cvt_pk(s[qb][6], s[qb][7]);
                pw1.x = cvt_pk(s[qb][8], s[qb][9]); pw1.y = cvt_pk(s[qb][10], s[qb][11]); pw1.z = cvt_pk(s[qb][12], s[qb][13]); pw1.w = cvt_pk(s[qb][14], s[qb][15]);
                pf[qb][0] = __builtin_bit_cast(bf16x8, pw0); pf[qb][1] = __builtin_bit_cast(bf16x8, pw1);
            }
#pragma unroll
            for (int d0 = 0; d0 < 2; ++d0) {
#pragma unroll
                for (int ss = 0; ss < 2; ++ss) {
                    LAS const unsigned char* vp = Vb + (16 * ss + 4 * hi + tq_q) * A_VP + (32 * d0 + 16 * blk + 4 * tq_p) * 2;
                    const s16x4 lo = __builtin_amdgcn_ds_read_tr16_b64_v4i16((LAS s16x4*)vp);
                    const s16x4 hh = __builtin_amdgcn_ds_read_tr16_b64_v4i16((LAS s16x4*)(vp + 8 * A_VP));
                    const bf16x8 vf = (bf16x8){lo[0], lo[1], lo[2], lo[3], hh[0], hh[1], hh[2], hh[3]};
#pragma unroll
                    for (int qb = 0; qb < QB; ++qb) o[qb][d0] = __builtin_amdgcn_mfma_f32_32x32x16_bf16(pf[qb][ss], vf, o[qb][d0], 0, 0, 0);
                }
            }
        }
        if (VAR == 0) {
#pragma unroll
            for (int qb = 0; qb < QB; ++qb) {
                if (__any(mxt[qb] > 64.0f)) {
                    const float dl = fmaxf(xhalf_max(mxt[qb]), 0.f), al = __builtin_amdgcn_exp2f(-dl);
                    l_run[qb] *= al; m_run[qb] += dl;
                    if (hi == 0) WSF[32 * qb + r32] = al;
                    __builtin_amdgcn_fence(__ATOMIC_RELEASE, "wavefront"); __builtin_amdgcn_wave_barrier(); __builtin_amdgcn_fence(__ATOMIC_ACQUIRE, "wavefront");
#pragma unroll
                    for (int i = 0; i < 16; ++i) { const float al2 = WSF[32 * qb + crow(i, hi)]; o[qb][0][i] *= al2; o[qb][1][i] *= al2; }
                    __builtin_amdgcn_fence(__ATOMIC_RELEASE, "wavefront"); __builtin_amdgcn_wave_barrier(); __builtin_amdgcn_fence(__ATOMIC_ACQUIRE, "wavefront");
                }
                mxt[qb] = -INFINITY;
            }
        }
        if (NBUF == 2) { if (t + 1 < NT) store_tile((t + 1) & 1); }
        else if (t + 1 < NT) { __syncthreads(); store_tile(0); }
        __syncthreads();
    }
#pragma unroll
    for (int qb = 0; qb < QB; ++qb) {
        const float lt = xhalf_sum(l_run[qb]);
        if (hi == 0) WSF[32 * qb + r32] = 1.0f / lt;
        if (VAR == 3) { if (hi == 0) P.LSE[(tb + res + (size_t)r * (qw + r32)) * 12 + g * 4 + h] = m_run[qb] + __builtin_amdgcn_logf(lt); }
    }
    __builtin_amdgcn_fence(__ATOMIC_RELEASE, "wavefront"); __builtin_amdgcn_wave_barrier(); __builtin_amdgcn_fence(__ATOMIC_ACQUIRE, "wavefront");
#pragma unroll
    for (int qb = 0; qb < QB; ++qb) {
#pragma unroll
        for (int i = 0; i < 16; ++i) {
            const int qi = qw + 32 * qb + crow(i, hi); const float al = WSF[32 * qb + crow(i, hi)];
            bf16_t* op;
            if (VAR == 3) op = P.ZQw + (tb + res + (size_t)r * qi) * ZC + C_DQ + g * 256 + h * 64;
            else op = P.Y + (tb + qi) * DM + VAR * 256 + h * 64;
            const unsigned a0 = cvt_pk(o[qb][0][i] * al, 0.f), a1 = cvt_pk(o[qb][1][i] * al, 0.f);
            op[r32] = (bf16_t)(a0 & 0xffffu); op[32 + r32] = (bf16_t)(a1 & 0xffffu);
        }
    }
    __syncthreads();
}

DI int t5_bucket(int rel) {
    const int n = rel < 0 ? -rel : rel;
    const int v = n < 8 ? n : 8 + (n >= 15) + (n >= 27) + (n >= 50) + (n >= 91) + (n >= 166) + (n >= 305) + (n >= 559);
    return (rel > 0 ? 16 : 0) + v;
}
DI void transpose_item(const float* W, int ldw, int coff, const float* kscale, bf16_t* WT, int ldt, LAS float* scr, int kb, int nb, int lane) {
    const int k0 = 64 * kb, n0 = 32 * nb;
    const int rr = lane >> 3, c4 = 4 * (lane & 7);
    f32x4 v[8];
#pragma unroll
    for (int i = 0; i < 8; ++i) v[i] = *(const f32x4*)(W + (size_t)(k0 + 8 * i + rr) * ldw + coff + n0 + c4);
#pragma unroll
    for (int i = 0; i < 8; ++i) {
        const int kk = 8 * i + rr; f32x4 x = v[i];
        if (kscale) x = x * kscale[k0 + kk];
        LAS float* d = scr + kk * 33 + c4; d[0] = x.x; d[1] = x.y; d[2] = x.z; d[3] = x.w;
    }
    __builtin_amdgcn_fence(__ATOMIC_RELEASE, "wavefront"); __builtin_amdgcn_wave_barrier(); __builtin_amdgcn_fence(__ATOMIC_ACQUIRE, "wavefront");
    const int c = lane & 7;
#pragma unroll
    for (int j = 0; j < 4; ++j) { const int n = (lane >> 3) + 8 * j; const LAS float* s = scr + (8 * c) * 33 + n;
        u32x4 o; o.x = cvt_pk(s[0 * 33], s[1 * 33]); o.y = cvt_pk(s[2 * 33], s[3 * 33]); o.z = cvt_pk(s[4 * 33], s[5 * 33]); o.w = cvt_pk(s[6 * 33], s[7 * 33]);
        *(u32x4*)(WT + (size_t)(n0 + n) * ldt + k0 + 8 * c) = o; }
    __builtin_amdgcn_fence(__ATOMIC_RELEASE, "wavefront"); __builtin_amdgcn_wave_barrier(); __builtin_amdgcn_fence(__ATOMIC_ACQUIRE, "wavefront");
}
DI void transpose_mat(const float* W, int K, int N, int ldw, int coff, const float* kscale, bf16_t* WT, int ldt, LAS float* scr, int gw, int NGW, int lane) {
    const int nblk = N / 32, items = (K / 64) * nblk;
    for (int it = gw; it < items; it += NGW) transpose_item(W, ldw, coff, kscale, WT, ldt, scr, it / nblk, it % nblk, lane);
}
template <int RN> DI void ln_rows(const float* in, float* outf, bf16_t* outb, float* stat, const float* gam, const float* bet, int lane) {
    f32x4 v[RN][4]; float mean[RN], rstd[RN];
#pragma unroll
    for (int r = 0; r < RN; ++r)
#pragma unroll
        for (int j = 0; j < 4; ++j) v[r][j] = ((const f32x4*)(in + (size_t)r * DM))[lane + 64 * j];
#pragma unroll
    for (int r = 0; r < RN; ++r) { float s = 0.f;
#pragma unroll
        for (int j = 0; j < 4; ++j) s += (v[r][j].x + v[r][j].y) + (v[r][j].z + v[r][j].w);
        mean[r] = s; }
#pragma unroll
    for (int r = 0; r < RN; ++r) mean[r] = wave_sum(mean[r]);
#pragma unroll
    for (int r = 0; r < RN; ++r) { mean[r] *= (1.f / DM); float s2 = 0.f;
#pragma unroll
        for (int j = 0; j < 4; ++j) { v[r][j] = v[r][j] - mean[r]; s2 += (v[r][j].x * v[r][j].x + v[r][j].y * v[r][j].y) + (v[r][j].z * v[r][j].z + v[r][j].w * v[r][j].w); }
        rstd[r] = s2; }
#pragma unroll
    for (int r = 0; r < RN; ++r) rstd[r] = wave_sum(rstd[r]);
#pragma unroll
    for (int r = 0; r < RN; ++r) { rstd[r] = 1.0f / sqrtf(rstd[r] * (1.f / DM) + 1e-5f); if (stat && lane == 0) { stat[2 * r] = mean[r]; stat[2 * r + 1] = rstd[r]; } }
#pragma unroll
    for (int j = 0; j < 4; ++j) {
        const f32x4 gg = ((const f32x4*)gam)[lane + 64 * j], bb = ((const f32x4*)bet)[lane + 64 * j];
#pragma unroll
        for (int r = 0; r < RN; ++r) {
            const f32x4 y = v[r][j] * rstd[r] * gg + bb;
            if (outf) ((f32x4*)(outf + (size_t)r * DM))[lane + 64 * j] = y;
            if (outb) { u32x2 w2; w2.x = cvt_pk(y.x, y.y); w2.y = cvt_pk(y.z, y.w); ((u32x2*)(outb + (size_t)r * DM))[lane + 64 * j] = w2; }
        }
    }
}

#define XB_TMO      128
#define XB_XCNT(j)  (256  + 64 * (j))
#define XB_XSUB(j)  (1280 + 64 * (j))
#define XB_XGEN(j)  (2304 + 64 * (j))
#define XB_TOP      3328
#define XB_TOPGEN   3392
#define XCD_BAR_WORDS 3456
#define XB_SPIN_CAP (1u << 20)
DI unsigned xb_ld(unsigned* p)              { return __hip_atomic_load(p, __ATOMIC_RELAXED, __HIP_MEMORY_SCOPE_AGENT); }
DI unsigned xb_add(unsigned* p, unsigned v) { return __hip_atomic_fetch_add(p, v, __ATOMIC_RELAXED, __HIP_MEMORY_SCOPE_AGENT); }
DI unsigned xb_xcc_id() { return (unsigned)__builtin_amdgcn_s_getreg((3 << 11) | 20) & 0xFu; }
#define XB_SPIN(cond, bar) do { unsigned _sp = 0; while (cond) { __builtin_amdgcn_s_sleep(1); \
    if ((++_sp & 255u) == 0u) { if (xb_ld(&(bar)[XB_TMO])) break; if (_sp > XB_SPIN_CAP) { atomicAdd(&(bar)[XB_TMO], 1u); break; } } } } while (0)
DI void xcd_barrier_complete(unsigned* bar, unsigned x, unsigned& nloc, unsigned& nx) {
    const unsigned G = gridDim.x;
    unsigned sum, cnt, mine, sp = 0u;
    for (;;) {
        sum = 0u; cnt = 0u; mine = 0u;
#pragma unroll
        for (unsigned j = 0; j < 16; ++j) { const unsigned c = xb_ld(&bar[XB_XCNT(j)]); sum += c; cnt += (c > 0u) ? 1u : 0u; mine = (j == x) ? c : mine; }
        if (sum == G) break;
        __builtin_amdgcn_s_sleep(1);
        if ((++sp & 255u) == 0u) { if (xb_ld(&bar[XB_TMO])) break; if (sp > XB_SPIN_CAP) { atomicAdd(&bar[XB_TMO], 1u); break; } }
    }
    nloc = mine > 0u ? mine : 1u; nx = cnt > 0u ? cnt : 1u;
}
DI void xcd_barrier(unsigned* bar, volatile LAS unsigned* st, bool leader) {
    asm volatile("s_waitcnt vmcnt(0)" ::: "memory");
    __syncthreads();
    if (leader) {
        const unsigned x = xb_xcc_id();
        __builtin_amdgcn_s_waitcnt(0);
        unsigned nloc = st[0], nx = st[1];
        if (nloc == 0u) { xcd_barrier_complete(bar, x, nloc, nx); st[0] = nloc; st[1] = nx; }
        const unsigned old = xb_add(&bar[XB_XSUB(x)], 1u);
        const unsigned gen = old / nloc;
        if (old + 1u == (gen + 1u) * nloc) {
            __builtin_amdgcn_fence(__ATOMIC_RELEASE, "agent");
            asm volatile("s_waitcnt vmcnt(0)" ::: "memory");
            const unsigned og = xb_add(&bar[XB_TOP], 1u);
            const unsigned tg = og / nx;
            if (og + 1u == (tg + 1u) * nx) xb_add(&bar[XB_TOPGEN], 1u);
            else XB_SPIN(xb_ld(&bar[XB_TOPGEN]) == tg, bar);
            __builtin_amdgcn_fence(__ATOMIC_ACQUIRE, "agent");
            xb_add(&bar[XB_XGEN(x)], 1u);
            asm volatile("s_waitcnt vmcnt(0)" ::: "memory");
        } else {
            XB_SPIN(xb_ld(&bar[XB_XGEN(x)]) == gen, bar);
            __builtin_amdgcn_fence(__ATOMIC_ACQUIRE, "agent");
            asm volatile("s_waitcnt vmcnt(0)" ::: "memory");
        }
    }
    __syncthreads();
}

struct Args { const float* in[22]; float* out; unsigned char* ws; int ph_lo, ph_hi; };
constexpr int PH_PER_LAYER = 11, N_PHASES = 1 + NL * PH_PER_LAYER;
constexpr int TAB_OFF = 131072 + 2048;
typedef volatile LAS unsigned long long* tab_t;
DI unsigned long long tab_get(tab_t TAB, int i) {
    const unsigned long long v = TAB[i];
    const unsigned lo = __builtin_amdgcn_readfirstlane((unsigned)v), hi = __builtin_amdgcn_readfirstlane((unsigned)(v >> 32));
    return ((unsigned long long)hi << 32) | lo;
}
#define TABF(i) ((const float*)tab_get(TAB, (i)))
#define TABWS() ((unsigned char*)tab_get(TAB, 23))
#define TABOUT() ((float*)tab_get(TAB, 22))

DI int opaque_s(int v) { asm volatile("" : "+s"(v)); return v; }
DI void conv_layer(tab_t TAB, LAS unsigned char* lds, int l, int gw, int NGW, int gt, int NGT, int wave, int lane) {
    unsigned char* ws = TABWS();
    bf16_t* Wqkv_t = (bf16_t*)(ws + W_QKV); bf16_t* Wuq_t = (bf16_t*)(ws + W_UQ); bf16_t* Wukv_t = (bf16_t*)(ws + W_UKV);
    LAS float* scr = (LAS float*)(lds + wave * 8704);
    { const float* win = TABF(5) + (size_t)l * DM * INC;
      transpose_mat(win, DM, 4000, INC, 0, nullptr, Wqkv_t, DM, scr, gw, NGW, lane);
      transpose_mat(win, DM, 4096, INC, C_G, nullptr, (bf16_t*)(ws + W_G), DM, scr, gw, NGW, lane); }
    transpose_mat(TABF(16) + (size_t)l * DM * FF, DM, FF, FF, 0, nullptr, (bf16_t*)(ws + W_FF1), DM, scr, gw, NGW, lane);
    transpose_mat(TABF(17) + (size_t)l * FF * DM, FF, DM, DM, 0, nullptr, (bf16_t*)(ws + W_FF2), FF, scr, gw, NGW, lane);
    for (int n = 0; n < 4; ++n) transpose_mat(TABF(12) + ((size_t)l * 4 + n) * 256 * DM, 256, DM, DM, 0, nullptr, (bf16_t*)(ws + W_B) + (size_t)n * DM * 256, 256, scr, gw, NGW, lane);
    transpose_mat(TABF(13) + (size_t)l * DM * DM, DM, DM, DM, 0, nullptr, (bf16_t*)(ws + W_OUT), DM, scr, gw, NGW, lane);
    transpose_mat(TABF(19) + (size_t)l * DM * DM, DM, DM, DM, 0, nullptr, (bf16_t*)(ws + W_PG), DM, scr, gw, NGW, lane);
    transpose_mat(TABF(18) + (size_t)l * 256 * DM, 256, DM, DM, 0, nullptr, (bf16_t*)(ws + W_PLE), 256, scr, gw, NGW, lane);
    transpose_mat(TABF(7) + (size_t)l * 256 * 384, 256, 384, 384, 0, TABF(6) + l * 256, Wuq_t, 256, scr, gw, NGW, lane);
    transpose_mat(TABF(9) + (size_t)l * 128 * 512, 128, 512, 512, 0, TABF(8) + l * 128, Wukv_t, 256, scr, gw, NGW, lane);
    for (int i = gt; i < 96 * DM / 2; i += NGT) ((unsigned*)(Wqkv_t + (size_t)4000 * DM))[i] = 0u;
    for (int i = gt; i < 128 * 256 / 2; i += NGT) ((unsigned*)(Wuq_t + (size_t)384 * 256))[i] = 0u;
    for (int i = gt; i < 512 * 64; i += NGT) { const int rr = i >> 6, cc = i & 63; ((unsigned*)(Wukv_t + (size_t)rr * 256 + 128))[cc] = 0u; }
    const float* pl = TABF(1) + (size_t)l * T * 256; bf16_t* PB = (bf16_t*)(ws + WS_PB);
    for (int i = gt; i < T * 256 / 8; i += NGT) {
        const f32x4 v0 = ((const f32x4*)pl)[2 * i], v1 = ((const f32x4*)pl)[2 * i + 1];
        u32x4 o; o.x = cvt_pk(v0.x, v0.y); o.y = cvt_pk(v0.z, v0.w); o.z = cvt_pk(v1.x, v1.y); o.w = cvt_pk(v1.z, v1.w);
        ((u32x4*)PB)[i] = o;
    }
}

__global__ void __launch_bounds__(512) fwd_kernel(Args a) {
    extern __shared__ __attribute__((aligned(16))) unsigned char lds_raw[];
    LAS unsigned char* lds = (LAS unsigned char*)lds_raw;
    cg::grid_group grid = cg::this_grid();
    tab_t TAB = (tab_t)(lds + TAB_OFF);
    if (threadIdx.x == 0) {
#pragma unroll
        for (int i = 0; i < 22; ++i) TAB[i] = (unsigned long long)a.in[i];
        TAB[22] = (unsigned long long)a.out; TAB[23] = (unsigned long long)a.ws;
    }
    volatile LAS unsigned* BST = (volatile LAS unsigned*)(lds + TAB_OFF + 256);
    if (threadIdx.x < 2) BST[threadIdx.x] = 0u;
    if (blockIdx.x == 0) { unsigned* bw = (unsigned*)a.ws; for (int i = threadIdx.x; i < XCD_BAR_WORDS; i += 512) bw[i] = 0u; }
    __syncthreads();
    const int ph_lo = a.ph_lo, ph_hi = a.ph_hi;
    const int wave_s = __builtin_amdgcn_readfirstlane((int)threadIdx.x >> 6);
#define TIDS int tid_ = wave_s * 64 + lane_id(); asm volatile("" : "+v"(tid_)); const int tid = tid_, lane = tid & 63, wave = __builtin_amdgcn_readfirstlane(tid >> 6); int G_ = gridDim.x, bid_ = blockIdx.x; asm volatile("" : "+s"(G_), "+s"(bid_)); const int G = G_, bid = bid_; \
             const int gw = bid * 8 + wave, NGW = G * 8; const int gt = bid * 512 + tid, NGT = G * 512; (void)lane; (void)gw; (void)NGW; (void)gt; (void)NGT; (void)wave;
#define GRIDX opaque_s((int)gridDim.x)
#define BIDX opaque_s((int)blockIdx.x)
#define PHASE(k) asm volatile("" ::: "memory"); if (ph_lo <= (k) && (k) < ph_hi)
#define SEAM0(k) do { if (ph_lo <= (k) && (k) + 1 < ph_hi) { grid.sync(); if (wave_s == 0 && lane_id() == 0) (void)xb_add(&((unsigned*)TABWS())[XB_XCNT(xb_xcc_id())], 1u); } } while (0)
#define SEAM(k) do { if (ph_lo <= (k) && (k) + 1 < ph_hi) xcd_barrier((unsigned*)TABWS(), BST, wave_s == 0 && lane_id() == 0); } while (0)

    PHASE(0) {
        TIDS
        conv_layer(TAB, lds, 0, gw, NGW, gt, NGT, wave, lane);
        unsigned char* ws = TABWS();
        float* COS = (float*)(ws + WS_ROPE); float* SIN = COS + S * 16;
        for (int i = gt; i < S * 16; i += NGT) {
            const int pos = i >> 4, f = i & 15;
            const double b4 = (f & 3) == 0 ? 1.0 : ((f & 3) == 1 ? 0.5623413251903491 : ((f & 3) == 2 ? 0.31622776601683794 : 0.1778279410038923));
            const double p10 = (f >> 2) == 0 ? 1.0 : ((f >> 2) == 1 ? 0.1 : ((f >> 2) == 2 ? 0.01 : 0.001));
            const float inv = (float)(b4 * p10);
            const float ang = (float)pos * inv;
            double rev = (double)ang * 0.15915494309189535; rev -= floor(rev);
            COS[i] = __builtin_amdgcn_cosf((float)rev); SIN[i] = __builtin_amdgcn_sinf((float)rev);
        }
        const float* rel_bias = TABF(4); float* LUTS = (float*)(ws + WS_LUTS); float* LUTD = (float*)(ws + WS_LUTD);
        for (int i = gt; i < 4 * 257; i += NGT) { const int hh = i / 257, rl = i % 257 - 128; LUTS[hh * 260 + rl + 128] = rel_bias[t5_bucket(rl) * 16 + hh] * LOG2E; }
        for (int i = gt; i < 12 * 129; i += NGT) { const int gh = i / 129, rl = i % 129 - 64, gg = gh >> 2; const int rr = gg == 0 ? 1 : (gg == 1 ? 4 : 16);
            LUTD[gh * 132 + rl + 64] = rel_bias[t5_bucket(rl * rr) * 16 + 4 + gh] * LOG2E; }
        const float* x = TABF(0); float* H = TABOUT(); bf16_t* HB = (bf16_t*)(ws + WS_HB); const float* eg = TABF(2); const float* eb = TABF(3);
        float* ST = (float*)(ws + WS_STATS); (void)H;
        for (int m = gw * 8; m < T; m += NGW * 8) ln_rows<8>(x + (size_t)m * DM, nullptr, HB + (size_t)m * DM, ST + (size_t)m * 2, eg, eb, lane);
    }
    SEAM0(0);

    for (int l = 0; l < NL; ++l) {
        const int P0 = 1 + l * PH_PER_LAYER;
        PHASE(P0 + 0) {
            unsigned char* ws = TABWS();
            pg8::Gemm g{(const bf16_t*)(ws + WS_HB), (const bf16_t*)(ws + W_QKV), DM, DM}; pg8::StaticOrder so; so.init(T, ZC, GRIDX, BIDX);
            pg8::EpiStore<0> E{(bf16_t*)(ws + WS_Z), ZC, ZC, nullptr, 0, 1.0f, lds + STG_OFF};
            pg8::gemm_phase(lds, g, so, E, wave_s);
        }
        SEAM(P0 + 0);
        PHASE(P0 + 1) {
            { TIDS
              unsigned char* ws = TABWS();
              const bf16_t* ZQ = (const bf16_t*)(ws + WS_Z); float* RSTD = (float*)(ws + WS_RSTD); bf16_t* KR = (bf16_t*)(ws + WS_KR);
              const float* COS = (const float*)(ws + WS_ROPE); const float* SIN = COS + S * 16;
              pg8::StaticOrder so; so.init(T, 512, G, bid); pg8::Unit uu;
              for (int i = 0; so.tile(i, uu); ++i) {
                  const int ch = lane & 7;
#pragma unroll 1
                  for (int it = 0; it < 4; ++it) {
                      const int m = uu.pm * 256 + wave * 32 + it * 8 + (lane >> 3);
                      const bf16_t* zr = ZQ + (size_t)m * ZC;
                      float sq = 0.f, sk = 0.f;
#pragma unroll
                      for (int j = 0; j < 4; ++j) { const u32x4 q = *(const u32x4*)(zr + C_AQ + ch * 32 + 8 * j);
                          sq += bf_lo(q.x) * bf_lo(q.x) + bf_hi(q.x) * bf_hi(q.x) + bf_lo(q.y) * bf_lo(q.y) + bf_hi(q.y) * bf_hi(q.y)
                              + bf_lo(q.z) * bf_lo(q.z) + bf_hi(q.z) * bf_hi(q.z) + bf_lo(q.w) * bf_lo(q.w) + bf_hi(q.w) * bf_hi(q.w); }
#pragma unroll
                      for (int j = 0; j < 2; ++j) { const u32x4 q = *(const u32x4*)(zr + C_AKV + ch * 16 + 8 * j);
                          sk += bf_lo(q.x) * bf_lo(q.x) + bf_hi(q.x) * bf_hi(q.x) + bf_lo(q.y) * bf_lo(q.y) + bf_hi(q.y) * bf_hi(q.y)
                              + bf_lo(q.z) * bf_lo(q.z) + bf_hi(q.z) * bf_hi(q.z) + bf_lo(q.w) * bf_lo(q.w) + bf_hi(q.w) * bf_hi(q.w); }
                      sq += shx<1>(sq); sk += shx<1>(sk); sq += shx<2>(sq); sk += shx<2>(sk); sq += shx<4>(sq); sk += shx<4>(sk);
                      if (ch == 0) { RSTD[(size_t)m * 2] = 1.0f / sqrtf(sq * (1.f / 256.f) + 1e-6f); RSTD[(size_t)m * 2 + 1] = 1.0f / sqrtf(sk * (1.f / 128.f) + 1e-6f); }
                      if (ch < 4 && uu.pn == 0) {
                          const int pos = m & (S - 1);
                          const u32x2 a1 = *(const u32x2*)(zr + C_AKR + 4 * ch), a2 = *(const u32x2*)(zr + C_AKR + 16 + 4 * ch);
                          const f32x4 c = *(const f32x4*)(COS + pos * 16 + 4 * ch), sn = *(const f32x4*)(SIN + pos * 16 + 4 * ch);
                          const float x10 = bf_lo(a1.x), x11 = bf_hi(a1.x), x12 = bf_lo(a1.y), x13 = bf_hi(a1.y), x20 = bf_lo(a2.x), x21 = bf_hi(a2.x), x22 = bf_lo(a2.y), x23 = bf_hi(a2.y);
                          u32x2 o1, o2;
                          o1.x = cvt_pk(x10 * c.x - x20 * sn.x, x11 * c.y - x21 * sn.y); o1.y = cvt_pk(x12 * c.z - x22 * sn.z, x13 * c.w - x23 * sn.w);
                          o2.x = cvt_pk(x10 * sn.x + x20 * c.x, x11 * sn.y + x21 * c.y); o2.y = cvt_pk(x12 * sn.z + x22 * c.z, x13 * sn.w + x23 * c.w);
                          *(u32x2*)(KR + (size_t)m * 32 + 4 * ch) = o1; *(u32x2*)(KR + (size_t)m * 32 + 16 + 4 * ch) = o2;
                      }
                  }
              }
              asm volatile("s_waitcnt vmcnt(0)" ::: "memory");
              __syncthreads();
            }
            asm volatile("" ::: "memory");
            { unsigned char* ws = TABWS();
              pg8::Gemm g{(const bf16_t*)(ws + WS_Z) + C_AQ, (const bf16_t*)(ws + W_UQ), ZC, 256}; pg8::StaticOrder so; so.init(T, 512, GRIDX, BIDX);
              pg8::EpiStore<0, false> E{(bf16_t*)(ws + WS_QM), 384, 384, (const float*)(ws + WS_RSTD), 2, 0.10206207261596575f * LOG2E, lds + STG_OFF};
              pg8::gemm_phase(lds, g, so, E, wave_s); }
            asm volatile("" ::: "memory");
            { unsigned char* ws = TABWS();
              pg8::Gemm g{(const bf16_t*)(ws + WS_Z) + C_AKV, (const bf16_t*)(ws + W_UKV), ZC, 256}; pg8::StaticOrder so; so.init(T, 512, GRIDX, BIDX);
              pg8::EpiStore<0> E{(bf16_t*)(ws + WS_KVM), 512, 512, (const float*)(ws + WS_RSTD) + 1, 2, 1.0f, lds + STG_OFF};
              pg8::gemm_phase(lds, g, so, E, wave_s); }
        }
        SEAM(P0 + 1);
        PHASE(P0 + 2) {
            unsigned char* ws = TABWS(); const int G = GRIDX, bid = BIDX;
            bf16_t* ZQ = (bf16_t*)(ws + WS_Z);
            AttnP AP{ZQ, (const bf16_t*)(ws + WS_QM), (const bf16_t*)(ws + WS_KVM), (const bf16_t*)(ws + WS_KR), (bf16_t*)(ws + WS_Y), ZQ, (float*)(ws + WS_LSE),
                     (const float*)(ws + WS_LUTS), (const float*)(ws + WS_LUTD), TABF(11) + (size_t)l * 4 * 465, TABF(10) + l * 4, (const float*)(ws + WS_ROPE)};
            const int xq = bid & 7, jq = bid >> 3, Gq = (G + 7 - xq) >> 3;
            for (int j = jq; j < 64; j += Gq) attn_unit<0>(lds, AP, xq * 64 + j, wave_s);
            for (int j = jq; j < 64; j += Gq) attn_unit<1>(lds, AP, xq * 64 + j, wave_s);
            for (int j = jq; j < 64; j += Gq) attn_unit<2>(lds, AP, xq * 64 + j, wave_s);
            for (int j = jq; j < 192; j += Gq) attn_unit<3>(lds, AP, xq * 192 + j, wave_s);
        }
        SEAM(P0 + 2);
        PHASE(P0 + 3) {
            TIDS
            unsigned char* ws = TABWS();
            const bf16_t* ZQ = (const bf16_t*)(ws + WS_Z); const float* LSE = (const float*)(ws + WS_LSE); bf16_t* Y = (bf16_t*)(ws + WS_Y);
            for (int i = gt; i < T * 32; i += NGT) {
                const int m = i >> 5, hh = (i >> 3) & 3, ch = i & 7;
                const float l0 = LSE[(size_t)m * 12 + hh], l1 = LSE[(size_t)m * 12 + 4 + hh], l2 = LSE[(size_t)m * 12 + 8 + hh];
                const float mx = fmaxf(l0, fmaxf(l1, l2));
                float w0 = __builtin_amdgcn_exp2f(l0 - mx), w1 = __builtin_amdgcn_exp2f(l1 - mx), w2 = __builtin_amdgcn_exp2f(l2 - mx);
                const float inv = 1.0f / (w0 + w1 + w2); w0 *= inv; w1 *= inv; w2 *= inv;
                const bf16_t* zp = ZQ + (size_t)m * ZC + C_DQ + hh * 64 + ch * 8;
                const u32x4 a0 = *(const u32x4*)zp, a1 = *(const u32x4*)(zp + 256), a2 = *(const u32x4*)(zp + 512);
                u32x4 o;
                o.x = cvt_pk(w0 * bf_lo(a0.x) + w1 * bf_lo(a1.x) + w2 * bf_lo(a2.x), w0 * bf_hi(a0.x) + w1 * bf_hi(a1.x) + w2 * bf_hi(a2.x));
                o.y = cvt_pk(w0 * bf_lo(a0.y) + w1 * bf_lo(a1.y) + w2 * bf_lo(a2.y), w0 * bf_hi(a0.y) + w1 * bf_hi(a1.y) + w2 * bf_hi(a2.y));
                o.z = cvt_pk(w0 * bf_lo(a0.z) + w1 * bf_lo(a1.z) + w2 * bf_lo(a2.z), w0 * bf_hi(a0.z) + w1 * bf_hi(a1.z) + w2 * bf_hi(a2.z));
                o.w = cvt_pk(w0 * bf_lo(a0.w) + w1 * bf_lo(a1.w) + w2 * bf_lo(a2.w), w0 * bf_hi(a0.w) + w1 * bf_hi(a1.w) + w2 * bf_hi(a2.w));
                *(u32x4*)(Y + (size_t)m * DM + 768 + hh * 64 + ch * 8) = o;
            }
        }
        SEAM(P0 + 3);
        PHASE(P0 + 4) {
            unsigned char* ws = TABWS();
            pg8::Gemm g{(const bf16_t*)(ws + WS_HB), (const bf16_t*)(ws + W_G), DM, DM}; pg8::StaticOrder so; so.init(T, ZC, GRIDX, BIDX);
            pg8::EpiStore<1> E{(bf16_t*)(ws + WS_Z), ZC, ZC, nullptr, 0, 1.0f, lds + STG_OFF};
            pg8::gemm_phase(lds, g, so, E, wave_s);
        }
        SEAM(P0 + 4);
        PHASE(P0 + 5) {
            unsigned char* ws = TABWS();
            pg8::Gemm g{(const bf16_t*)(ws + WS_Y), (const bf16_t*)(ws + W_B), DM, 256}; pg8::MergeOrder mo; mo.s.init(T, DM, GRIDX, BIDX);
            pg8::EpiMerge E{(bf16_t*)(ws + WS_MG), (const bf16_t*)(ws + WS_Z)};
            pg8::gemm_phase(lds, g, mo, E, wave_s);
        }
        SEAM(P0 + 5);
        PHASE(P0 + 6) {
            unsigned char* ws = TABWS();
            pg8::Gemm g{(const bf16_t*)(ws + WS_MG), (const bf16_t*)(ws + W_OUT), DM, DM}; pg8::StaticOrder so; so.init(T, DM, GRIDX, BIDX);
            float* Hout = TABOUT();
            pg8::EpiResid<false> E{l == 0 ? TABF(0) : (const float*)Hout, Hout, nullptr, (const float*)(ws + WS_STATS), l == 0 ? TABF(2) : TABF(20) + (l - 1) * DM, l == 0 ? TABF(3) : TABF(21) + (l - 1) * DM};
            pg8::gemm_phase(lds, g, so, E, wave_s);
        }
        SEAM(P0 + 6);
        PHASE(P0 + 7) {
            TIDS
            unsigned char* ws = TABWS(); float* H = TABOUT(); bf16_t* HB = (bf16_t*)(ws + WS_HB); const float* gg = TABF(14) + l * DM; const float* bb = TABF(15) + l * DM;
            float* ST = (float*)(ws + WS_STATS);
            for (int m = gw * 8; m < T; m += NGW * 8) ln_rows<8>(H + (size_t)m * DM, nullptr, HB + (size_t)m * DM, ST + (size_t)m * 2, gg, bb, lane);
        }
        SEAM(P0 + 7);
        PHASE(P0 + 8) {
            { unsigned char* ws = TABWS();
              pg8::Gemm g{(const bf16_t*)(ws + WS_HB), (const bf16_t*)(ws + W_FF1), DM, DM}; pg8::StaticOrder so; so.init(T, FF, GRIDX, BIDX);
              pg8::EpiStore<2> E{(bf16_t*)(ws + WS_Z), FF, FF, nullptr, 0, 1.0f, lds + STG_OFF};
              pg8::gemm_phase(lds, g, so, E, wave_s); }
            asm volatile("" ::: "memory");
            { unsigned char* ws = TABWS();
              pg8::Gemm g{(const bf16_t*)(ws + WS_HB), (const bf16_t*)(ws + W_PG), DM, DM}; pg8::StaticOrder so; so.init(T, DM, GRIDX, BIDX);
              pg8::EpiStore<1> E{(bf16_t*)(ws + WS_Y), DM, DM, nullptr, 0, 1.0f, lds + STG_OFF};
              pg8::gemm_phase(lds, g, so, E, wave_s); }
            asm volatile("" ::: "memory");
            { unsigned char* ws = TABWS();
              pg8::Gemm g{(const bf16_t*)(ws + WS_PB), (const bf16_t*)(ws + W_PLE), 256, 256}; pg8::StaticOrder so; so.init(T, DM, GRIDX, BIDX);
              pg8::EpiMulInto E{(bf16_t*)(ws + WS_Y)};
              pg8::gemm_phase(lds, g, so, E, wave_s); }
        }
        SEAM(P0 + 8);
        PHASE(P0 + 9) {
            unsigned char* ws = TABWS();
            pg8::Gemm g{(const bf16_t*)(ws + WS_Z), (const bf16_t*)(ws + W_FF2), FF, FF}; pg8::StaticOrder so; so.init(T, DM, GRIDX, BIDX);
            float* Hout = TABOUT();
            pg8::EpiResid<true> E{(const float*)Hout, Hout, (const bf16_t*)(ws + WS_Y), (const float*)(ws + WS_STATS), TABF(14) + l * DM, TABF(15) + l * DM};
            pg8::gemm_phase(lds, g, so, E, wave_s);
        }
        SEAM(P0 + 9);
        PHASE(P0 + 10) {
            TIDS
            unsigned char* ws = TABWS(); float* H = TABOUT(); bf16_t* HB = (bf16_t*)(ws + WS_HB); const float* gg = TABF(20) + l * DM; const float* bb = TABF(21) + l * DM;
            float* ST = (float*)(ws + WS_STATS);
            if (l + 1 < NL) { for (int m = gw * 8; m < T; m += NGW * 8) ln_rows<8>(H + (size_t)m * DM, nullptr, HB + (size_t)m * DM, ST + (size_t)m * 2, gg, bb, lane); }
            else { for (int m = gw * 8; m < T; m += NGW * 8) ln_rows<8>(H + (size_t)m * DM, H + (size_t)m * DM, nullptr, nullptr, gg, bb, lane); }
            if (l + 1 < NL) conv_layer(TAB, lds, l + 1, gw, NGW, gt, NGT, wave, lane);
        }
        if (l + 1 < NL) SEAM(P0 + 10);
    }
}

extern "C" void kernel_launch(void* const* d_in, const int* in_sizes, int n_in, void* d_out, int out_size, void* d_ws, size_t ws_size, hipStream_t stream) {
    static int grid = 0;
    if (grid == 0) {
        if (n_in != 22 || out_size != T * DM || ws_size < WS_END) { fprintf(stderr, "kernel_launch: unexpected shapes (n_in %d out %d ws %zu)\n", n_in, out_size, ws_size); grid = -1; return; }
        int dev = 0, cus = 0, per = 0;
        (void)hipGetDevice(&dev); (void)hipDeviceGetAttribute(&cus, hipDeviceAttributeMultiprocessorCount, dev);
        (void)hipFuncSetAttribute((const void*)fwd_kernel, hipFuncAttributeMaxDynamicSharedMemorySize, LDS_BYTES);
        (void)hipOccupancyMaxActiveBlocksPerMultiprocessor(&per, (const void*)fwd_kernel, 512, LDS_BYTES);
        if (per < 1) per = 1;
        grid = cus * per;
        fprintf(stderr, "kernel_launch: grid %d (cus %d x %d)\n", grid, cus, per);
    }
    if (grid < 0) return;
    Args a{};
    for (int i = 0; i < 22; ++i) a.in[i] = (const float*)d_in[i];
    a.out = (float*)d_out; a.ws = (unsigned char*)d_ws;
#if N_LAUNCH_MODE == 1
    a.ph_lo = 0; a.ph_hi = N_PHASES;
    void* args[] = {&a};
    hipError_t e = hipLaunchCooperativeKernel((void*)fwd_kernel, dim3(grid), dim3(512), args, LDS_BYTES, stream);
    if (e != hipSuccess) fprintf(stderr, "cooperative launch failed: %s (grid %d)\n", hipGetErrorString(e), grid);
#else
    for (int k = 0; k < N_PHASES; ++k) { a.ph_lo = k; a.ph_hi = k + 1; hipLaunchKernelGGL(fwd_kernel, dim3(grid), dim3(512), LDS_BYTES, stream, a); }
#endif
}
```

```cpp
#include <hip/hip_runtime.h>
#include <hip/hip_cooperative_groups.h>
#include <cstdio>
#include <cstdint>
namespace cg = cooperative_groups;

#define LAS __attribute__((address_space(3)))
#define DI __device__ __forceinline__
typedef unsigned short bf16_t;
typedef short bf16x8 __attribute__((ext_vector_type(8)));
typedef short s16x4 __attribute__((ext_vector_type(4)));
typedef float f32x4 __attribute__((ext_vector_type(4)));
typedef float f32x2 __attribute__((ext_vector_type(2)));
typedef float f32x16 __attribute__((ext_vector_type(16)));
typedef unsigned u32x4 __attribute__((ext_vector_type(4)));
typedef unsigned u32x2 __attribute__((ext_vector_type(2)));
typedef __bf16 bf16x2_t __attribute__((ext_vector_type(2)));

#ifndef N_LAUNCH_MODE
#define N_LAUNCH_MODE 1
#endif

constexpr int T = 32768, S = 8192, DM = 1024, FF = 4096, INC = 8096, ZC = 4096, NL = 2;
constexpr int C_AQ = 0, C_AKV = 256, C_AKR = 384, C_BQ = 416, C_BK = 672, C_BV = 800, C_CQ = 928, C_CK = 1184, C_CV = 1440,
              C_DQ = 1696, C_DK = 2464, C_DV = 3232, C_G = 4000;
constexpr float LOG2E = 1.4426950408889634f;
constexpr float ALPHA = 1.4142135623730951f;

constexpr size_t MiB = 1u << 20;
constexpr size_t WS_RSTD = 64 * 1024, WS_LUTS = 320 * 1024, WS_LUTD = 328 * 1024, WS_LSE = 512 * 1024;
constexpr size_t WS_W = 2 * MiB;
constexpr size_t W_QKV = WS_W, W_G = WS_W + 8 * MiB, W_FF1 = WS_W + 16 * MiB, W_FF2 = WS_W + 24 * MiB, W_B = WS_W + 32 * MiB, W_OUT = WS_W + 34 * MiB,
                 W_PG = WS_W + 36 * MiB, W_PLE = WS_W + 38 * MiB, W_UQ = WS_W + 38 * MiB + 512 * 1024, W_UKV = WS_W + 38 * MiB + 768 * 1024;
constexpr size_t WS_ROPE = 41 * MiB, WS_PB = 42 * MiB, WS_HB = 58 * MiB, WS_Z = 122 * MiB, WS_Y = 378 * MiB, WS_M = 442 * MiB;
constexpr size_t WS_QM = WS_M, WS_KVM = WS_M + 24 * MiB, WS_KR = WS_M + 56 * MiB, WS_MG = WS_M;
constexpr size_t WS_STATS = 506 * MiB;
constexpr size_t WS_END = 512 * MiB;

constexpr int LDS_BYTES = 135168;

DI unsigned cvt_pk(float lo, float hi) { f32x2 v = {lo, hi}; bf16x2_t b = __builtin_convertvector(v, bf16x2_t); return __builtin_bit_cast(unsigned, b); }
DI float bf_lo(unsigned u) { return __uint_as_float(u << 16); }
DI float bf_hi(unsigned u) { return __uint_as_float(u & 0xffff0000u); }
DI float xhalf_max(float m) { auto rr = __builtin_amdgcn_permlane32_swap(__float_as_uint(m), __float_as_uint(m), false, false); return fmaxf(__uint_as_float(rr[0]), __uint_as_float(rr[1])); }
DI float xhalf_sum(float m) { auto rr = __builtin_amdgcn_permlane32_swap(__float_as_uint(m), __float_as_uint(m), false, false); return __uint_as_float(rr[0]) + __uint_as_float(rr[1]); }
template <int O> DI float shx(float v) { return __int_as_float(__builtin_amdgcn_ds_swizzle(__float_as_int(v), (O << 10) | 0x1f)); }
DI float wave_sum(float v) {
    v += shx<1>(v); v += shx<2>(v); v += shx<4>(v); v += shx<8>(v); v += shx<16>(v); v = xhalf_sum(v);
    return v;
}
DI float sigmoid_f(float x) { return __builtin_amdgcn_rcpf(1.0f + __builtin_amdgcn_exp2f(-x * LOG2E)); }
DI int lane_id() { int l; asm volatile("v_mbcnt_lo_u32_b32 %0, -1, 0\n\tv_mbcnt_hi_u32_b32 %0, -1, %0" : "=v"(l)); return l; }
DI int crow(int r, int hi) { return (r & 3) + 8 * (r >> 2) + 4 * hi; }

namespace pg8 {
constexpr int BM = 256, BK = 64, HALF = 128, HTB = HALF * BK * 2, STAGE_BYTES = 8 * HTB, NXCD = 8, WGM = 8;
DI int lds_byte(int r, int c) { const int st = (r >> 4) * 2 + (c >> 5), rr = r & 15, cc = c & 31, ob = rr * 64 + cc * 2; return st * 1024 + (ob ^ (((ob >> 9) & 1) << 5)); }
DI void stage_rc(int b, int& R, int& C) { const int st = b / 1024, sb = b % 1024, swz = sb ^ (((sb >> 9) & 1) << 5); R = (st >> 1) * 16 + swz / 64; C = (st & 1) * 32 + (swz % 64) / 2; }
DI int perm32(int rho) { const int n = rho >> 4, i = rho & 15; return 8 * (i >> 2) + 4 * n + (i & 3); }

struct Unit { int pm, pn, z; };
struct Gemm { const bf16_t* A; const bf16_t* Bt; int lda; int K; };

struct StaticOrder {
    int nM, nN, nwg, G, c;
    DI void init(int M, int N, int G_, int c_) { nM = M / BM; nN = N / BM; nwg = nM * nN; G = G_; c = c_; }
    DI bool tile(int i, Unit& u) const {
        const long L = (long)i * G + c; if (L >= nwg) return false;
        int wgid = (int)L; { const int q = nwg / NXCD, r = nwg % NXCD, xcd = wgid % NXCD, off = wgid / NXCD; wgid = (xcd < r ? xcd * (q + 1) : r * (q + 1) + (xcd - r) * q) + off; }
        const int nig = WGM * nN, gid = wgid / nig, fm = gid * WGM, gsz = (nM - fm) < WGM ? (nM - fm) : WGM;
        u.pm = fm + ((wgid % nig) % gsz); u.pn = (wgid % nig) / gsz; u.z = 0; return true;
    }
    DI bool next(int i, Unit& u) const { return tile(i, u); }
    DI size_t aoff(const Unit& u, const Gemm& g) const { return (size_t)u.pm * BM * g.lda * 2; }
    DI size_t boff(const Unit& u, const Gemm& g) const { return (size_t)u.pn * BM * g.K * 2; }
};
struct MergeOrder {
    StaticOrder s;
    DI bool next(int i, Unit& u) const { if (!s.tile(i >> 2, u)) return false; u.z = i & 3; return true; }
    DI size_t aoff(const Unit& u, const Gemm& g) const { return (size_t)u.pm * BM * g.lda * 2 + (size_t)u.z * 256 * 2; }
    DI size_t boff(const Unit& u, const Gemm& g) const { return (size_t)(u.z * 4 + u.pn) * BM * g.K * 2; }
};

#define EPI_ROWS_BEGIN \
    _Pragma("unroll") for (int ai = 0; ai < 2; ++ai) _Pragma("unroll") for (int m = 0; m < 4; ++m) { const int row = u.pm * BM + ai * HALF + wr * 64 + m * 16 + fr;
#define EPI_COLS_BEGIN \
    _Pragma("unroll") for (int bj = 0; bj < 2; ++bj) { const int col = u.pn * BM + bj * HALF + wc * 32 + 8 * fq; f32x4 v0 = acc[ai][bj][m][0], v1 = acc[ai][bj][m][1];
#define EPI_END } asm volatile("" ::: "memory"); }

template <int ACT  > struct EpiStore {
    bf16_t* O; int ldc; int ncv; const float* rs; int rss; float cmul;
    DI void operator()(const f32x4 (&acc)[2][2][4][2], const Unit& u, int wr, int wc, int fr, int fq) const {
        float scv[2][4];
#pragma unroll
        for (int ai = 0; ai < 2; ++ai)
#pragma unroll
            for (int m = 0; m < 4; ++m) scv[ai][m] = rs ? rs[(size_t)(u.pm * BM + ai * HALF + wr * 64 + m * 16 + fr) * rss] * cmul : 1.0f;
        EPI_ROWS_BEGIN
            const float sc = scv[ai][m]; bf16_t* rowp = O + (size_t)row * ldc;
            EPI_COLS_BEGIN
                if (col < ncv) {
                    v0 = v0 * sc; v1 = v1 * sc;
                    if (ACT == 1) {
#pragma unroll
                        for (int j = 0; j < 4; ++j) { v0[j] = sigmoid_f(v0[j]); v1[j] = sigmoid_f(v1[j]); }
                    }
                    if (ACT == 2) {
#pragma unroll
                        for (int j = 0; j < 4; ++j) { const float a = fmaxf(v0[j], 0.f), b = fmaxf(v1[j], 0.f); v0[j] = a * a; v1[j] = b * b; }
                    }
                    u32x4 w; w.x = cvt_pk(v0[0], v0[1]); w.y = cvt_pk(v0[2], v0[3]); w.z = cvt_pk(v1[0], v1[1]); w.w = cvt_pk(v1[2], v1[3]);
                    *(u32x4*)(rowp + col) = w;
                }
            }
            asm volatile("" ::: "memory");
        }
    }
};
#define EPI_ROW(ai, m) (u.pm * BM + (ai) * HALF + wr * 64 + (m) * 16 + fr)
#define EPI_COL(bj) (u.pn * BM + (bj) * HALF + wc * 32 + 8 * fq)
DI void mul_bf8(f32x4& v0, f32x4& v1, const u32x4 g) {
    v0[0] *= bf_lo(g.x); v0[1] *= bf_hi(g.x); v0[2] *= bf_lo(g.y); v0[3] *= bf_hi(g.y); v1[0] *= bf_lo(g.z); v1[1] *= bf_hi(g.z); v1[2] *= bf_lo(g.w); v1[3] *= bf_hi(g.w); }
DI void add_bf8(f32x4& v0, f32x4& v1, const u32x4 g) {
    v0[0] += bf_lo(g.x); v0[1] += bf_hi(g.x); v0[2] += bf_lo(g.y); v0[3] += bf_hi(g.y); v1[0] += bf_lo(g.z); v1[1] += bf_hi(g.z); v1[2] += bf_lo(g.w); v1[3] += bf_hi(g.w); }
DI u32x4 pack_bf8(const f32x4 v0, const f32x4 v1) { u32x4 w; w.x = cvt_pk(v0[0], v0[1]); w.y = cvt_pk(v0[2], v0[3]); w.z = cvt_pk(v1[0], v1[1]); w.w = cvt_pk(v1[2], v1[3]); return w; }
struct EpiMerge {
    bf16_t* MG; const bf16_t* GT;
    DI void operator()(const f32x4 (&acc)[2][2][4][2], const Unit& u, int wr, int wc, int fr, int fq) const {
#pragma unroll
        for (int ai = 0; ai < 2; ++ai)
#pragma unroll
            for (int mh = 0; mh < 2; ++mh) {
                u32x4 gv[2][2], ov[2][2];
#pragma unroll
                for (int mm = 0; mm < 2; ++mm)
#pragma unroll
                    for (int bj = 0; bj < 2; ++bj) {
                        const size_t row = EPI_ROW(ai, 2 * mh + mm); const int col = EPI_COL(bj);
                        gv[mm][bj] = *(const u32x4*)(GT + row * ZC + u.z * DM + col);
                        if (u.z != 0) ov[mm][bj] = *(const u32x4*)(MG + row * DM + col);
                    }
#pragma unroll
                for (int mm = 0; mm < 2; ++mm)
#pragma unroll
                    for (int bj = 0; bj < 2; ++bj) {
                        const size_t row = EPI_ROW(ai, 2 * mh + mm); const int col = EPI_COL(bj);
                        f32x4 v0 = acc[ai][bj][2 * mh + mm][0], v1 = acc[ai][bj][2 * mh + mm][1];
                        mul_bf8(v0, v1, gv[mm][bj]);
                        if (u.z != 0) add_bf8(v0, v1, ov[mm][bj]);
                        *(u32x4*)(MG + row * DM + col) = pack_bf8(v0, v1);
                    }
                asm volatile("" ::: "memory");
            }
    }
};
template <bool EXTRA> struct EpiResid {
    const float* Xin; float* Xout; const bf16_t* E; const float* stats; const float* gam; const float* bet;
    DI void operator()(const f32x4 (&acc)[2][2][4][2], const Unit& u, int wr, int wc, int fr, int fq) const {
        f32x4 g0[2], g1[2], b0[2], b1[2];
#pragma unroll
        for (int bj = 0; bj < 2; ++bj) { const int col = EPI_COL(bj);
            g0[bj] = *(const f32x4*)(gam + col) * ALPHA; g1[bj] = *(const f32x4*)(gam + col + 4) * ALPHA;
            b0[bj] = *(const f32x4*)(bet + col) * ALPHA; b1[bj] = *(const f32x4*)(bet + col + 4) * ALPHA; }
#pragma unroll
        for (int ai = 0; ai < 2; ++ai)
#pragma unroll
            for (int mh = 0; mh < 2; ++mh) {
                f32x4 x0[2][2], x1[2][2]; u32x4 ev[2][2]; f32x2 st[2];
#pragma unroll
                for (int mm = 0; mm < 2; ++mm) {
                    const size_t row = EPI_ROW(ai, 2 * mh + mm);
                    st[mm] = *(const f32x2*)(stats + row * 2);
#pragma unroll
                    for (int bj = 0; bj < 2; ++bj) {
                        const int col = EPI_COL(bj);
                        x0[mm][bj] = *(const f32x4*)(Xin + row * DM + col); x1[mm][bj] = *(const f32x4*)(Xin + row * DM + col + 4);
                        if (EXTRA) ev[mm][bj] = *(const u32x4*)(E + row * DM + col);
                    }
                }
#pragma unroll
                for (int mm = 0; mm < 2; ++mm)
#pragma unroll
                    for (int bj = 0; bj < 2; ++bj) {
                        const size_t row = EPI_ROW(ai, 2 * mh + mm); const int col = EPI_COL(bj);
                        const float mean = st[mm].x, rstd = st[mm].y;
                        f32x4 v0 = acc[ai][bj][2 * mh + mm][0] + ((x0[mm][bj] - mean) * rstd) * g0[bj] + b0[bj];
                        f32x4 v1 = acc[ai][bj][2 * mh + mm][1] + ((x1[mm][bj] - mean) * rstd) * g1[bj] + b1[bj];
                        if (EXTRA) add_bf8(v0, v1, ev[mm][bj]);
                        *(f32x4*)(Xout + row * DM + col) = v0; *(f32x4*)(Xout + row * DM + col + 4) = v1;
                    }
                asm volatile("" ::: "memory");
            }
    }
};
struct EpiMulInto {
    bf16_t* P;
    DI void operator()(const f32x4 (&acc)[2][2][4][2], const Unit& u, int wr, int wc, int fr, int fq) const {
#pragma unroll
        for (int ai = 0; ai < 2; ++ai) {
            u32x4 gv[4][2];
#pragma unroll
            for (int m = 0; m < 4; ++m)
#pragma unroll
                for (int bj = 0; bj < 2; ++bj) gv[m][bj] = *(const u32x4*)(P + (size_t)EPI_ROW(ai, m) * DM + EPI_COL(bj));
#pragma unroll
            for (int m = 0; m < 4; ++m)
#pragma unroll
                for (int bj = 0; bj < 2; ++bj) {
                    f32x4 v0 = acc[ai][bj][m][0], v1 = acc[ai][bj][m][1];
                    mul_bf8(v0, v1, gv[m][bj]);
                    *(u32x4*)(P + (size_t)EPI_ROW(ai, m) * DM + EPI_COL(bj)) = pack_bf8(v0, v1);
                }
            asm volatile("" ::: "memory");
        }
    }
};

template <class Epi, class Sched>
DI void gemm_phase(LAS unsigned char* lds, const Gemm g, const Sched& S_, const Epi& E, const int wave_s) {
    int tid_ = wave_s * 64 + lane_id(); asm volatile("" : "+v"(tid_));
    const int tid = tid_, wid = __builtin_amdgcn_readfirstlane(tid >> 6), lane = tid & 63, wr = wid >> 2, wc = wid & 3, fr = lane & 15, fq = lane >> 4;
    const int K = g.K, nt = K / BK;
    unsigned voffA[2], voffB[2];
#pragma unroll
    for (int i = 0; i < 2; ++i) { int R, C; stage_rc(tid * 16 + i * 8192, R, C); const int Rb = (R & ~31) + perm32(R & 31);
        voffA[i] = (unsigned)(R * g.lda + C) * 2u; voffB[i] = (unsigned)(Rb * K + C) * 2u; }
    const size_t kstep = (size_t)(BK * 2);
    const size_t hstepA = (size_t)HALF * g.lda * 2, hstepB = (size_t)HALF * K * 2;
    const unsigned ldsw = (unsigned)wid * 1024u;
    const int aoff = lds_byte(wr * 64 + fr, fq * 8), boff = lds_byte(wc * 32 + fr, fq * 8);
#define PG8_SA(b, h) (((b) * 2 + (h)) * HTB)
#define PG8_SB(b, h) ((4 + (b) * 2 + (h)) * HTB)
#define PG8_STAGE(bufoff, gbase, voff) do { _Pragma("unroll") for (int _i = 0; _i < 2; ++_i) \
        __builtin_amdgcn_global_load_lds((const unsigned*)((const char*)(gbase) + (voff)[_i]), (LAS unsigned*)(lds + (bufoff) + ldsw + _i * 8192), 16, 0, 0); } while (0)
#define PG8_LDA(dst, b, h) do { _Pragma("unroll") for (int m = 0; m < 4; ++m) _Pragma("unroll") for (int k = 0; k < 2; ++k) dst[m][k] = *(const LAS bf16x8*)(lds + PG8_SA(b, h) + aoff + m * 2048 + k * 1024); } while (0)
#define PG8_LDB(dst, b, h) do { _Pragma("unroll") for (int n = 0; n < 2; ++n) _Pragma("unroll") for (int k = 0; k < 2; ++k) dst[n][k] = *(const LAS bf16x8*)(lds + PG8_SB(b, h) + boff + n * 2048 + k * 1024); } while (0)
#define PG8_MMA(ai, bj, At, Bt) do { __builtin_amdgcn_s_setprio(1); _Pragma("unroll") for (int m = 0; m < 4; ++m) _Pragma("unroll") for (int n = 0; n < 2; ++n) _Pragma("unroll") for (int k = 0; k < 2; ++k) \
        acc[ai][bj][m][n] = __builtin_amdgcn_mfma_f32_16x16x32_bf16(Bt[n][k], At[m][k], acc[ai][bj][m][n], 0, 0, 0); __builtin_amdgcn_s_setprio(0); } while (0)
#define PG8_WAIT_V(n) asm volatile("s_waitcnt vmcnt(" #n ")" ::: "memory")
#define PG8_WAIT_L(n) asm volatile("s_waitcnt lgkmcnt(" #n ")" ::: "memory")
#define PG8_BAR __builtin_amdgcn_s_barrier()
#define PG8_SCHED __builtin_amdgcn_sched_barrier(0)
    Unit cur, nxt; int ui = 0;
    if (!S_.next(0, cur)) return;
    f32x4 acc[2][2][4][2];
#pragma unroll
    for (int a = 0; a < 2; ++a)
#pragma unroll
        for (int b = 0; b < 2; ++b)
#pragma unroll
            for (int m = 0; m < 4; ++m)
#pragma unroll
                for (int n = 0; n < 2; ++n) acc[a][b][m][n] = (f32x4){0.f, 0.f, 0.f, 0.f};
    bf16x8 At[4][2], B0[2][2], B1[2][2];
    const char* cA = (const char*)g.A + S_.aoff(cur, g); const char* cB = (const char*)g.Bt + S_.boff(cur, g);
    PG8_STAGE(PG8_SB(0, 0), cB, voffB); PG8_STAGE(PG8_SB(0, 1), cB + hstepB, voffB); PG8_STAGE(PG8_SA(0, 0), cA, voffA); PG8_STAGE(PG8_SA(0, 1), cA + hstepA, voffA);
    if (wr == 1) PG8_BAR;
    PG8_WAIT_V(2); PG8_BAR;
    PG8_STAGE(PG8_SB(1, 0), cB + kstep, voffB); PG8_STAGE(PG8_SA(1, 0), cA + kstep, voffA); PG8_STAGE(PG8_SB(1, 1), cB + hstepB + kstep, voffB);
    PG8_WAIT_V(6); PG8_BAR;
    for (;;) {
        const bool has_next = S_.next(ui + 1, nxt);
        const char* nA = has_next ? (const char*)g.A + S_.aoff(nxt, g) : cA; const char* nB = has_next ? (const char*)g.Bt + S_.boff(nxt, g) : cB;
        for (int t = 0; t < nt; t += 2) {
            const bool last = (t == nt - 2);
            const char* a1 = cA + (size_t)(t + 1) * kstep;
            const char* a2 = last ? nA : cA + (size_t)(t + 2) * kstep; const char* b2 = last ? nB : cB + (size_t)(t + 2) * kstep;
            const char* a3 = a2 + kstep; const char* b3 = b2 + kstep;
            PG8_LDB(B0, 0, 0); PG8_LDB(B1, 0, 1); PG8_SCHED; PG8_LDA(At, 0, 0); PG8_STAGE(PG8_SA(1, 1), a1 + hstepA, voffA);
            PG8_WAIT_V(8); PG8_WAIT_L(0); PG8_BAR; PG8_MMA(0, 0, At, B0); PG8_MMA(0, 1, At, B1); PG8_BAR; PG8_SCHED;
            PG8_LDA(At, 0, 1); PG8_STAGE(PG8_SB(0, 0), b2, voffB); PG8_STAGE(PG8_SB(0, 1), b2 + hstepB, voffB); PG8_STAGE(PG8_SA(0, 0), a2, voffA);
            PG8_WAIT_V(8); PG8_WAIT_L(0); PG8_BAR; PG8_MMA(1, 0, At, B0); PG8_MMA(1, 1, At, B1); PG8_BAR; PG8_SCHED;
            PG8_LDB(B0, 1, 0); PG8_LDB(B1, 1, 1); PG8_SCHED; PG8_LDA(At, 1, 0); PG8_STAGE(PG8_SA(0, 1), a2 + hstepA, voffA);
            PG8_WAIT_V(8); PG8_WAIT_L(0); PG8_BAR; PG8_MMA(0, 0, At, B0); PG8_MMA(0, 1, At, B1); PG8_BAR; PG8_SCHED;
            PG8_LDA(At, 1, 1); PG8_STAGE(PG8_SB(1, 0), b3, voffB); PG8_STAGE(PG8_SB(1, 1), b3 + hstepB, voffB); PG8_STAGE(PG8_SA(1, 0), a3, voffA);
            PG8_WAIT_V(8); PG8_WAIT_L(0); PG8_BAR; PG8_MMA(1, 0, At, B0); PG8_MMA(1, 1, At, B1); PG8_BAR; PG8_SCHED;
        }
        if (wr == 0) PG8_BAR;
        { const int l2 = lane_id(); E(acc, cur, wr, wc, l2 & 15, l2 >> 4); }
        if (!has_next) break;
#pragma unroll
        for (int a = 0; a < 2; ++a)
#pragma unroll
            for (int b = 0; b < 2; ++b)
#pragma unroll
                for (int m = 0; m < 4; ++m)
#pragma unroll
                    for (int n = 0; n < 2; ++n) acc[a][b][m][n] = (f32x4){0.f, 0.f, 0.f, 0.f};
        cur = nxt; cA = nA; cB = nB; ++ui;
        if (wr == 1) PG8_BAR;
    }
    PG8_WAIT_V(0);
    PG8_BAR;
#undef PG8_SA
#undef PG8_SB
#undef PG8_STAGE
#undef PG8_LDA
#undef PG8_LDB
#undef PG8_MMA
#undef PG8_WAIT_V
#undef PG8_WAIT_L
#undef PG8_BAR
#undef PG8_SCHED
}
}

struct AttnP {
    const bf16_t* ZQ; const bf16_t* QM; const bf16_t* KVM; const bf16_t* KR; bf16_t* Y; bf16_t* ZQw; float* LSE;
    const float* LUTS; const float* LUTD; const float* rpb; const float* sink; const float* COS;
};
constexpr int A_VP = 144, A_LUT = 114688, A_WSF = A_LUT + 2048, A_END = A_WSF + 2048;

template <int VAR> DI void attn_unit(LAS unsigned char* lds, const AttnP& P, const int u, const int wave_s) {
    constexpr int NKS = (VAR == 0) ? 6 : 4, QB = 1, QPW = 32 * QB;
    constexpr int A_TK = (VAR == 0) ? 128 : (VAR == 1 ? 256 : 384), NBUF = (VAR == 0) ? 2 : 1, A_KP = (VAR == 0) ? 208 : 144, NLD = A_TK / 64;
    constexpr int A_KB = 0, A_VB = NBUF * A_TK * A_KP;
    static_assert(A_VB + NBUF * A_TK * A_VP <= A_LUT, "attention tiles vs LDS map");
    int tid_ = wave_s * 64 + lane_id(); asm volatile("" : "+v"(tid_));
    const int tid = tid_, lane = tid & 63, r32 = lane & 31, hi = lane >> 5, w = __builtin_amdgcn_readfirstlane(tid >> 6);
    LAS float* LUT = (LAS float*)(lds + A_LUT);
    LAS float* WSF = (LAS float*)(lds + A_WSF) + w * 64;
    int b, h, qt, g = 0, r = 1, res = 0, L = S, j0 = 0;
    if (VAR == 0) { qt = u & 31; h = (u >> 5) & 3; b = u >> 7; j0 = 256 * qt; }
    else if (VAR == 3) { qt = u & 31; h = (u >> 5) & 3; b = u / 384; g = (u >> 7) % 3; r = (g == 0) ? 1 : (g == 1 ? 4 : 16); L = S / r; const int tpr = 32 / r; res = qt / tpr; j0 = 256 * (qt % tpr); }
    else { qt = u & 31; h = (u >> 5) & 3; b = u >> 7; j0 = 256 * qt; }
    const size_t tb = (size_t)b * S;
    const int qw = j0 + QPW * w;
    if (VAR == 1) { for (int i = tid; i < 257; i += 512) LUT[i] = P.LUTS[h * 260 + i]; }
    if (VAR == 2) { for (int i = tid; i < 465; i += 512) LUT[i] = P.rpb[h * 465 + i] * LOG2E; }
    if (VAR == 3) { for (int i = tid; i < 129; i += 512) LUT[i] = P.LUTD[(g * 4 + h) * 132 + i]; }
    bf16x8 qf[QB][NKS];
#pragma unroll
    for (int qb = 0; qb < QB; ++qb) {
        const int qi = qw + 32 * qb + r32;
        const bf16_t* qp;
        if (VAR == 0) qp = P.QM + (tb + qi) * 384 + h * 96;
        else if (VAR == 1) qp = P.ZQ + (tb + qi) * ZC + C_BQ + h * 64;
        else if (VAR == 2) qp = P.ZQ + (tb + qi) * ZC + C_CQ + h * 64;
        else qp = P.ZQ + (tb + res + (size_t)r * qi) * ZC + C_DQ + g * 256 + h * 64;
#pragma unroll
        for (int ks = 0; ks < NKS; ++ks) qf[qb][ks] = *(const bf16x8*)(qp + 16 * ks + 8 * hi);
        if (VAR == 0) {
            const float* cp = P.COS + qi * 16 + 8 * hi; const float* sp = cp + S * 16;
            const f32x4 c0 = *(const f32x4*)cp, c1 = *(const f32x4*)(cp + 4), s0 = *(const f32x4*)sp, s1 = *(const f32x4*)(sp + 4);
            const u32x4 a4 = __builtin_bit_cast(u32x4, qf[qb][4]), a5 = __builtin_bit_cast(u32x4, qf[qb][5]);
            u32x4 o4, o5;
#define ROPE2(k, ca, cb, sa, sb) { const float x1l = bf_lo(a4[k]), x1h = bf_hi(a4[k]), x2l = bf_lo(a5[k]), x2h = bf_hi(a5[k]); \
                o4[k] = cvt_pk(x1l * ca - x2l * sa, x1h * cb - x2h * sb); o5[k] = cvt_pk(x1l * sa + x2l * ca, x1h * sb + x2h * cb); }
            ROPE2(0, c0[0], c0[1], s0[0], s0[1]) ROPE2(1, c0[2], c0[3], s0[2], s0[3]) ROPE2(2, c1[0], c1[1], s1[0], s1[1]) ROPE2(3, c1[2], c1[3], s1[2], s1[3])
#undef ROPE2
            qf[qb][4] = __builtin_bit_cast(bf16x8, o4); qf[qb][5] = __builtin_bit_cast(bf16x8, o5);
        }
    }
    int NT, kfirst;
    if (VAR == 0) { NT = S / A_TK; kfirst = 0; }
    else if (VAR == 1) { NT = 2; kfirst = j0 - 128; }
    else if (VAR == 2) { const int f = min(max(4 * qt - 4, 0), 120); NT = 2; kfirst = 64 * f; }
    else { NT = 1; kfirst = j0 - 64; }
    float m_run[QB], l_run[QB];
    f32x16 o[QB][2];
#pragma unroll
    for (int qb = 0; qb < QB; ++qb) {
        m_run[qb] = (VAR == 0) ? 0.f : -1e30f; l_run[qb] = 0.f;
        if (VAR == 1) { m_run[qb] = P.sink[h] * LOG2E; l_run[qb] = (hi == 0) ? 1.0f : 0.0f; }
#pragma unroll
        for (int i = 0; i < 16; ++i) { o[qb][0][i] = 0.f; o[qb][1][i] = 0.f; }
    }
    const float c2 = 0.125f * LOG2E;
    const int qrow = (qw >> 6), qc = (qw & 63) + r32;
    const int r0 = min(max(qrow - 4, 0), 120), cs = min(max(qc - 8, 0), 48);
    const int srow = tid >> 3, sch = tid & 7, srow2 = tid >> 2, sch2 = tid & 3;
    u32x4 kreg[NLD], vreg[NLD], rreg;
    auto load_tile = [&](int t) {
#pragma unroll
        for (int i = 0; i < NLD; ++i) {
            const int kidx = kfirst + A_TK * t + srow + 64 * i;
            if (VAR == 0) {
                const bf16_t* kp = P.KVM + (tb + kidx) * 512 + h * 128 + sch * 8;
                kreg[i] = *(const u32x4*)kp; vreg[i] = *(const u32x4*)(kp + 64);
            } else if (VAR == 1) {
                const int kc = min(max(kidx, 0), S - 1); const bf16_t* base = P.ZQ + (tb + kc) * ZC + (h >> 1) * 64 + sch * 8;
                kreg[i] = *(const u32x4*)(base + C_BK); vreg[i] = *(const u32x4*)(base + C_BV);
            } else if (VAR == 2) {
                const int kc = min(kidx, S - 1); const bf16_t* base = P.ZQ + (tb + kc) * ZC + h * 64 + sch * 8;
                kreg[i] = *(const u32x4*)(base + C_CK); vreg[i] = *(const u32x4*)(base + C_CV);
            } else {
                const int kc = min(max(kidx, 0), L - 1); const bf16_t* base = P.ZQ + (tb + res + (size_t)r * kc) * ZC + g * 256 + h * 64 + sch * 8;
                kreg[i] = *(const u32x4*)(base + C_DK); vreg[i] = *(const u32x4*)(base + C_DV);
            }
        }
        if (VAR == 0) rreg = *(const u32x4*)(P.KR + (tb + kfirst + A_TK * t + srow2) * 32 + sch2 * 8);
    };
    auto store_tile = [&](int buf) {
#pragma unroll
        for (int i = 0; i < NLD; ++i) {
            *(LAS u32x4*)(lds + A_KB + buf * A_TK * A_KP + (srow + 64 * i) * A_KP + sch * 16) = kreg[i];
            *(LAS u32x4*)(lds + A_VB + buf * A_TK * A_VP + (srow + 64 * i) * A_VP + sch * 16) = vreg[i];
        }
        if (VAR == 0) *(LAS u32x4*)(lds + A_KB + buf * A_TK * A_KP + srow2 * A_KP + 128 + sch2 * 16) = rreg;
    };
    load_tile(0); store_tile(0);
    __syncthreads();
    const int tq = lane & 15, tq_q = tq >> 2, tq_p = tq & 3, blk = (lane >> 4) & 1;
    float mxt[QB];
    if (VAR == 0) {
#pragma unroll
        for (int qb = 0; qb < QB; ++qb) {
            f32x16 s0;
#pragma unroll
            for (int i = 0; i < 16; ++i) s0[i] = 0.f;
#pragma unroll
            for (int ks = 0; ks < NKS; ++ks) {
                const bf16x8 kf = *(LAS const bf16x8*)(lds + A_KB + r32 * A_KP + (16 * ks + 8 * hi) * 2);
                s0 = __builtin_amdgcn_mfma_f32_32x32x16_bf16(kf, qf[qb][ks], s0, 0, 0, 0);
            }
            float mx = s0[0];
#pragma unroll
            for (int i = 1; i < 16; ++i) mx = fmaxf(mx, s0[i]);
            m_run[qb] = xhalf_max(mx); mxt[qb] = -INFINITY;
        }
    }
    f32x16 negm;
#pragma unroll
    for (int i = 0; i < 16; ++i) negm[i] = -m_run[0];
    u32x4 kregB[NLD], vregB[NLD], rregB;
    auto load_tileB = [&](int t) {
#pragma unroll
        for (int i = 0; i < NLD; ++i) {
            const bf16_t* kp = P.KVM + (tb + kfirst + A_TK * t + srow + 64 * i) * 512 + h * 128 + sch * 8;
            kregB[i] = *(const u32x4*)kp; vregB[i] = *(const u32x4*)(kp + 64);
        }
        rregB = *(const u32x4*)(P.KR + (tb + kfirst + A_TK * t + srow2) * 32 + sch2 * 8);
    };
    auto store_tileB = [&](int buf) {
#pragma unroll
        for (int i = 0; i < NLD; ++i) {
            *(LAS u32x4*)(lds + A_KB + buf * A_TK * A_KP + (srow + 64 * i) * A_KP + sch * 16) = kregB[i];
            *(LAS u32x4*)(lds + A_VB + buf * A_TK * A_VP + (srow + 64 * i) * A_VP + sch * 16) = vregB[i];
        }
        *(LAS u32x4*)(lds + A_KB + buf * A_TK * A_KP + srow2 * A_KP + 128 + sch2 * 16) = rregB;
    };
    auto mla_tile = [&](const int buf) {
#define SBAR0() __builtin_amdgcn_sched_barrier(0)
#define PINV(x) asm volatile("" : "+v"(x))
#define EXPS(v, i0, i1, i2) do { v[i0] = __builtin_amdgcn_exp2f(v[i0]); v[i1] = __builtin_amdgcn_exp2f(v[i1]); v[i2] = __builtin_amdgcn_exp2f(v[i2]); } while (0)
#define EXP2S(v, i0, i1) do { v[i0] = __builtin_amdgcn_exp2f(v[i0]); v[i1] = __builtin_amdgcn_exp2f(v[i1]); } while (0)
            LAS const unsigned char* Kt = lds + A_KB + buf * A_TK * A_KP + r32 * A_KP + 16 * hi;
            LAS const unsigned char* Vt = lds + A_VB + buf * A_TK * A_VP + (4 * hi + tq_q) * A_VP + (16 * blk + 4 * tq_p) * 2;
            bf16x8 kf[NKS];
#pragma unroll
            for (int ks = 0; ks < NKS; ++ks) kf[ks] = *(LAS const bf16x8*)(Kt + 32 * ks);
            f32x16 sc = negm, sn;
#pragma unroll
            for (int ks = 0; ks < NKS; ++ks) sc = __builtin_amdgcn_mfma_f32_32x32x16_bf16(kf[ks], qf[0][ks], sc, 0, 0, 0);
            SBAR0();
#pragma unroll
            for (int sb = 0; sb < A_TK / 32; ++sb) {
                bf16x8 vf[2][2];
#pragma unroll
                for (int d0 = 0; d0 < 2; ++d0)
#pragma unroll
                    for (int ss = 0; ss < 2; ++ss) {
                        LAS const unsigned char* vp = Vt + (32 * sb + 16 * ss) * A_VP + 64 * d0;
                        const s16x4 lo = __builtin_amdgcn_ds_read_tr16_b64_v4i16((LAS s16x4*)vp);
                        const s16x4 hh = __builtin_amdgcn_ds_read_tr16_b64_v4i16((LAS s16x4*)(vp + 8 * A_VP));
                        vf[d0][ss] = (bf16x8){lo[0], lo[1], lo[2], lo[3], hh[0], hh[1], hh[2], hh[3]};
                    }
                if (sb + 1 < A_TK / 32) {
#pragma unroll
                    for (int ks = 0; ks < NKS; ++ks) kf[ks] = *(LAS const bf16x8*)(Kt + (32 * (sb + 1)) * A_KP + 32 * ks);
                }
                SBAR0();
                if (sb + 1 < A_TK / 32) {
                    sn = __builtin_amdgcn_mfma_f32_32x32x16_bf16(kf[0], qf[0][0], negm, 0, 0, 0); EXPS(sc, 0, 1, 2); PINV(sc); SBAR0();
                    sn = __builtin_amdgcn_mfma_f32_32x32x16_bf16(kf[1], qf[0][1], sn, 0, 0, 0);   EXPS(sc, 3, 4, 5); PINV(sc); SBAR0();
                    sn = __builtin_amdgcn_mfma_f32_32x32x16_bf16(kf[2], qf[0][2], sn, 0, 0, 0);   EXPS(sc, 6, 7, 8); PINV(sc); SBAR0();
                    sn = __builtin_amdgcn_mfma_f32_32x32x16_bf16(kf[3], qf[0][3], sn, 0, 0, 0);   EXPS(sc, 9, 10, 11); PINV(sc); SBAR0();
                    sn = __builtin_amdgcn_mfma_f32_32x32x16_bf16(kf[4], qf[0][4], sn, 0, 0, 0);   EXP2S(sc, 12, 13); PINV(sc); SBAR0();
                    sn = __builtin_amdgcn_mfma_f32_32x32x16_bf16(kf[5], qf[0][5], sn, 0, 0, 0);   EXP2S(sc, 14, 15); PINV(sc); SBAR0();
                } else {
#pragma unroll
                    for (int i = 0; i < 16; ++i) sc[i] = __builtin_amdgcn_exp2f(sc[i]);
                    SBAR0();
                }
                u32x4 pw0, pw1;
                pw0.x = cvt_pk(sc[0], sc[1]); pw0.y = cvt_pk(sc[2], sc[3]); pw0.z = cvt_pk(sc[4], sc[5]); pw0.w = cvt_pk(sc[6], sc[7]);
                pw1.x = cvt_pk(sc[8], sc[9]); pw1.y = cvt_pk(sc[10], sc[11]); pw1.z = cvt_pk(sc[12], sc[13]); pw1.w = cvt_pk(sc[14], sc[15]);
                const bf16x8 pfa = __builtin_bit_cast(bf16x8, pw0), pfb = __builtin_bit_cast(bf16x8, pw1);
                SBAR0();
                float ps = l_run[0];
                o[0][0] = __builtin_amdgcn_mfma_f32_32x32x16_bf16(pfa, vf[0][0], o[0][0], 0, 0, 0); ps += sc[0]; ps += sc[1]; ps += sc[2]; ps += sc[3]; PINV(ps); SBAR0();
                o[0][1] = __builtin_amdgcn_mfma_f32_32x32x16_bf16(pfa, vf[1][0], o[0][1], 0, 0, 0); ps += sc[4]; ps += sc[5]; ps += sc[6]; ps += sc[7]; PINV(ps); SBAR0();
                o[0][0] = __builtin_amdgcn_mfma_f32_32x32x16_bf16(pfb, vf[0][1], o[0][0], 0, 0, 0); ps += sc[8]; ps += sc[9]; ps += sc[10]; ps += sc[11]; PINV(ps); SBAR0();
                o[0][1] = __builtin_amdgcn_mfma_f32_32x32x16_bf16(pfb, vf[1][1], o[0][1], 0, 0, 0); ps += sc[12]; ps += sc[13]; ps += sc[14]; ps += sc[15]; PINV(ps);
                l_run[0] = ps;
                if (sb + 1 < A_TK / 32) sc = sn;
                SBAR0();
            }
#undef SBAR0
#undef PINV
#undef EXPS
#undef EXP2S
            if (__any(l_run[0] > 1.8446744e19f)) {
                const float dn = 5.421010862427522e-20f;
                l_run[0] *= dn;
#pragma unroll
                for (int i = 0; i < 16; ++i) { o[0][0][i] *= dn; o[0][1][i] *= dn; negm[i] -= 64.0f; }
            }
    };
#define LDS_BAR() asm volatile("s_waitcnt lgkmcnt(0)\n\ts_barrier" ::: "memory")
    if constexpr (VAR == 0) {
        load_tile(1);
        for (int t = 0; t < NT; t += 2) {
            if (t + 2 < NT) load_tileB(t + 2);
            mla_tile(0);
            store_tile(1);
            LDS_BAR();
            if (t + 3 < NT) load_tile(t + 3);
            mla_tile(1);
            if (t + 2 < NT) store_tileB(0);
            LDS_BAR();
        }
    } else
    for (int t = 0; t < NT; ++t) {
        if (t + 1 < NT) load_tile(t + 1);
        const int buf = (NBUF == 2) ? (t & 1) : 0;
        if constexpr (VAR == 0) { mla_tile(buf); } else
#pragma unroll 2
        for (int sb = 0; sb < A_TK / 32; ++sb) {
            const int kb = kfirst + A_TK * t + 32 * sb;
            bool act = true;
            if (VAR == 1) act = (kb + 31 >= max(qw - 128, 0)) && (kb <= min(qw + 159, S - 1));
            if (VAR == 2) { const int kr = kb >> 6; act = (kr >= r0) && (kr < r0 + 8); }
            if (VAR == 3) act = (kb + 31 >= max(qw - 64, 0)) && (kb <= min(qw + 95, L - 1));
            if (!act) continue;
            LAS const unsigned char* Kb = lds + A_KB + buf * A_TK * A_KP + (32 * sb) * A_KP;
            LAS const unsigned char* Vb = lds + A_VB + buf * A_TK * A_VP + (32 * sb) * A_VP;
            f32x16 s[QB];
#pragma unroll
            for (int qb = 0; qb < QB; ++qb)
#pragma unroll
                for (int i = 0; i < 16; ++i) s[qb][i] = (VAR == 0) ? -m_run[qb] : 0.f;
#pragma unroll
            for (int ks = 0; ks < NKS; ++ks) {
                const bf16x8 kf = *(LAS const bf16x8*)(Kb + r32 * A_KP + (16 * ks + 8 * hi) * 2);
#pragma unroll
                for (int qb = 0; qb < QB; ++qb) s[qb] = __builtin_amdgcn_mfma_f32_32x32x16_bf16(kf, qf[qb][ks], s[qb], 0, 0, 0);
            }
            bf16x8 pf[QB][2];
#pragma unroll
            for (int qb = 0; qb < QB; ++qb) {
                if (VAR == 1 || VAR == 3) {
                    const int HALFW = (VAR == 1) ? 128 : 64, LL = (VAR == 1) ? S : L;
                    const int qpos = qw + r32;
#pragma unroll
                    for (int i = 0; i < 16; ++i) {
                        const int kp = kb + crow(i, hi), rel = kp - qpos;
                        const bool ok = (rel >= -HALFW) && (rel <= HALFW) && (kp >= 0) && (kp < LL);
                        const int idx = min(max(rel + HALFW, 0), 2 * HALFW);
                        s[qb][i] = ok ? (s[qb][i] * c2 + LUT[idx]) : -INFINITY;
                    }
                }
                if (VAR == 2) {
                    const int dr = (kb >> 6) - qrow + 7;
#pragma unroll
                    for (int i = 0; i < 16; ++i) {
                        const int ck = (kb & 63) + crow(i, hi), d = ck - qc;
                        const bool ok = (ck >= cs) && (ck < cs + 16);
                        const int idx = dr * 31 + min(max(d + 15, 0), 30);
                        s[qb][i] = ok ? (s[qb][i] * c2 + LUT[idx]) : -INFINITY;
                    }
                }
                float mx = s[qb][0];
#pragma unroll
                for (int i = 1; i < 16; ++i) mx = fmaxf(mx, s[qb][i]);
                if (VAR == 0) mxt[qb] = fmaxf(mxt[qb], mx);
                else {
                mx = xhalf_max(mx);
                const float mnew = fmaxf(m_run[qb], mx);
                if (__any(mnew != m_run[qb])) {
                    const float al = __builtin_amdgcn_exp2f(m_run[qb] - mnew);
                    l_run[qb] *= al; m_run[qb] = mnew;
                    if (hi == 0) WSF[32 * qb + r32] = al;
                    __builtin_amdgcn_fence(__ATOMIC_RELEASE, "wavefront"); __builtin_amdgcn_wave_barrier(); __builtin_amdgcn_fence(__ATOMIC_ACQUIRE, "wavefront");
#pragma unroll
                    for (int i = 0; i < 16; ++i) { const float al2 = WSF[32 * qb + crow(i, hi)]; o[qb][0][i] *= al2; o[qb][1][i] *= al2; }
                    __builtin_amdgcn_fence(__ATOMIC_RELEASE, "wavefront"); __builtin_amdgcn_wave_barrier(); __builtin_amdgcn_fence(__ATOMIC_ACQUIRE, "wavefront");
                }
                }
                float ps = 0.f;
#pragma unroll
                for (int i = 0; i < 16; ++i) { s[qb][i] = __builtin_amdgcn_exp2f((VAR == 0) ? s[qb][i] : s[qb][i] - m_run[qb]); ps += s[qb][i]; }
                l_run[qb] += ps;
                u32x4 pw0, pw1;
                pw0.x = cvt_pk(s[qb][0], s[qb][1]); pw0.y = cvt_pk(s[qb][2], s[qb][3]); pw0.z = cvt_pk(s[qb][4], s[qb][5]); pw0.w = cvt_pk(s[qb][6], s[qb][7]);
                pw1.x = cvt_pk(s[qb][8], s[qb][9]); pw1.y = cvt_pk(s[qb][10], s[qb][11]); pw1.z = cvt_pk(s[qb][12], s[qb][13]); pw1.w = cvt_pk(s[qb][14], s[qb][15]);
                pf[qb][0] = __builtin_bit_cast(bf16x8, pw0); pf[qb][1] = __builtin_bit_cast(bf16x8, pw1);
            }
#pragma unroll
            for (int d0 = 0; d0 < 2; ++d0) {
#pragma unroll
                for (int ss = 0; ss < 2; ++ss) {
                    LAS const unsigned char* vp = Vb + (16 * ss + 4 * hi + tq_q) * A_VP + (32 * d0 + 16 * blk + 4 * tq_p) * 2;
                    const s16x4 lo = __builtin_amdgcn_ds_read_tr16_b64_v4i16((LAS s16x4*)vp);
                    const s16x4 hh = __builtin_amdgcn_ds_read_tr16_b64_v4i16((LAS s16x4*)(vp + 8 * A_VP));
                    const bf16x8 vf = (bf16x8){lo[0], lo[1], lo[2], lo[3], hh[0], hh[1], hh[2], hh[3]};
#pragma unroll
                    for (int qb = 0; qb < QB; ++qb) o[qb][d0] = __builtin_amdgcn_mfma_f32_32x32x16_bf16(pf[qb][ss], vf, o[qb][d0], 0, 0, 0);
                }
            }
        }
        if (VAR == 0) {
#pragma unroll
            for (int qb = 0; qb < QB; ++qb) {
                if (__any(mxt[qb] > 64.0f)) {
                    const float dl = fmaxf(xhalf_max(mxt[qb]), 0.f), al = __builtin_amdgcn_exp2f(-dl);
                    l_run[qb] *= al; m_run[qb] += dl;
                    if (hi == 0) WSF[32 * qb + r32] = al;
                    __builtin_amdgcn_fence(__ATOMIC_RELEASE, "wavefront"); __builtin_amdgcn_wave_barrier(); __builtin_amdgcn_fence(__ATOMIC_ACQUIRE, "wavefront");
#pragma unroll
                    for (int i = 0; i < 16; ++i) { const float al2 = WSF[32 * qb + crow(i, hi)]; o[qb][0][i] *= al2; o[qb][1][i] *= al2; }
                    __builtin_amdgcn_fence(__ATOMIC_RELEASE, "wavefront"); __builtin_amdgcn_wave_barrier(); __builtin_amdgcn_fence(__ATOMIC_ACQUIRE, "wavefront");
                }
                mxt[qb] = -INFINITY;
            }
        }
        if (NBUF == 2) { if (t + 1 < NT) store_tile((t + 1) & 1); }
        else if (t + 1 < NT) { __syncthreads(); store_tile(0); }
        __syncthreads();
    }
#pragma unroll
    for (int qb = 0; qb < QB; ++qb) {
        const float lt = xhalf_sum(l_run[qb]);
        if (hi == 0) WSF[32 * qb + r32] = 1.0f / lt;
        if (VAR == 3) { if (hi == 0) P.LSE[(tb + res + (size_t)r * (qw + r32)) * 12 + g * 4 + h] = m_run[qb] + __builtin_amdgcn_logf(lt); }
    }
    __builtin_amdgcn_fence(__ATOMIC_RELEASE, "wavefront"); __builtin_amdgcn_wave_barrier(); __builtin_amdgcn_fence(__ATOMIC_ACQUIRE, "wavefront");
#pragma unroll
    for (int qb = 0; qb < QB; ++qb) {
#pragma unroll
        for (int i = 0; i < 16; ++i) {
            const int qi = qw + 32 * qb + crow(i, hi); const float al = WSF[32 * qb + crow(i, hi)];
            bf16_t* op;
            if (VAR == 3) op = P.ZQw + (tb + res + (size_t)r * qi) * ZC + C_DQ + g * 256 + h * 64;
            else op = P.Y + (tb + qi) * DM + VAR * 256 + h * 64;
            const unsigned a0 = cvt_pk(o[qb][0][i] * al, 0.f), a1 = cvt_pk(o[qb][1][i] * al, 0.f);
            op[r32] = (bf16_t)(a0 & 0xffffu); op[32 + r32] = (bf16_t)(a1 & 0xffffu);
        }
    }
    __syncthreads();
}

DI int t5_bucket(int rel) {
    const int n = rel < 0 ? -rel : rel;
    const int v = n < 8 ? n : 8 + (n >= 15) + (n >= 27) + (n >= 50) + (n >= 91) + (n >= 166) + (n >= 305) + (n >= 559);
    return (rel > 0 ? 16 : 0) + v;
}
DI void transpose_item(const float* W, int ldw, int coff, const float* kscale, bf16_t* WT, int ldt, LAS float* scr, int kb, int nb, int lane) {
    const int k0 = 64 * kb, n0 = 32 * nb;
    const int rr = lane >> 3, c4 = 4 * (lane & 7);
    f32x4 v[8];
#pragma unroll
    for (int i = 0; i < 8; ++i) v[i] = *(const f32x4*)(W + (size_t)(k0 + 8 * i + rr) * ldw + coff + n0 + c4);
#pragma unroll
    for (int i = 0; i < 8; ++i) {
        const int kk = 8 * i + rr; f32x4 x = v[i];
        if (kscale) x = x * kscale[k0 + kk];
        LAS float* d = scr + kk * 33 + c4; d[0] = x.x; d[1] = x.y; d[2] = x.z; d[3] = x.w;
    }
    __builtin_amdgcn_fence(__ATOMIC_RELEASE, "wavefront"); __builtin_amdgcn_wave_barrier(); __builtin_amdgcn_fence(__ATOMIC_ACQUIRE, "wavefront");
    const int c = lane & 7;
#pragma unroll
    for (int j = 0; j < 4; ++j) { const int n = (lane >> 3) + 8 * j; const LAS float* s = scr + (8 * c) * 33 + n;
        u32x4 o; o.x = cvt_pk(s[0 * 33], s[1 * 33]); o.y = cvt_pk(s[2 * 33], s[3 * 33]); o.z = cvt_pk(s[4 * 33], s[5 * 33]); o.w = cvt_pk(s[6 * 33], s[7 * 33]);
        *(u32x4*)(WT + (size_t)(n0 + n) * ldt + k0 + 8 * c) = o; }
    __builtin_amdgcn_fence(__ATOMIC_RELEASE, "wavefront"); __builtin_amdgcn_wave_barrier(); __builtin_amdgcn_fence(__ATOMIC_ACQUIRE, "wavefront");
}
DI void transpose_mat(const float* W, int K, int N, int ldw, int coff, const float* kscale, bf16_t* WT, int ldt, LAS float* scr, int gw, int NGW, int lane) {
    const int nblk = N / 32, items = (K / 64) * nblk;
    for (int it = gw; it < items; it += NGW) transpose_item(W, ldw, coff, kscale, WT, ldt, scr, it / nblk, it % nblk, lane);
}
template <int RN> DI void ln_rows(const float* in, float* outf, bf16_t* outb, float* stat, const float* gam, const float* bet, int lane) {
    f32x4 v[RN][4]; float mean[RN], rstd[RN];
#pragma unroll
    for (int r = 0; r < RN; ++r)
#pragma unroll
        for (int j = 0; j < 4; ++j) v[r][j] = ((const f32x4*)(in + (size_t)r * DM))[lane + 64 * j];
#pragma unroll
    for (int r = 0; r < RN; ++r) { float s = 0.f;
#pragma unroll
        for (int j = 0; j < 4; ++j) s += (v[r][j].x + v[r][j].y) + (v[r][j].z + v[r][j].w);
        mean[r] = s; }
#pragma unroll
    for (int r = 0; r < RN; ++r) mean[r] = wave_sum(mean[r]);
#pragma unroll
    for (int r = 0; r < RN; ++r) { mean[r] *= (1.f / DM); float s2 = 0.f;
#pragma unroll
        for (int j = 0; j < 4; ++j) { v[r][j] = v[r][j] - mean[r]; s2 += (v[r][j].x * v[r][j].x + v[r][j].y * v[r][j].y) + (v[r][j].z * v[r][j].z + v[r][j].w * v[r][j].w); }
        rstd[r] = s2; }
#pragma unroll
    for (int r = 0; r < RN; ++r) rstd[r] = wave_sum(rstd[r]);
#pragma unroll
    for (int r = 0; r < RN; ++r) { rstd[r] = 1.0f / sqrtf(rstd[r] * (1.f / DM) + 1e-5f); if (stat && lane == 0) { stat[2 * r] = mean[r]; stat[2 * r + 1] = rstd[r]; } }
#pragma unroll
    for (int j = 0; j < 4; ++j) {
        const f32x4 gg = ((const f32x4*)gam)[lane + 64 * j], bb = ((const f32x4*)bet)[lane + 64 * j];
#pragma unroll
        for (int r = 0; r < RN; ++r) {
            const f32x4 y = v[r][j] * rstd[r] * gg + bb;
            if (outf) ((f32x4*)(outf + (size_t)r * DM))[lane + 64 * j] = y;
            if (outb) { u32x2 w2; w2.x = cvt_pk(y.x, y.y); w2.y = cvt_pk(y.z, y.w); ((u32x2*)(outb + (size_t)r * DM))[lane + 64 * j] = w2; }
        }
    }
}

#define XB_TMO      128
#define XB_XCNT(j)  (256  + 64 * (j))
#define XB_XSUB(j)  (1280 + 64 * (j))
#define XB_XGEN(j)  (2304 + 64 * (j))
#define XB_TOP      3328
#define XB_TOPGEN   3392
#define XCD_BAR_WORDS 3456
#define XB_SPIN_CAP (1u << 20)
DI unsigned xb_ld(unsigned* p)              { return __hip_atomic_load(p, __ATOMIC_RELAXED, __HIP_MEMORY_SCOPE_AGENT); }
DI unsigned xb_add(unsigned* p, unsigned v) { return __hip_atomic_fetch_add(p, v, __ATOMIC_RELAXED, __HIP_MEMORY_SCOPE_AGENT); }
DI unsigned xb_xcc_id() { return (unsigned)__builtin_amdgcn_s_getreg((3 << 11) | 20) & 0xFu; }
#define XB_SPIN(cond, bar) do { unsigned _sp = 0; while (cond) { __builtin_amdgcn_s_sleep(1); \
    if ((++_sp & 255u) == 0u) { if (xb_ld(&(bar)[XB_TMO])) break; if (_sp > XB_SPIN_CAP) { atomicAdd(&(bar)[XB_TMO], 1u); break; } } } } while (0)
DI void xcd_barrier_complete(unsigned* bar, unsigned x, unsigned& nloc, unsigned& nx) {
    const unsigned G = gridDim.x;
    unsigned sum, cnt, mine, sp = 0u;
    for (;;) {
        sum = 0u; cnt = 0u; mine = 0u;
#pragma unroll
        for (unsigned j = 0; j < 16; ++j) { const unsigned c = xb_ld(&bar[XB_XCNT(j)]); sum += c; cnt += (c > 0u) ? 1u : 0u; mine = (j == x) ? c : mine; }
        if (sum == G) break;
        __builtin_amdgcn_s_sleep(1);
        if ((++sp & 255u) == 0u) { if (xb_ld(&bar[XB_TMO])) break; if (sp > XB_SPIN_CAP) { atomicAdd(&bar[XB_TMO], 1u); break; } }
    }
    nloc = mine > 0u ? mine : 1u; nx = cnt > 0u ? cnt : 1u;
}
DI void xcd_barrier(unsigned* bar, volatile LAS unsigned* st, bool leader) {
    asm volatile("s_waitcnt vmcnt(0)" ::: "memory");
    __syncthreads();
    if (leader) {
        const unsigned x = xb_xcc_id();
        __builtin_amdgcn_s_waitcnt(0);
        unsigned nloc = st[0], nx = st[1];
        if (nloc == 0u) { xcd_barrier_complete(bar, x, nloc, nx); st[0] = nloc; st[1] = nx; }
        const unsigned old = xb_add(&bar[XB_XSUB(x)], 1u);
        const unsigned gen = old / nloc;
        if (old + 1u == (gen + 1u) * nloc) {
            __builtin_amdgcn_fence(__ATOMIC_RELEASE, "agent");
            asm volatile("s_waitcnt vmcnt(0)" ::: "memory");
            const unsigned og = xb_add(&bar[XB_TOP], 1u);
            const unsigned tg = og / nx;
            if (og + 1u == (tg + 1u) * nx) xb_add(&bar[XB_TOPGEN], 1u);
            else XB_SPIN(xb_ld(&bar[XB_TOPGEN]) == tg, bar);
            __builtin_amdgcn_fence(__ATOMIC_ACQUIRE, "agent");
            xb_add(&bar[XB_XGEN(x)], 1u);
            asm volatile("s_waitcnt vmcnt(0)" ::: "memory");
        } else {
            XB_SPIN(xb_ld(&bar[XB_XGEN(x)]) == gen, bar);
            __builtin_amdgcn_fence(__ATOMIC_ACQUIRE, "agent");
            asm volatile("s_waitcnt vmcnt(0)" ::: "memory");
        }
    }
    __syncthreads();
}

struct Args { const float* in[22]; float* out; unsigned char* ws; int ph_lo, ph_hi; };
constexpr int PH_PER_LAYER = 11, N_PHASES = 1 + NL * PH_PER_LAYER;
constexpr int TAB_OFF = 131072 + 2048;
typedef volatile LAS unsigned long long* tab_t;
DI unsigned long long tab_get(tab_t TAB, int i) {
    const unsigned long long v = TAB[i];
    const unsigned lo = __builtin_amdgcn_readfirstlane((unsigned)v), hi = __builtin_amdgcn_readfirstlane((unsigned)(v >> 32));
    return ((unsigned long long)hi << 32) | lo;
}
#define TABF(i) ((const float*)tab_get(TAB, (i)))
#define TABWS() ((unsigned char*)tab_get(TAB, 23))
#define TABOUT() ((float*)tab_get(TAB, 22))

DI int opaque_s(int v) { asm volatile("" : "+s"(v)); return v; }
DI void conv_layer(tab_t TAB, LAS unsigned char* lds, int l, int gw, int NGW, int gt, int NGT, int wave, int lane) {
    unsigned char* ws = TABWS();
    bf16_t* Wqkv_t = (bf16_t*)(ws + W_QKV); bf16_t* Wuq_t = (bf16_t*)(ws + W_UQ); bf16_t* Wukv_t = (bf16_t*)(ws + W_UKV);
    LAS float* scr = (LAS float*)(lds + wave * 8704);
    { const float* win = TABF(5) + (size_t)l * DM * INC;
      transpose_mat(win, DM, 4000, INC, 0, nullptr, Wqkv_t, DM, scr, gw, NGW, lane);
      transpose_mat(win, DM, 4096, INC, C_G, nullptr, (bf16_t*)(ws + W_G), DM, scr, gw, NGW, lane); }
    transpose_mat(TABF(16) + (size_t)l * DM * FF, DM, FF, FF, 0, nullptr, (bf16_t*)(ws + W_FF1), DM, scr, gw, NGW, lane);
    transpose_mat(TABF(17) + (size_t)l * FF * DM, FF, DM, DM, 0, nullptr, (bf16_t*)(ws + W_FF2), FF, scr, gw, NGW, lane);
    for (int n = 0; n < 4; ++n) transpose_mat(TABF(12) + ((size_t)l * 4 + n) * 256 * DM, 256, DM, DM, 0, nullptr, (bf16_t*)(ws + W_B) + (size_t)n * DM * 256, 256, scr, gw, NGW, lane);
    transpose_mat(TABF(13) + (size_t)l * DM * DM, DM, DM, DM, 0, nullptr, (bf16_t*)(ws + W_OUT), DM, scr, gw, NGW, lane);
    transpose_mat(TABF(19) + (size_t)l * DM * DM, DM, DM, DM, 0, nullptr, (bf16_t*)(ws + W_PG), DM, scr, gw, NGW, lane);
    transpose_mat(TABF(18) + (size_t)l * 256 * DM, 256, DM, DM, 0, nullptr, (bf16_t*)(ws + W_PLE), 256, scr, gw, NGW, lane);
    transpose_mat(TABF(7) + (size_t)l * 256 * 384, 256, 384, 384, 0, TABF(6) + l * 256, Wuq_t, 256, scr, gw, NGW, lane);
    transpose_mat(TABF(9) + (size_t)l * 128 * 512, 128, 512, 512, 0, TABF(8) + l * 128, Wukv_t, 256, scr, gw, NGW, lane);
    for (int i = gt; i < 96 * DM / 2; i += NGT) ((unsigned*)(Wqkv_t + (size_t)4000 * DM))[i] = 0u;
    for (int i = gt; i < 128 * 256 / 2; i += NGT) ((unsigned*)(Wuq_t + (size_t)384 * 256))[i] = 0u;
    for (int i = gt; i < 512 * 64; i += NGT) { const int rr = i >> 6, cc = i & 63; ((unsigned*)(Wukv_t + (size_t)rr * 256 + 128))[cc] = 0u; }
    const float* pl = TABF(1) + (size_t)l * T * 256; bf16_t* PB = (bf16_t*)(ws + WS_PB);
    for (int i = gt; i < T * 256 / 8; i += NGT) {
        const f32x4 v0 = ((const f32x4*)pl)[2 * i], v1 = ((const f32x4*)pl)[2 * i + 1];
        u32x4 o; o.x = cvt_pk(v0.x, v0.y); o.y = cvt_pk(v0.z, v0.w); o.z = cvt_pk(v1.x, v1.y); o.w = cvt_pk(v1.z, v1.w);
        ((u32x4*)PB)[i] = o;
    }
}

__global__ void __launch_bounds__(512) fwd_kernel(Args a) {
    extern __shared__ __attribute__((aligned(16))) unsigned char lds_raw[];
    LAS unsigned char* lds = (LAS unsigned char*)lds_raw;
    cg::grid_group grid = cg::this_grid();
    tab_t TAB = (tab_t)(lds + TAB_OFF);
    if (threadIdx.x == 0) {
#pragma unroll
        for (int i = 0; i < 22; ++i) TAB[i] = (unsigned long long)a.in[i];
        TAB[22] = (unsigned long long)a.out; TAB[23] = (unsigned long long)a.ws;
    }
    volatile LAS unsigned* BST = (volatile LAS unsigned*)(lds + TAB_OFF + 256);
    if (threadIdx.x < 2) BST[threadIdx.x] = 0u;
    if (blockIdx.x == 0) { unsigned* bw = (unsigned*)a.ws; for (int i = threadIdx.x; i < XCD_BAR_WORDS; i += 512) bw[i] = 0u; }
    __syncthreads();
    const int ph_lo = a.ph_lo, ph_hi = a.ph_hi;
    const int wave_s = __builtin_amdgcn_readfirstlane((int)threadIdx.x >> 6);
#define TIDS int tid_ = wave_s * 64 + lane_id(); asm volatile("" : "+v"(tid_)); const int tid = tid_, lane = tid & 63, wave = __builtin_amdgcn_readfirstlane(tid >> 6); int G_ = gridDim.x, bid_ = blockIdx.x; asm volatile("" : "+s"(G_), "+s"(bid_)); const int G = G_, bid = bid_; \
             const int gw = bid * 8 + wave, NGW = G * 8; const int gt = bid * 512 + tid, NGT = G * 512; (void)lane; (void)gw; (void)NGW; (void)gt; (void)NGT; (void)wave;
#define GRIDX opaque_s((int)gridDim.x)
#define BIDX opaque_s((int)blockIdx.x)
#define PHASE(k) asm volatile("" ::: "memory"); if (ph_lo <= (k) && (k) < ph_hi)
#define SEAM0(k) do { if (ph_lo <= (k) && (k) + 1 < ph_hi) { grid.sync(); if (wave_s == 0 && lane_id() == 0) (void)xb_add(&((unsigned*)TABWS())[XB_XCNT(xb_xcc_id())], 1u); } } while (0)
#define SEAM(k) do { if (ph_lo <= (k) && (k) + 1 < ph_hi) xcd_barrier((unsigned*)TABWS(), BST, wave_s == 0 && lane_id() == 0); } while (0)

    PHASE(0) {
        TIDS
        conv_layer(TAB, lds, 0, gw, NGW, gt, NGT, wave, lane);
        unsigned char* ws = TABWS();
        float* COS = (float*)(ws + WS_ROPE); float* SIN = COS + S * 16;
        for (int i = gt; i < S * 16; i += NGT) {
            const int pos = i >> 4, f = i & 15;
            const double b4 = (f & 3) == 0 ? 1.0 : ((f & 3) == 1 ? 0.5623413251903491 : ((f & 3) == 2 ? 0.31622776601683794 : 0.1778279410038923));
            const double p10 = (f >> 2) == 0 ? 1.0 : ((f >> 2) == 1 ? 0.1 : ((f >> 2) == 2 ? 0.01 : 0.001));
            const float inv = (float)(b4 * p10);
            const float ang = (float)pos * inv;
            double rev = (double)ang * 0.15915494309189535; rev -= floor(rev);
            COS[i] = __builtin_amdgcn_cosf((float)rev); SIN[i] = __builtin_amdgcn_sinf((float)rev);
        }
        const float* rel_bias = TABF(4); float* LUTS = (float*)(ws + WS_LUTS); float* LUTD = (float*)(ws + WS_LUTD);
        for (int i = gt; i < 4 * 257; i += NGT) { const int hh = i / 257, rl = i % 257 - 128; LUTS[hh * 260 + rl + 128] = rel_bias[t5_bucket(rl) * 16 + hh] * LOG2E; }
        for (int i = gt; i < 12 * 129; i += NGT) { const int gh = i / 129, rl = i % 129 - 64, gg = gh >> 2; const int rr = gg == 0 ? 1 : (gg == 1 ? 4 : 16);
            LUTD[gh * 132 + rl + 64] = rel_bias[t5_bucket(rl * rr) * 16 + 4 + gh] * LOG2E; }
        const float* x = TABF(0); float* H = TABOUT(); bf16_t* HB = (bf16_t*)(ws + WS_HB); const float* eg = TABF(2); const float* eb = TABF(3);
        float* ST = (float*)(ws + WS_STATS); (void)H;
        for (int m = gw * 8; m < T; m += NGW * 8) ln_rows<8>(x + (size_t)m * DM, nullptr, HB + (size_t)m * DM, ST + (size_t)m * 2, eg, eb, lane);
    }
    SEAM0(0);

    for (int l = 0; l < NL; ++l) {
        const int P0 = 1 + l * PH_PER_LAYER;
        PHASE(P0 + 0) {
            unsigned char* ws = TABWS();
            pg8::Gemm g{(const bf16_t*)(ws + WS_HB), (const bf16_t*)(ws + W_QKV), DM, DM}; pg8::StaticOrder so; so.init(T, ZC, GRIDX, BIDX);
            pg8::EpiStore<0> E{(bf16_t*)(ws + WS_Z), ZC, ZC, nullptr, 0, 1.0f};
            pg8::gemm_phase(lds, g, so, E, wave_s);
        }
        SEAM(P0 + 0);
        PHASE(P0 + 1) {
            { TIDS
              unsigned char* ws = TABWS();
              const bf16_t* ZQ = (const bf16_t*)(ws + WS_Z); float* RSTD = (float*)(ws + WS_RSTD); bf16_t* KR = (bf16_t*)(ws + WS_KR);
              const float* COS = (const float*)(ws + WS_ROPE); const float* SIN = COS + S * 16;
              pg8::StaticOrder so; so.init(T, 512, G, bid); pg8::Unit uu;
              for (int i = 0; so.tile(i, uu); ++i) {
                  const int ch = lane & 7;
#pragma unroll 1
                  for (int it = 0; it < 4; ++it) {
                      const int m = uu.pm * 256 + wave * 32 + it * 8 + (lane >> 3);
                      const bf16_t* zr = ZQ + (size_t)m * ZC;
                      float sq = 0.f, sk = 0.f;
#pragma unroll
                      for (int j = 0; j < 4; ++j) { const u32x4 q = *(const u32x4*)(zr + C_AQ + ch * 32 + 8 * j);
                          sq += bf_lo(q.x) * bf_lo(q.x) + bf_hi(q.x) * bf_hi(q.x) + bf_lo(q.y) * bf_lo(q.y) + bf_hi(q.y) * bf_hi(q.y)
                              + bf_lo(q.z) * bf_lo(q.z) + bf_hi(q.z) * bf_hi(q.z) + bf_lo(q.w) * bf_lo(q.w) + bf_hi(q.w) * bf_hi(q.w); }
#pragma unroll
                      for (int j = 0; j < 2; ++j) { const u32x4 q = *(const u32x4*)(zr + C_AKV + ch * 16 + 8 * j);
                          sk += bf_lo(q.x) * bf_lo(q.x) + bf_hi(q.x) * bf_hi(q.x) + bf_lo(q.y) * bf_lo(q.y) + bf_hi(q.y) * bf_hi(q.y)
                              + bf_lo(q.z) * bf_lo(q.z) + bf_hi(q.z) * bf_hi(q.z) + bf_lo(q.w) * bf_lo(q.w) + bf_hi(q.w) * bf_hi(q.w); }
                      sq += shx<1>(sq); sk += shx<1>(sk); sq += shx<2>(sq); sk += shx<2>(sk); sq += shx<4>(sq); sk += shx<4>(sk);
                      if (ch == 0) { RSTD[(size_t)m * 2] = 1.0f / sqrtf(sq * (1.f / 256.f) + 1e-6f); RSTD[(size_t)m * 2 + 1] = 1.0f / sqrtf(sk * (1.f / 128.f) + 1e-6f); }
                      if (ch < 4 && uu.pn == 0) {
                          const int pos = m & (S - 1);
                          const u32x2 a1 = *(const u32x2*)(zr + C_AKR + 4 * ch), a2 = *(const u32x2*)(zr + C_AKR + 16 + 4 * ch);
                          const f32x4 c = *(const f32x4*)(COS + pos * 16 + 4 * ch), sn = *(const f32x4*)(SIN + pos * 16 + 4 * ch);
                          const float x10 = bf_lo(a1.x), x11 = bf_hi(a1.x), x12 = bf_lo(a1.y), x13 = bf_hi(a1.y), x20 = bf_lo(a2.x), x21 = bf_hi(a2.x), x22 = bf_lo(a2.y), x23 = bf_hi(a2.y);
                          u32x2 o1, o2;
                          o1.x = cvt_pk(x10 * c.x - x20 * sn.x, x11 * c.y - x21 * sn.y); o1.y = cvt_pk(x12 * c.z - x22 * sn.z, x13 * c.w - x23 * sn.w);
                          o2.x = cvt_pk(x10 * sn.x + x20 * c.x, x11 * sn.y + x21 * c.y); o2.y = cvt_pk(x12 * sn.z + x22 * c.z, x13 * sn.w + x23 * c.w);
                          *(u32x2*)(KR + (size_t)m * 32 + 4 * ch) = o1; *(u32x2*)(KR + (size_t)m * 32 + 16 + 4 * ch) = o2;
                      }
                  }
              }
              asm volatile("s_waitcnt vmcnt(0)" ::: "memory");
              __syncthreads();
            }
            asm volatile("" ::: "memory");
            { unsigned char* ws = TABWS();
              pg8::Gemm g{(const bf16_t*)(ws + WS_Z) + C_AQ, (const bf16_t*)(ws + W_UQ), ZC, 256}; pg8::StaticOrder so; so.init(T, 512, GRIDX, BIDX);
              pg8::EpiStore<0> E{(bf16_t*)(ws + WS_QM), 384, 384, (const float*)(ws + WS_RSTD), 2, 0.10206207261596575f * LOG2E};
              pg8::gemm_phase(lds, g, so, E, wave_s); }
            asm volatile("" ::: "memory");
            { unsigned char* ws = TABWS();
              pg8::Gemm g{(const bf16_t*)(ws + WS_Z) + C_AKV, (const bf16_t*)(ws + W_UKV), ZC, 256}; pg8::StaticOrder so; so.init(T, 512, GRIDX, BIDX);
              pg8::EpiStore<0> E{(bf16_t*)(ws + WS_KVM), 512, 512, (const float*)(ws + WS_RSTD) + 1, 2, 1.0f};
              pg8::gemm_phase(lds, g, so, E, wave_s); }
        }
        SEAM(P0 + 1);
        PHASE(P0 + 2) {
            unsigned char* ws = TABWS(); const int G = GRIDX, bid = BIDX;
            bf16_t* ZQ = (bf16_t*)(ws + WS_Z);
            AttnP AP{ZQ, (const bf16_t*)(ws + WS_QM), (const bf16_t*)(ws + WS_KVM), (const bf16_t*)(ws + WS_KR), (bf16_t*)(ws + WS_Y), ZQ, (float*)(ws + WS_LSE),
                     (const float*)(ws + WS_LUTS), (const float*)(ws + WS_LUTD), TABF(11) + (size_t)l * 4 * 465, TABF(10) + l * 4, (const float*)(ws + WS_ROPE)};
            const int xq = bid & 7, jq = bid >> 3, Gq = (G + 7 - xq) >> 3;
            for (int j = jq; j < 64; j += Gq) attn_unit<0>(lds, AP, xq * 64 + j, wave_s);
            for (int j = jq; j < 64; j += Gq) attn_unit<1>(lds, AP, xq * 64 + j, wave_s);
            for (int j = jq; j < 64; j += Gq) attn_unit<2>(lds, AP, xq * 64 + j, wave_s);
            for (int j = jq; j < 192; j += Gq) attn_unit<3>(lds, AP, xq * 192 + j, wave_s);
        }
        SEAM(P0 + 2);
        PHASE(P0 + 3) {
            TIDS
            unsigned char* ws = TABWS();
            const bf16_t* ZQ = (const bf16_t*)(ws + WS_Z); const float* LSE = (const float*)(ws + WS_LSE); bf16_t* Y = (bf16_t*)(ws + WS_Y);
            for (int i = gt; i < T * 32; i += NGT) {
                const int m = i >> 5, hh = (i >> 3) & 3, ch = i & 7;
                const float l0 = LSE[(size_t)m * 12 + hh], l1 = LSE[(size_t)m * 12 + 4 + hh], l2 = LSE[(size_t)m * 12 + 8 + hh];
                const float mx = fmaxf(l0, fmaxf(l1, l2));
                float w0 = __builtin_amdgcn_exp2f(l0 - mx), w1 = __builtin_amdgcn_exp2f(l1 - mx), w2 = __builtin_amdgcn_exp2f(l2 - mx);
                const float inv = 1.0f / (w0 + w1 + w2); w0 *= inv; w1 *= inv; w2 *= inv;
                const bf16_t* zp = ZQ + (size_t)m * ZC + C_DQ + hh * 64 + ch * 8;
                const u32x4 a0 = *(const u32x4*)zp, a1 = *(const u32x4*)(zp + 256), a2 = *(const u32x4*)(zp + 512);
                u32x4 o;
                o.x = cvt_pk(w0 * bf_lo(a0.x) + w1 * bf_lo(a1.x) + w2 * bf_lo(a2.x), w0 * bf_hi(a0.x) + w1 * bf_hi(a1.x) + w2 * bf_hi(a2.x));
                o.y = cvt_pk(w0 * bf_lo(a0.y) + w1 * bf_lo(a1.y) + w2 * bf_lo(a2.y), w0 * bf_hi(a0.y) + w1 * bf_hi(a1.y) + w2 * bf_hi(a2.y));
                o.z = cvt_pk(w0 * bf_lo(a0.z) + w1 * bf_lo(a1.z) + w2 * bf_lo(a2.z), w0 * bf_hi(a0.z) + w1 * bf_hi(a1.z) + w2 * bf_hi(a2.z));
                o.w = cvt_pk(w0 * bf_lo(a0.w) + w1 * bf_lo(a1.w) + w2 * bf_lo(a2.w), w0 * bf_hi(a0.w) + w1 * bf_hi(a1.w) + w2 * bf_hi(a2.w));
                *(u32x4*)(Y + (size_t)m * DM + 768 + hh * 64 + ch * 8) = o;
            }
        }
        SEAM(P0 + 3);
        PHASE(P0 + 4) {
            unsigned char* ws = TABWS();
            pg8::Gemm g{(const bf16_t*)(ws + WS_HB), (const bf16_t*)(ws + W_G), DM, DM}; pg8::StaticOrder so; so.init(T, ZC, GRIDX, BIDX);
            pg8::EpiStore<1> E{(bf16_t*)(ws + WS_Z), ZC, ZC, nullptr, 0, 1.0f};
            pg8::gemm_phase(lds, g, so, E, wave_s);
        }
        SEAM(P0 + 4);
        PHASE(P0 + 5) {
            unsigned char* ws = TABWS();
            pg8::Gemm g{(const bf16_t*)(ws + WS_Y), (const bf16_t*)(ws + W_B), DM, 256}; pg8::MergeOrder mo; mo.s.init(T, DM, GRIDX, BIDX);
            pg8::EpiMerge E{(bf16_t*)(ws + WS_MG), (const bf16_t*)(ws + WS_Z)};
            pg8::gemm_phase(lds, g, mo, E, wave_s);
        }
        SEAM(P0 + 5);
        PHASE(P0 + 6) {
            unsigned char* ws = TABWS();
            pg8::Gemm g{(const bf16_t*)(ws + WS_MG), (const bf16_t*)(ws + W_OUT), DM, DM}; pg8::StaticOrder so; so.init(T, DM, GRIDX, BIDX);
            float* Hout = TABOUT();
            pg8::EpiResid<false> E{l == 0 ? TABF(0) : (const float*)Hout, Hout, nullptr, (const float*)(ws + WS_STATS), l == 0 ? TABF(2) : TABF(20) + (l - 1) * DM, l == 0 ? TABF(3) : TABF(21) + (l - 1) * DM};
            pg8::gemm_phase(lds, g, so, E, wave_s);
        }
        SEAM(P0 + 6);
        PHASE(P0 + 7) {
            TIDS
            unsigned char* ws = TABWS(); float* H = TABOUT(); bf16_t* HB = (bf16_t*)(ws + WS_HB); const float* gg = TABF(14) + l * DM; const float* bb = TABF(15) + l * DM;
            float* ST = (float*)(ws + WS_STATS);
            for (int m = gw * 8; m < T; m += NGW * 8) ln_rows<8>(H + (size_t)m * DM, nullptr, HB + (size_t)m * DM, ST + (size_t)m * 2, gg, bb, lane);
        }
        SEAM(P0 + 7);
        PHASE(P0 + 8) {
            { unsigned char* ws = TABWS();
              pg8::Gemm g{(const bf16_t*)(ws + WS_HB), (const bf16_t*)(ws + W_FF1), DM, DM}; pg8::StaticOrder so; so.init(T, FF, GRIDX, BIDX);
              pg8::EpiStore<2> E{(bf16_t*)(ws + WS_Z), FF, FF, nullptr, 0, 1.0f};
              pg8::gemm_phase(lds, g, so, E, wave_s); }
            asm volatile("" ::: "memory");
            { unsigned char* ws = TABWS();
              pg8::Gemm g{(const bf16_t*)(ws + WS_HB), (const bf16_t*)(ws + W_PG), DM, DM}; pg8::StaticOrder so; so.init(T, DM, GRIDX, BIDX);
              pg8::EpiStore<1> E{(bf16_t*)(ws + WS_Y), DM, DM, nullptr, 0, 1.0f};
              pg8::gemm_phase(lds, g, so, E, wave_s); }
            asm volatile("" ::: "memory");
            { unsigned char* ws = TABWS();
              pg8::Gemm g{(const bf16_t*)(ws + WS_PB), (const bf16_t*)(ws + W_PLE), 256, 256}; pg8::StaticOrder so; so.init(T, DM, GRIDX, BIDX);
              pg8::EpiMulInto E{(bf16_t*)(ws + WS_Y)};
              pg8::gemm_phase(lds, g, so, E, wave_s); }
        }
        SEAM(P0 + 8);
        PHASE(P0 + 9) {
            unsigned char* ws = TABWS();
            pg8::Gemm g{(const bf16_t*)(ws + WS_Z), (const bf16_t*)(ws + W_FF2), FF, FF}; pg8::StaticOrder so; so.init(T, DM, GRIDX, BIDX);
            float* Hout = TABOUT();
            pg8::EpiResid<true> E{(const float*)Hout, Hout, (const bf16_t*)(ws + WS_Y), (const float*)(ws + WS_STATS), TABF(14) + l * DM, TABF(15) + l * DM};
            pg8::gemm_phase(lds, g, so, E, wave_s);
        }
        SEAM(P0 + 9);
        PHASE(P0 + 10) {
            TIDS
            unsigned char* ws = TABWS(); float* H = TABOUT(); bf16_t* HB = (bf16_t*)(ws + WS_HB); const float* gg = TABF(20) + l * DM; const float* bb = TABF(21) + l * DM;
            float* ST = (float*)(ws + WS_STATS);
            if (l + 1 < NL) { for (int m = gw * 8; m < T; m += NGW * 8) ln_rows<8>(H + (size_t)m * DM, nullptr, HB + (size_t)m * DM, ST + (size_t)m * 2, gg, bb, lane); }
            else { for (int m = gw * 8; m < T; m += NGW * 8) ln_rows<8>(H + (size_t)m * DM, H + (size_t)m * DM, nullptr, nullptr, gg, bb, lane); }
            if (l + 1 < NL) conv_layer(TAB, lds, l + 1, gw, NGW, gt, NGT, wave, lane);
        }
        if (l + 1 < NL) SEAM(P0 + 10);
    }
}

extern "C" void kernel_launch(void* const* d_in, const int* in_sizes, int n_in, void* d_out, int out_size, void* d_ws, size_t ws_size, hipStream_t stream) {
    static int grid = 0;
    if (grid == 0) {
        if (n_in != 22 || out_size != T * DM || ws_size < WS_END) { fprintf(stderr, "kernel_launch: unexpected shapes (n_in %d out %d ws %zu)\n", n_in, out_size, ws_size); grid = -1; return; }
        int dev = 0, cus = 0, per = 0;
        (void)hipGetDevice(&dev); (void)hipDeviceGetAttribute(&cus, hipDeviceAttributeMultiprocessorCount, dev);
        (void)hipFuncSetAttribute((const void*)fwd_kernel, hipFuncAttributeMaxDynamicSharedMemorySize, LDS_BYTES);
        (void)hipOccupancyMaxActiveBlocksPerMultiprocessor(&per, (const void*)fwd_kernel, 512, LDS_BYTES);
        if (per < 1) per = 1;
        grid = cus * per;
        fprintf(stderr, "kernel_launch: grid %d (cus %d x %d)\n", grid, cus, per);
    }
    if (grid < 0) return;
    Args a{};
    for (int i = 0; i < 22; ++i) a.in[i] = (const float*)d_in[i];
    a.out = (float*)d_out; a.ws = (unsigned char*)d_ws;
#if N_LAUNCH_MODE == 1
    a.ph_lo = 0; a.ph_hi = N_PHASES;
    void* args[] = {&a};
    hipError_t e = hipLaunchCooperativeKernel((void*)fwd_kernel, dim3(grid), dim3(512), args, LDS_BYTES, stream);
    if (e != hipSuccess) fprintf(stderr, "cooperative launch failed: %s (grid %d)\n", hipGetErrorString(e), grid);
#else
    for (int k = 0; k < N_PHASES; ++k) { a.ph_lo = k; a.ph_hi = k + 1; hipLaunchKernelGGL(fwd_kernel, dim3(grid), dim3(512), LDS_BYTES, stream, a); }
#endif
}
```

```cpp
#include <hip/hip_runtime.h>
#include <hip/hip_cooperative_groups.h>
#include <cstdio>
#include <cstdint>
namespace cg = cooperative_groups;

#define LAS __attribute__((address_space(3)))
#define DI __device__ __forceinline__
typedef unsigned short bf16_t;
typedef short bf16x8 __attribute__((ext_vector_type(8)));
typedef short s16x4 __attribute__((ext_vector_type(4)));
typedef float f32x4 __attribute__((ext_vector_type(4)));
typedef float f32x2 __attribute__((ext_vector_type(2)));
typedef float f32x16 __attribute__((ext_vector_type(16)));
typedef unsigned u32x4 __attribute__((ext_vector_type(4)));
typedef unsigned u32x2 __attribute__((ext_vector_type(2)));
typedef __bf16 bf16x2_t __attribute__((ext_vector_type(2)));

#ifndef N_LAUNCH_MODE
#define N_LAUNCH_MODE 1
#endif

constexpr int T = 32768, S = 8192, DM = 1024, FF = 4096, INC = 8096, ZC = 4096, NL = 2;
constexpr int C_AQ = 0, C_AKV = 256, C_AKR = 384, C_BQ = 416, C_BK = 672, C_BV = 800, C_CQ = 928, C_CK = 1184, C_CV = 1440,
              C_DQ = 1696, C_DK = 2464, C_DV = 3232, C_G = 4000;
constexpr float LOG2E = 1.4426950408889634f;
constexpr float ALPHA = 1.4142135623730951f;

constexpr size_t MiB = 1u << 20;
constexpr size_t WS_RSTD = 64 * 1024, WS_LUTS = 320 * 1024, WS_LUTD = 328 * 1024, WS_LSE = 512 * 1024;
constexpr size_t WS_W = 2 * MiB;
constexpr size_t W_QKV = WS_W, W_G = WS_W + 8 * MiB, W_FF1 = WS_W + 16 * MiB, W_FF2 = WS_W + 24 * MiB, W_B = WS_W + 32 * MiB, W_OUT = WS_W + 34 * MiB,
                 W_PG = WS_W + 36 * MiB, W_PLE = WS_W + 38 * MiB, W_UQ = WS_W + 38 * MiB + 512 * 1024, W_UKV = WS_W + 38 * MiB + 768 * 1024;
constexpr size_t WS_ROPE = 41 * MiB, WS_PB = 42 * MiB, WS_HB = 58 * MiB, WS_Z = 122 * MiB, WS_Y = 378 * MiB, WS_M = 442 * MiB;
constexpr size_t WS_QM = WS_M, WS_KVM = WS_M + 24 * MiB, WS_KR = WS_M + 56 * MiB, WS_MG = WS_M;
constexpr size_t WS_STATS = 506 * MiB;
constexpr size_t WS_END = 512 * MiB;

constexpr int LDS_BYTES = 135168;

DI unsigned cvt_pk(float lo, float hi) { f32x2 v = {lo, hi}; bf16x2_t b = __builtin_convertvector(v, bf16x2_t); return __builtin_bit_cast(unsigned, b); }
DI float bf_lo(unsigned u) { return __uint_as_float(u << 16); }
DI float bf_hi(unsigned u) { return __uint_as_float(u & 0xffff0000u); }
DI float xhalf_max(float m) { auto rr = __builtin_amdgcn_permlane32_swap(__float_as_uint(m), __float_as_uint(m), false, false); return fmaxf(__uint_as_float(rr[0]), __uint_as_float(rr[1])); }
DI float xhalf_sum(float m) { auto rr = __builtin_amdgcn_permlane32_swap(__float_as_uint(m), __float_as_uint(m), false, false); return __uint_as_float(rr[0]) + __uint_as_float(rr[1]); }
template <int O> DI float shx(float v) { return __int_as_float(__builtin_amdgcn_ds_swizzle(__float_as_int(v), (O << 10) | 0x1f)); }
DI float wave_sum(float v) {
    v += shx<1>(v); v += shx<2>(v); v += shx<4>(v); v += shx<8>(v); v += shx<16>(v); v = xhalf_sum(v);
    return v;
}
DI float sigmoid_f(float x) { return __builtin_amdgcn_rcpf(1.0f + __builtin_amdgcn_exp2f(-x * LOG2E)); }
DI int lane_id() { int l; asm volatile("v_mbcnt_lo_u32_b32 %0, -1, 0\n\tv_mbcnt_hi_u32_b32 %0, -1, %0" : "=v"(l)); return l; }
DI int crow(int r, int hi) { return (r & 3) + 8 * (r >> 2) + 4 * hi; }

namespace pg8 {
constexpr int BM = 256, BK = 64, HALF = 128, HTB = HALF * BK * 2, STAGE_BYTES = 8 * HTB, NXCD = 8, WGM = 8;
DI int lds_byte(int r, int c) { const int st = (r >> 4) * 2 + (c >> 5), rr = r & 15, cc = c & 31, ob = rr * 64 + cc * 2; return st * 1024 + (ob ^ (((ob >> 9) & 1) << 5)); }
DI void stage_rc(int b, int& R, int& C) { const int st = b / 1024, sb = b % 1024, swz = sb ^ (((sb >> 9) & 1) << 5); R = (st >> 1) * 16 + swz / 64; C = (st & 1) * 32 + (swz % 64) / 2; }
DI int perm32(int rho) { const int n = rho >> 4, i = rho & 15; return 8 * (i >> 2) + 4 * n + (i & 3); }

struct Unit { int pm, pn, z; };
struct Gemm { const bf16_t* A; const bf16_t* Bt; int lda; int K; };

struct StaticOrder {
    int nM, nN, nwg, G, c;
    DI void init(int M, int N, int G_, int c_) { nM = M / BM; nN = N / BM; nwg = nM * nN; G = G_; c = c_; }
    DI bool tile(int i, Unit& u) const {
        const long L = (long)i * G + c; if (L >= nwg) return false;
        int wgid = (int)L; { const int q = nwg / NXCD, r = nwg % NXCD, xcd = wgid % NXCD, off = wgid / NXCD; wgid = (xcd < r ? xcd * (q + 1) : r * (q + 1) + (xcd - r) * q) + off; }
        const int nig = WGM * nN, gid = wgid / nig, fm = gid * WGM, gsz = (nM - fm) < WGM ? (nM - fm) : WGM;
        u.pm = fm + ((wgid % nig) % gsz); u.pn = (wgid % nig) / gsz; u.z = 0; return true;
    }
    DI bool next(int i, Unit& u) const { return tile(i, u); }
    DI size_t aoff(const Unit& u, const Gemm& g) const { return (size_t)u.pm * BM * g.lda * 2; }
    DI size_t boff(const Unit& u, const Gemm& g) const { return (size_t)u.pn * BM * g.K * 2; }
};
struct MergeOrder {
    StaticOrder s;
    DI bool next(int i, Unit& u) const { if (!s.tile(i >> 2, u)) return false; u.z = i & 3; return true; }
    DI size_t aoff(const Unit& u, const Gemm& g) const { return (size_t)u.pm * BM * g.lda * 2 + (size_t)u.z * 256 * 2; }
    DI size_t boff(const Unit& u, const Gemm& g) const { return (size_t)(u.z * 4 + u.pn) * BM * g.K * 2; }
};

#define EPI_ROWS_BEGIN \
    _Pragma("unroll") for (int ai = 0; ai < 2; ++ai) _Pragma("unroll") for (int m = 0; m < 4; ++m) { const int row = u.pm * BM + ai * HALF + wr * 64 + m * 16 + fr;
#define EPI_COLS_BEGIN \
    _Pragma("unroll") for (int bj = 0; bj < 2; ++bj) { const int col = u.pn * BM + bj * HALF + wc * 32 + 8 * fq; f32x4 v0 = acc[ai][bj][m][0], v1 = acc[ai][bj][m][1];
#define EPI_END } asm volatile("" ::: "memory"); }

template <int ACT  > struct EpiStore {
    bf16_t* O; int ldc; int ncv; const float* rs; int rss; float cmul;
    DI void operator()(const f32x4 (&acc)[2][2][4][2], const Unit& u, int wr, int wc, int fr, int fq) const {
        float scv[2][4];
#pragma unroll
        for (int ai = 0; ai < 2; ++ai)
#pragma unroll
            for (int m = 0; m < 4; ++m) scv[ai][m] = rs ? rs[(size_t)(u.pm * BM + ai * HALF + wr * 64 + m * 16 + fr) * rss] * cmul : 1.0f;
        EPI_ROWS_BEGIN
            const float sc = scv[ai][m]; bf16_t* rowp = O + (size_t)row * ldc;
            EPI_COLS_BEGIN
                if (col < ncv) {
                    v0 = v0 * sc; v1 = v1 * sc;
                    if (ACT == 1) {
#pragma unroll
                        for (int j = 0; j < 4; ++j) { v0[j] = sigmoid_f(v0[j]); v1[j] = sigmoid_f(v1[j]); }
                    }
                    if (ACT == 2) {
#pragma unroll
                        for (int j = 0; j < 4; ++j) { const float a = fmaxf(v0[j], 0.f), b = fmaxf(v1[j], 0.f); v0[j] = a * a; v1[j] = b * b; }
                    }
                    u32x4 w; w.x = cvt_pk(v0[0], v0[1]); w.y = cvt_pk(v0[2], v0[3]); w.z = cvt_pk(v1[0], v1[1]); w.w = cvt_pk(v1[2], v1[3]);
                    *(u32x4*)(rowp + col) = w;
                }
            }
            asm volatile("" ::: "memory");
        }
    }
};
#define EPI_ROW(ai, m) (u.pm * BM + (ai) * HALF + wr * 64 + (m) * 16 + fr)
#define EPI_COL(bj) (u.pn * BM + (bj) * HALF + wc * 32 + 8 * fq)
DI void mul_bf8(f32x4& v0, f32x4& v1, const u32x4 g) {
    v0[0] *= bf_lo(g.x); v0[1] *= bf_hi(g.x); v0[2] *= bf_lo(g.y); v0[3] *= bf_hi(g.y); v1[0] *= bf_lo(g.z); v1[1] *= bf_hi(g.z); v1[2] *= bf_lo(g.w); v1[3] *= bf_hi(g.w); }
DI void add_bf8(f32x4& v0, f32x4& v1, const u32x4 g) {
    v0[0] += bf_lo(g.x); v0[1] += bf_hi(g.x); v0[2] += bf_lo(g.y); v0[3] += bf_hi(g.y); v1[0] += bf_lo(g.z); v1[1] += bf_hi(g.z); v1[2] += bf_lo(g.w); v1[3] += bf_hi(g.w); }
DI u32x4 pack_bf8(const f32x4 v0, const f32x4 v1) { u32x4 w; w.x = cvt_pk(v0[0], v0[1]); w.y = cvt_pk(v0[2], v0[3]); w.z = cvt_pk(v1[0], v1[1]); w.w = cvt_pk(v1[2], v1[3]); return w; }
struct EpiMerge {
    bf16_t* MG; const bf16_t* GT;
    DI void operator()(const f32x4 (&acc)[2][2][4][2], const Unit& u, int wr, int wc, int fr, int fq) const {
#pragma unroll
        for (int ai = 0; ai < 2; ++ai)
#pragma unroll
            for (int mh = 0; mh < 2; ++mh) {
                u32x4 gv[2][2], ov[2][2];
#pragma unroll
                for (int mm = 0; mm < 2; ++mm)
#pragma unroll
                    for (int bj = 0; bj < 2; ++bj) {
                        const size_t row = EPI_ROW(ai, 2 * mh + mm); const int col = EPI_COL(bj);
                        gv[mm][bj] = *(const u32x4*)(GT + row * ZC + u.z * DM + col);
                        if (u.z != 0) ov[mm][bj] = *(const u32x4*)(MG + row * DM + col);
                    }
#pragma unroll
                for (int mm = 0; mm < 2; ++mm)
#pragma unroll
                    for (int bj = 0; bj < 2; ++bj) {
                        const size_t row = EPI_ROW(ai, 2 * mh + mm); const int col = EPI_COL(bj);
                        f32x4 v0 = acc[ai][bj][2 * mh + mm][0], v1 = acc[ai][bj][2 * mh + mm][1];
                        mul_bf8(v0, v1, gv[mm][bj]);
                        if (u.z != 0) add_bf8(v0, v1, ov[mm][bj]);
                        *(u32x4*)(MG + row * DM + col) = pack_bf8(v0, v1);
                    }
                asm volatile("" ::: "memory");
            }
    }
};
template <bool EXTRA> struct EpiResid {
    const float* Xin; float* Xout; const bf16_t* E; const float* stats; const float* gam; const float* bet;
    DI void operator()(const f32x4 (&acc)[2][2][4][2], const Unit& u, int wr, int wc, int fr, int fq) const {
        f32x4 g0[2], g1[2], b0[2], b1[2];
#pragma unroll
        for (int bj = 0; bj < 2; ++bj) { const int col = EPI_COL(bj);
            g0[bj] = *(const f32x4*)(gam + col) * ALPHA; g1[bj] = *(const f32x4*)(gam + col + 4) * ALPHA;
            b0[bj] = *(const f32x4*)(bet + col) * ALPHA; b1[bj] = *(const f32x4*)(bet + col + 4) * ALPHA; }
#pragma unroll
        for (int ai = 0; ai < 2; ++ai)
#pragma unroll
            for (int mh = 0; mh < 2; ++mh) {
                f32x4 x0[2][2], x1[2][2]; u32x4 ev[2][2]; f32x2 st[2];
#pragma unroll
                for (int mm = 0; mm < 2; ++mm) {
                    const size_t row = EPI_ROW(ai, 2 * mh + mm);
                    st[mm] = *(const f32x2*)(stats + row * 2);
#pragma unroll
                    for (int bj = 0; bj < 2; ++bj) {
                        const int col = EPI_COL(bj);
                        x0[mm][bj] = *(const f32x4*)(Xin + row * DM + col); x1[mm][bj] = *(const f32x4*)(Xin + row * DM + col + 4);
                        if (EXTRA) ev[mm][bj] = *(const u32x4*)(E + row * DM + col);
                    }
                }
#pragma unroll
                for (int mm = 0; mm < 2; ++mm)
#pragma unroll
                    for (int bj = 0; bj < 2; ++bj) {
                        const size_t row = EPI_ROW(ai, 2 * mh + mm); const int col = EPI_COL(bj);
                        const float mean = st[mm].x, rstd = st[mm].y;
                        f32x4 v0 = acc[ai][bj][2 * mh + mm][0] + ((x0[mm][bj] - mean) * rstd) * g0[bj] + b0[bj];
                        f32x4 v1 = acc[ai][bj][2 * mh + mm][1] + ((x1[mm][bj] - mean) * rstd) * g1[bj] + b1[bj];
                        if (EXTRA) add_bf8(v0, v1, ev[mm][bj]);
                        *(f32x4*)(Xout + row * DM + col) = v0; *(f32x4*)(Xout + row * DM + col + 4) = v1;
                    }
                asm volatile("" ::: "memory");
            }
    }
};
struct EpiMulInto {
    bf16_t* P;
    DI void operator()(const f32x4 (&acc)[2][2][4][2], const Unit& u, int wr, int wc, int fr, int fq) const {
#pragma unroll
        for (int ai = 0; ai < 2; ++ai) {
            u32x4 gv[4][2];
#pragma unroll
            for (int m = 0; m < 4; ++m)
#pragma unroll
                for (int bj = 0; bj < 2; ++bj) gv[m][bj] = *(const u32x4*)(P + (size_t)EPI_ROW(ai, m) * DM + EPI_COL(bj));
#pragma unroll
            for (int m = 0; m < 4; ++m)
#pragma unroll
                for (int bj = 0; bj < 2; ++bj) {
                    f32x4 v0 = acc[ai][bj][m][0], v1 = acc[ai][bj][m][1];
                    mul_bf8(v0, v1, gv[m][bj]);
                    *(u32x4*)(P + (size_t)EPI_ROW(ai, m) * DM + EPI_COL(bj)) = pack_bf8(v0, v1);
                }
            asm volatile("" ::: "memory");
        }
    }
};

template <class Epi, class Sched>
DI void gemm_phase(LAS unsigned char* lds, const Gemm g, const Sched& S_, const Epi& E, const int wave_s) {
    int tid_ = wave_s * 64 + lane_id(); asm volatile("" : "+v"(tid_));
    const int tid = tid_, wid = __builtin_amdgcn_readfirstlane(tid >> 6), lane = tid & 63, wr = wid >> 2, wc = wid & 3, fr = lane & 15, fq = lane >> 4;
    const int K = g.K, nt = K / BK;
    unsigned voffA[2], voffB[2];
#pragma unroll
    for (int i = 0; i < 2; ++i) { int R, C; stage_rc(tid * 16 + i * 8192, R, C); const int Rb = (R & ~31) + perm32(R & 31);
        voffA[i] = (unsigned)(R * g.lda + C) * 2u; voffB[i] = (unsigned)(Rb * K + C) * 2u; }
    const size_t kstep = (size_t)(BK * 2);
    const size_t hstepA = (size_t)HALF * g.lda * 2, hstepB = (size_t)HALF * K * 2;
    const unsigned ldsw = (unsigned)wid * 1024u;
    const int aoff = lds_byte(wr * 64 + fr, fq * 8), boff = lds_byte(wc * 32 + fr, fq * 8);
#define PG8_SA(b, h) (((b) * 2 + (h)) * HTB)
#define PG8_SB(b, h) ((4 + (b) * 2 + (h)) * HTB)
#define PG8_STAGE(bufoff, gbase, voff) do { _Pragma("unroll") for (int _i = 0; _i < 2; ++_i) \
        __builtin_amdgcn_global_load_lds((const unsigned*)((const char*)(gbase) + (voff)[_i]), (LAS unsigned*)(lds + (bufoff) + ldsw + _i * 8192), 16, 0, 0); } while (0)
#define PG8_LDA(dst, b, h) do { _Pragma("unroll") for (int m = 0; m < 4; ++m) _Pragma("unroll") for (int k = 0; k < 2; ++k) dst[m][k] = *(const LAS bf16x8*)(lds + PG8_SA(b, h) + aoff + m * 2048 + k * 1024); } while (0)
#define PG8_LDB(dst, b, h) do { _Pragma("unroll") for (int n = 0; n < 2; ++n) _Pragma("unroll") for (int k = 0; k < 2; ++k) dst[n][k] = *(const LAS bf16x8*)(lds + PG8_SB(b, h) + boff + n * 2048 + k * 1024); } while (0)
#define PG8_MMA(ai, bj, At, Bt) do { __builtin_amdgcn_s_setprio(1); _Pragma("unroll") for (int m = 0; m < 4; ++m) _Pragma("unroll") for (int n = 0; n < 2; ++n) _Pragma("unroll") for (int k = 0; k < 2; ++k) \
        acc[ai][bj][m][n] = __builtin_amdgcn_mfma_f32_16x16x32_bf16(Bt[n][k], At[m][k], acc[ai][bj][m][n], 0, 0, 0); __builtin_amdgcn_s_setprio(0); } while (0)
#define PG8_WAIT_V(n) asm volatile("s_waitcnt vmcnt(" #n ")" ::: "memory")
#define PG8_WAIT_L(n) asm volatile("s_waitcnt lgkmcnt(" #n ")" ::: "memory")
#define PG8_BAR __builtin_amdgcn_s_barrier()
#define PG8_SCHED __builtin_amdgcn_sched_barrier(0)
    Unit cur, nxt; int ui = 0;
    if (!S_.next(0, cur)) return;
    f32x4 acc[2][2][4][2];
#pragma unroll
    for (int a = 0; a < 2; ++a)
#pragma unroll
        for (int b = 0; b < 2; ++b)
#pragma unroll
            for (int m = 0; m < 4; ++m)
#pragma unroll
                for (int n = 0; n < 2; ++n) acc[a][b][m][n] = (f32x4){0.f, 0.f, 0.f, 0.f};
    bf16x8 At[4][2], B0[2][2], B1[2][2];
    const char* cA = (const char*)g.A + S_.aoff(cur, g); const char* cB = (const char*)g.Bt + S_.boff(cur, g);
    PG8_STAGE(PG8_SB(0, 0), cB, voffB); PG8_STAGE(PG8_SB(0, 1), cB + hstepB, voffB); PG8_STAGE(PG8_SA(0, 0), cA, voffA); PG8_STAGE(PG8_SA(0, 1), cA + hstepA, voffA);
    if (wr == 1) PG8_BAR;
    PG8_WAIT_V(2); PG8_BAR;
    PG8_STAGE(PG8_SB(1, 0), cB + kstep, voffB); PG8_STAGE(PG8_SA(1, 0), cA + kstep, voffA); PG8_STAGE(PG8_SB(1, 1), cB + hstepB + kstep, voffB);
    PG8_WAIT_V(6); PG8_BAR;
    for (;;) {
        const bool has_next = S_.next(ui + 1, nxt);
        const char* nA = has_next ? (const char*)g.A + S_.aoff(nxt, g) : cA; const char* nB = has_next ? (const char*)g.Bt + S_.boff(nxt, g) : cB;
        for (int t = 0; t < nt; t += 2) {
            const bool last = (t == nt - 2);
            const char* a1 = cA + (size_t)(t + 1) * kstep;
            const char* a2 = last ? nA : cA + (size_t)(t + 2) * kstep; const char* b2 = last ? nB : cB + (size_t)(t + 2) * kstep;
            const char* a3 = a2 + kstep; const char* b3 = b2 + kstep;
            PG8_LDB(B0, 0, 0); PG8_LDB(B1, 0, 1); PG8_SCHED; PG8_LDA(At, 0, 0); PG8_STAGE(PG8_SA(1, 1), a1 + hstepA, voffA);
            PG8_WAIT_V(8); PG8_WAIT_L(0); PG8_BAR; PG8_MMA(0, 0, At, B0); PG8_MMA(0, 1, At, B1); PG8_BAR; PG8_SCHED;
            PG8_LDA(At, 0, 1); PG8_STAGE(PG8_SB(0, 0), b2, voffB); PG8_STAGE(PG8_SB(0, 1), b2 + hstepB, voffB); PG8_STAGE(PG8_SA(0, 0), a2, voffA);
            PG8_WAIT_V(8); PG8_WAIT_L(0); PG8_BAR; PG8_MMA(1, 0, At, B0); PG8_MMA(1, 1, At, B1); PG8_BAR; PG8_SCHED;
            PG8_LDB(B0, 1, 0); PG8_LDB(B1, 1, 1); PG8_SCHED; PG8_LDA(At, 1, 0); PG8_STAGE(PG8_SA(0, 1), a2 + hstepA, voffA);
            PG8_WAIT_V(8); PG8_WAIT_L(0); PG8_BAR; PG8_MMA(0, 0, At, B0); PG8_MMA(0, 1, At, B1); PG8_BAR; PG8_SCHED;
            PG8_LDA(At, 1, 1); PG8_STAGE(PG8_SB(1, 0), b3, voffB); PG8_STAGE(PG8_SB(1, 1), b3 + hstepB, voffB); PG8_STAGE(PG8_SA(1, 0), a3, voffA);
            PG8_WAIT_V(8); PG8_WAIT_L(0); PG8_BAR; PG8_MMA(1, 0, At, B0); PG8_MMA(1, 1, At, B1); PG8_BAR; PG8_SCHED;
        }
        if (wr == 0) PG8_BAR;
        { const int l2 = lane_id(); E(acc, cur, wr, wc, l2 & 15, l2 >> 4); }
        if (!has_next) break;
#pragma unroll
        for (int a = 0; a < 2; ++a)
#pragma unroll
            for (int b = 0; b < 2; ++b)
#pragma unroll
                for (int m = 0; m < 4; ++m)
#pragma unroll
                    for (int n = 0; n < 2; ++n) acc[a][b][m][n] = (f32x4){0.f, 0.f, 0.f, 0.f};
        cur = nxt; cA = nA; cB = nB; ++ui;
        if (wr == 1) PG8_BAR;
    }
    PG8_WAIT_V(0);
    PG8_BAR;
#undef PG8_SA
#undef PG8_SB
#undef PG8_STAGE
#undef PG8_LDA
#undef PG8_LDB
#undef PG8_MMA
#undef PG8_WAIT_V
#undef PG8_WAIT_L
#undef PG8_BAR
#undef PG8_SCHED
}
}

struct AttnP {
    const bf16_t* ZQ; const bf16_t* QM; const bf16_t* KVM; const bf16_t* KR; bf16_t* Y; bf16_t* ZQw; float* LSE;
    const float* LUTS; const float* LUTD; const float* rpb; const float* sink; const float* COS;
};
constexpr int A_VP = 144, A_LUT = 114688, A_WSF = A_LUT + 2048, A_END = A_WSF + 2048;

DI void glds16(const void* gsrc, unsigned lds_dst) { unsigned keep;
    asm volatile("s_mov_b32 %0, m0\n\ts_mov_b32 m0, %2\n\ts_nop 0\n\tglobal_load_lds_dwordx4 %1, off\n\ts_mov_b32 m0, %0" : "=&s"(keep) : "v"(gsrc), "s"(lds_dst) : "memory"); }
DI void glds16s(unsigned voff, const void* sbase, unsigned lds_dst) { unsigned keep;
    const unsigned long long sb = (unsigned long long)sbase;
    const unsigned blo = __builtin_amdgcn_readfirstlane((unsigned)sb), bhi = __builtin_amdgcn_readfirstlane((unsigned)(sb >> 32));
    const unsigned long long sbu = ((unsigned long long)bhi << 32) | blo;
    asm volatile("s_mov_b32 %0, m0\n\ts_mov_b32 m0, %3\n\ts_nop 0\n\tglobal_load_lds_dwordx4 %1, %2\n\ts_mov_b32 m0, %0" : "=&s"(keep) : "v"(voff), "s"(sbu), "s"(lds_dst) : "memory"); }
template <int VAR> DI void attn_unit(LAS unsigned char* lds, const AttnP& P, const int u, const int wave_s) {
    constexpr int NKS = (VAR == 0) ? 6 : 4, QB = (VAR == 0) ? 2 : 1, QPW = 32 * QB;
    constexpr int A_TK = (VAR == 0) ? 128 : (VAR == 1 ? 256 : 384), NBUF = (VAR == 0) ? 2 : 1, A_KP = (VAR == 0) ? 208 : 144, NLD = A_TK / 64;
    constexpr int A_KB = 0, A_VB = (VAR == 0) ? 2 * 24576 : NBUF * A_TK * A_KP;
    static_assert(A_VB + ((VAR == 0) ? 2 * 16384 : NBUF * A_TK * A_VP) <= A_LUT, "attention tiles vs LDS map");
    int tid_ = wave_s * 64 + lane_id(); asm volatile("" : "+v"(tid_));
    const int tid = tid_, lane = tid & 63, r32 = lane & 31, hi = lane >> 5, w = __builtin_amdgcn_readfirstlane(tid >> 6);
    LAS float* LUT = (LAS float*)(lds + A_LUT);
    LAS float* WSF = (LAS float*)(lds + A_WSF) + w * 64;
    int b, h, qt, g = 0, r = 1, res = 0, L = S, j0 = 0;
    if (VAR == 0) { qt = u & 15; h = (u >> 4) & 3; b = u >> 6; j0 = 512 * qt; }
    else if (VAR == 3) { qt = u & 31; h = (u >> 5) & 3; b = u / 384; g = (u >> 7) % 3; r = (g == 0) ? 1 : (g == 1 ? 4 : 16); L = S / r; const int tpr = 32 / r; res = qt / tpr; j0 = 256 * (qt % tpr); }
    else { qt = u & 31; h = (u >> 5) & 3; b = u >> 7; j0 = 256 * qt; }
    const size_t tb = (size_t)b * S;
    const int qw = j0 + QPW * w;
    if (VAR == 1) { for (int i = tid; i < 257; i += 512) LUT[i] = P.LUTS[h * 260 + i]; }
    if (VAR == 2) { for (int i = tid; i < 465; i += 512) LUT[i] = P.rpb[h * 465 + i] * LOG2E; }
    if (VAR == 3) { for (int i = tid; i < 129; i += 512) LUT[i] = P.LUTD[(g * 4 + h) * 132 + i]; }
    bf16x8 qf[QB][NKS];
#pragma unroll
    for (int qb = 0; qb < QB; ++qb) {
        const int qi = qw + 32 * qb + r32;
        const bf16_t* qp;
        if (VAR == 0) qp = P.QM + (tb + qi) * 384 + h * 96;
        else if (VAR == 1) qp = P.ZQ + (tb + qi) * ZC + C_BQ + h * 64;
        else if (VAR == 2) qp = P.ZQ + (tb + qi) * ZC + C_CQ + h * 64;
        else qp = P.ZQ + (tb + res + (size_t)r * qi) * ZC + C_DQ + g * 256 + h * 64;
#pragma unroll
        for (int ks = 0; ks < NKS; ++ks) qf[qb][ks] = *(const bf16x8*)(qp + 16 * ks + 8 * hi);
        if (VAR == 0) {
            const float* cp = P.COS + qi * 16 + 8 * hi; const float* sp = cp + S * 16;
            const f32x4 c0 = *(const f32x4*)cp, c1 = *(const f32x4*)(cp + 4), s0 = *(const f32x4*)sp, s1 = *(const f32x4*)(sp + 4);
            const u32x4 a4 = __builtin_bit_cast(u32x4, qf[qb][4]), a5 = __builtin_bit_cast(u32x4, qf[qb][5]);
            u32x4 o4, o5;
#define ROPE2(k, ca, cb, sa, sb) { const float x1l = bf_lo(a4[k]), x1h = bf_hi(a4[k]), x2l = bf_lo(a5[k]), x2h = bf_hi(a5[k]); \
                o4[k] = cvt_pk(x1l * ca - x2l * sa, x1h * cb - x2h * sb); o5[k] = cvt_pk(x1l * sa + x2l * ca, x1h * sb + x2h * cb); }
            ROPE2(0, c0[0], c0[1], s0[0], s0[1]) ROPE2(1, c0[2], c0[3], s0[2], s0[3]) ROPE2(2, c1[0], c1[1], s1[0], s1[1]) ROPE2(3, c1[2], c1[3], s1[2], s1[3])
#undef ROPE2
            qf[qb][4] = __builtin_bit_cast(bf16x8, o4); qf[qb][5] = __builtin_bit_cast(bf16x8, o5);
        }
    }
    int NT, kfirst;
    if (VAR == 0) { NT = S / A_TK; kfirst = 0; }
    else if (VAR == 1) { NT = 2; kfirst = j0 - 128; }
    else if (VAR == 2) { const int f = min(max(4 * qt - 4, 0), 120); NT = 2; kfirst = 64 * f; }
    else { NT = 1; kfirst = j0 - 64; }
    float m_run[QB], l_run[QB];
    f32x16 o[QB][2];
#pragma unroll
    for (int qb = 0; qb < QB; ++qb) {
        m_run[qb] = (VAR == 0) ? 0.f : -1e30f; l_run[qb] = 0.f;
        if (VAR == 1) { m_run[qb] = P.sink[h] * LOG2E; l_run[qb] = (hi == 0) ? 1.0f : 0.0f; }
#pragma unroll
        for (int i = 0; i < 16; ++i) { o[qb][0][i] = 0.f; o[qb][1][i] = 0.f; }
    }
    const float c2 = 0.125f * LOG2E;
    const int qrow = (qw >> 6), qc = (qw & 63) + r32;
    const int r0 = min(max(qrow - 4, 0), 120), cs = min(max(qc - 8, 0), 48);
    const int srow = tid >> 3, sch = tid & 7, srow2 = tid >> 2, sch2 = tid & 3;
    u32x4 kreg[NLD], vreg[NLD], rreg;
    auto load_tile = [&](int t) {
#pragma unroll
        for (int i = 0; i < NLD; ++i) {
            const int kidx = kfirst + A_TK * t + srow + 64 * i;
            if (VAR == 0) {
                const bf16_t* kp = P.KVM + (tb + kidx) * 512 + h * 128 + sch * 8;
                kreg[i] = *(const u32x4*)kp; vreg[i] = *(const u32x4*)(kp + 64);
            } else if (VAR == 1) {
                const int kc = min(max(kidx, 0), S - 1); const bf16_t* base = P.ZQ + (tb + kc) * ZC + (h >> 1) * 64 + sch * 8;
                kreg[i] = *(const u32x4*)(base + C_BK); vreg[i] = *(const u32x4*)(base + C_BV);
            } else if (VAR == 2) {
                const int kc = min(kidx, S - 1); const bf16_t* base = P.ZQ + (tb + kc) * ZC + h * 64 + sch * 8;
                kreg[i] = *(const u32x4*)(base + C_CK); vreg[i] = *(const u32x4*)(base + C_CV);
            } else {
                const int kc = min(max(kidx, 0), L - 1); const bf16_t* base = P.ZQ + (tb + res + (size_t)r * kc) * ZC + g * 256 + h * 64 + sch * 8;
                kreg[i] = *(const u32x4*)(base + C_DK); vreg[i] = *(const u32x4*)(base + C_DV);
            }
        }
        if (VAR == 0) rreg = *(const u32x4*)(P.KR + (tb + kfirst + A_TK * t + srow2) * 32 + sch2 * 8);
    };
    auto store_tile = [&](int buf) {
#pragma unroll
        for (int i = 0; i < NLD; ++i) {
            *(LAS u32x4*)(lds + A_KB + buf * A_TK * A_KP + (srow + 64 * i) * A_KP + sch * 16) = kreg[i];
            *(LAS u32x4*)(lds + A_VB + buf * A_TK * A_VP + (srow + 64 * i) * A_VP + sch * 16) = vreg[i];
        }
        if (VAR == 0) *(LAS u32x4*)(lds + A_KB + buf * A_TK * A_KP + srow2 * A_KP + 128 + sch2 * 16) = rreg;
    };
    const unsigned lds_base = (unsigned)(size_t)lds;
    const unsigned dl_k = (unsigned)((lane & 31) * 1024 + (lane >> 5) * 16), dl_r = (unsigned)((lane & 31) * 64 + (lane >> 5) * 16),
                   dl_v = (unsigned)((lane >> 3) * 1024 + (((lane & 7) ^ ((lane >> 3) & 7)) << 4));
    auto dma_tile = [&](int t, int buf) {
        const size_t krow0 = tb + kfirst + A_TK * t;
#pragma unroll
        for (int q = 0; q < 3; ++q) {
            const int i = w + 8 * q, sbk = i / 6, cp = i % 6;
            const unsigned dst = (unsigned)__builtin_amdgcn_readfirstlane((int)(lds_base + A_KB + buf * 24576 + (sbk * 12 + 2 * cp) * 512));
            if (cp < 4) glds16s(dl_k, P.KVM + (krow0 + 32 * sbk) * 512 + h * 128 + 16 * cp, dst);
            else        glds16s(dl_r, P.KR + (krow0 + 32 * sbk) * 32 + 16 * (cp - 4), dst);
        }
#pragma unroll
        for (int q = 0; q < 2; ++q) {
            const int j = w + 8 * q;
            glds16s(dl_v, P.KVM + (krow0 + 8 * j) * 512 + h * 128 + 64, (unsigned)__builtin_amdgcn_readfirstlane((int)(lds_base + A_VB + buf * 16384 + j * 1024)));
        }
    };
    if constexpr (VAR == 0) { dma_tile(0, 0); asm volatile("s_waitcnt vmcnt(0)" ::: "memory"); } else { load_tile(0); store_tile(0); }
    __syncthreads();
    const int tq = lane & 15, tq_q = tq >> 2, tq_p = tq & 3, blk = (lane >> 4) & 1;
    float mxt[QB];
    if (VAR == 0) {
#pragma unroll
        for (int qb = 0; qb < QB; ++qb) {
            f32x16 s0;
#pragma unroll
            for (int i = 0; i < 16; ++i) s0[i] = 0.f;
#pragma unroll
            for (int ks = 0; ks < NKS; ++ks) {
                const bf16x8 kf = *(LAS const bf16x8*)(lds + A_KB + ((2 * ks + hi) * 32 + r32) * 16);
                s0 = __builtin_amdgcn_mfma_f32_32x32x16_bf16(kf, qf[qb][ks], s0, 0, 0, 0);
            }
            float mx = s0[0];
#pragma unroll
            for (int i = 1; i < 16; ++i) mx = fmaxf(mx, s0[i]);
            m_run[qb] = xhalf_max(mx); mxt[qb] = -INFINITY;
        }
    }
    f32x16 negm;
#pragma unroll
    for (int i = 0; i < 16; ++i) negm[i] = -fmaxf(m_run[0], m_run[QB - 1]);
    auto mla_tile = [&](const int buf) {
#define SBAR0() __builtin_amdgcn_sched_barrier(0)
#define PINV(x) asm volatile("" : "+v"(x))
#define EX(v, i) v[i] = __builtin_amdgcn_exp2f(v[i])
            LAS const unsigned char* Kt = lds + A_KB + buf * 24576 + (hi * 32 + r32) * 16;
            LAS const unsigned char* Vt = lds + A_VB + buf * 16384 + (4 * hi + tq_q) * 128 + 8 * (tq_p & 1);
            const int vsw = (4 * hi + tq_q) & 7, vch = 2 * blk + (tq_p >> 1);
            f32x16 sc0 = negm, sc1 = negm, sn0, sn1;
#pragma unroll
            for (int ks = 0; ks < NKS; ++ks) {
                const bf16x8 kfx = *(LAS const bf16x8*)(Kt + 1024 * ks);
                sc0 = __builtin_amdgcn_mfma_f32_32x32x16_bf16(kfx, qf[0][ks], sc0, 0, 0, 0);
                sc1 = __builtin_amdgcn_mfma_f32_32x32x16_bf16(kfx, qf[1][ks], sc1, 0, 0, 0);
            }
            SBAR0();
#pragma unroll
            for (int sb = 0; sb < A_TK / 32; ++sb) {
                if (sb + 1 < A_TK / 32) {
                    LAS const unsigned char* Kn = Kt + (sb + 1) * 6144;
                    bf16x8 k0 = *(LAS const bf16x8*)(Kn), k1 = *(LAS const bf16x8*)(Kn + 1024), k2 = *(LAS const bf16x8*)(Kn + 2048);
                    SBAR0();
                    sn0 = __builtin_amdgcn_mfma_f32_32x32x16_bf16(k0, qf[0][0], negm, 0, 0, 0); EX(sc0, 0); EX(sc0, 1); EX(sc0, 2); PINV(sc0); SBAR0();
                    sn1 = __builtin_amdgcn_mfma_f32_32x32x16_bf16(k0, qf[1][0], negm, 0, 0, 0); EX(sc1, 0); EX(sc1, 1); EX(sc1, 2); PINV(sc1); SBAR0();
                    k0 = *(LAS const bf16x8*)(Kn + 3072);
                    sn0 = __builtin_amdgcn_mfma_f32_32x32x16_bf16(k1, qf[0][1], sn0, 0, 0, 0);  EX(sc0, 3); EX(sc0, 4); EX(sc0, 5); PINV(sc0); SBAR0();
                    sn1 = __builtin_amdgcn_mfma_f32_32x32x16_bf16(k1, qf[1][1], sn1, 0, 0, 0);  EX(sc1, 3); EX(sc1, 4); EX(sc1, 5); PINV(sc1); SBAR0();
                    k1 = *(LAS const bf16x8*)(Kn + 4096);
                    sn0 = __builtin_amdgcn_mfma_f32_32x32x16_bf16(k2, qf[0][2], sn0, 0, 0, 0);  EX(sc0, 6); EX(sc0, 7); EX(sc0, 8); PINV(sc0); SBAR0();
                    sn1 = __builtin_amdgcn_mfma_f32_32x32x16_bf16(k2, qf[1][2], sn1, 0, 0, 0);  EX(sc1, 6); EX(sc1, 7); EX(sc1, 8); PINV(sc1); SBAR0();
                    k2 = *(LAS const bf16x8*)(Kn + 5120);
                    sn0 = __builtin_amdgcn_mfma_f32_32x32x16_bf16(k0, qf[0][3], sn0, 0, 0, 0);  EX(sc0, 9); EX(sc0, 10); EX(sc0, 11); PINV(sc0); SBAR0();
                    sn1 = __builtin_amdgcn_mfma_f32_32x32x16_bf16(k0, qf[1][3], sn1, 0, 0, 0);  EX(sc1, 9); EX(sc1, 10); EX(sc1, 11); PINV(sc1); SBAR0();
                    sn0 = __builtin_amdgcn_mfma_f32_32x32x16_bf16(k1, qf[0][4], sn0, 0, 0, 0);  EX(sc0, 12); EX(sc0, 13); PINV(sc0); SBAR0();
                    sn1 = __builtin_amdgcn_mfma_f32_32x32x16_bf16(k1, qf[1][4], sn1, 0, 0, 0);  EX(sc1, 12); EX(sc1, 13); PINV(sc1); SBAR0();
                    sn0 = __builtin_amdgcn_mfma_f32_32x32x16_bf16(k2, qf[0][5], sn0, 0, 0, 0);  EX(sc0, 14); EX(sc0, 15); PINV(sc0); SBAR0();
                    sn1 = __builtin_amdgcn_mfma_f32_32x32x16_bf16(k2, qf[1][5], sn1, 0, 0, 0);  EX(sc1, 14); EX(sc1, 15); PINV(sc1); SBAR0();
                } else {
#pragma unroll
                    for (int i = 0; i < 16; ++i) { EX(sc0, i); EX(sc1, i); }
                    SBAR0();
                }
                u32x4 pa0, pa1, pb0, pb1;
                pa0.x = cvt_pk(sc0[0], sc0[1]); pa0.y = cvt_pk(sc0[2], sc0[3]); pa0.z = cvt_pk(sc0[4], sc0[5]); pa0.w = cvt_pk(sc0[6], sc0[7]);
                pa1.x = cvt_pk(sc0[8], sc0[9]); pa1.y = cvt_pk(sc0[10], sc0[11]); pa1.z = cvt_pk(sc0[12], sc0[13]); pa1.w = cvt_pk(sc0[14], sc0[15]);
                pb0.x = cvt_pk(sc1[0], sc1[1]); pb0.y = cvt_pk(sc1[2], sc1[3]); pb0.z = cvt_pk(sc1[4], sc1[5]); pb0.w = cvt_pk(sc1[6], sc1[7]);
                pb1.x = cvt_pk(sc1[8], sc1[9]); pb1.y = cvt_pk(sc1[10], sc1[11]); pb1.z = cvt_pk(sc1[12], sc1[13]); pb1.w = cvt_pk(sc1[14], sc1[15]);
                const bf16x8 pf00 = __builtin_bit_cast(bf16x8, pa0), pf01 = __builtin_bit_cast(bf16x8, pa1), pf10 = __builtin_bit_cast(bf16x8, pb0), pf11 = __builtin_bit_cast(bf16x8, pb1);
                float ps0 = l_run[0], ps1 = l_run[1];
#pragma unroll
                for (int d0 = 0; d0 < 2; ++d0)
#pragma unroll
                    for (int ss = 0; ss < 2; ++ss) {
                        LAS const unsigned char* vp = Vt + (32 * sb + 16 * ss) * 128 + (((4 * d0 + vch) ^ vsw) << 4);
                        const s16x4 lo = __builtin_amdgcn_ds_read_tr16_b64_v4i16((LAS s16x4*)vp);
                        const s16x4 hh = __builtin_amdgcn_ds_read_tr16_b64_v4i16((LAS s16x4*)(vp + 8 * 128));
                        const bf16x8 vfx = (bf16x8){lo[0], lo[1], lo[2], lo[3], hh[0], hh[1], hh[2], hh[3]};
                        o[0][d0] = __builtin_amdgcn_mfma_f32_32x32x16_bf16(ss == 0 ? pf00 : pf01, vfx, o[0][d0], 0, 0, 0);
                        o[1][d0] = __builtin_amdgcn_mfma_f32_32x32x16_bf16(ss == 0 ? pf10 : pf11, vfx, o[1][d0], 0, 0, 0);
                        const int q4 = 4 * (2 * d0 + ss);
                        ps0 += sc0[q4]; ps0 += sc0[q4 + 1]; ps0 += sc0[q4 + 2]; ps0 += sc0[q4 + 3];
                        ps1 += sc1[q4]; ps1 += sc1[q4 + 1]; ps1 += sc1[q4 + 2]; ps1 += sc1[q4 + 3];
                    }
                l_run[0] = ps0; l_run[1] = ps1;
                if (sb + 1 < A_TK / 32) { sc0 = sn0; sc1 = sn1; }
                SBAR0();
            }
#undef SBAR0
#undef PINV
#undef EX
            if (__any(fmaxf(l_run[0], l_run[1]) > 1.8446744e19f)) {
                const float dn = 5.421010862427522e-20f;
                l_run[0] *= dn; l_run[1] *= dn;
#pragma unroll
                for (int i = 0; i < 16; ++i) { o[0][0][i] *= dn; o[0][1][i] *= dn; o[1][0][i] *= dn; o[1][1][i] *= dn; negm[i] -= 64.0f; }
            }
    };
#define LDS_BAR() asm volatile("s_waitcnt lgkmcnt(0)\n\ts_barrier" ::: "memory")
    if constexpr (VAR == 0) {
        for (int t = 0; t < NT; ++t) {
            if (t + 1 < NT) dma_tile(t + 1, (t + 1) & 1);
            mla_tile(t & 1);
            asm volatile("s_waitcnt vmcnt(0)" ::: "memory");
            LDS_BAR();
        }
    } else
    for (int t = 0; t < NT; ++t) {
        if (t + 1 < NT) load_tile(t + 1);
        const int buf = (NBUF == 2) ? (t & 1) : 0;
        if constexpr (VAR == 0) { mla_tile(buf); } else
#pragma unroll 2
        for (int sb = 0; sb < A_TK / 32; ++sb) {
            const int kb = kfirst + A_TK * t + 32 * sb;
            bool act = true;
            if (VAR == 1) act = (kb + 31 >= max(qw - 128, 0)) && (kb <= min(qw + 159, S - 1));
            if (VAR == 2) { const int kr = kb >> 6; act = (kr >= r0) && (kr < r0 + 8); }
            if (VAR == 3) act = (kb + 31 >= max(qw - 64, 0)) && (kb <= min(qw + 95, L - 1));
            if (!act) continue;
            LAS const unsigned char* Kb = lds + A_KB + buf * A_TK * A_KP + (32 * sb) * A_KP;
            LAS const unsigned char* Vb = lds + A_VB + buf * A_TK * A_VP + (32 * sb) * A_VP;
            f32x16 s[QB];
#pragma unroll
            for (int qb = 0; qb < QB; ++qb)
#pragma unroll
                for (int i = 0; i < 16; ++i) s[qb][i] = (VAR == 0) ? -m_run[qb] : 0.f;
#pragma unroll
            for (int ks = 0; ks < NKS; ++ks) {
                const bf16x8 kf = *(LAS const bf16x8*)(Kb + r32 * A_KP + (16 * ks + 8 * hi) * 2);
#pragma unroll
                for (int qb = 0; qb < QB; ++qb) s[qb] = __builtin_amdgcn_mfma_f32_32x32x16_bf16(kf, qf[qb][ks], s[qb], 0, 0, 0);
            }
            bf16x8 pf[QB][2];
#pragma unroll
            for (int qb = 0; qb < QB; ++qb) {
                if (VAR == 1 || VAR == 3) {
                    const int HALFW = (VAR == 1) ? 128 : 64, LL = (VAR == 1) ? S : L;
                    const int qpos = qw + r32;
#pragma unroll
                    for (int i = 0; i < 16; ++i) {
                        const int kp = kb + crow(i, hi), rel = kp - qpos;
                        const bool ok = (rel >= -HALFW) && (rel <= HALFW) && (kp >= 0) && (kp < LL);
                        const int idx = min(max(rel + HALFW, 0), 2 * HALFW);
                        s[qb][i] = ok ? (s[qb][i] * c2 + LUT[idx]) : -INFINITY;
                    }
                }
                if (VAR == 2) {
                    const int dr = (kb >> 6) - qrow + 7;
#pragma unroll
                    for (int i = 0; i < 16; ++i) {
                        const int ck = (kb & 63) + crow(i, hi), d = ck - qc;
                        const bool ok = (ck >= cs) && (ck < cs + 16);
                        const int idx = dr * 31 + min(max(d + 15, 0), 30);
                        s[qb][i] = ok ? (s[qb][i] * c2 + LUT[idx]) : -INFINITY;
                    }
                }
                float mx = s[qb][0];
#pragma unroll
                for (int i = 1; i < 16; ++i) mx = fmaxf(mx, s[qb][i]);
                if (VAR == 0) mxt[qb] = fmaxf(mxt[qb], mx);
                else {
                mx = xhalf_max(mx);
                const float mnew = fmaxf(m_run[qb], mx);
                if (__any(mnew != m_run[qb])) {
                    const float al = __builtin_amdgcn_exp2f(m_run[qb] - mnew);
                    l_run[qb] *= al; m_run[qb] = mnew;
                    if (hi == 0) WSF[32 * qb + r32] = al;
                    __builtin_amdgcn_fence(__ATOMIC_RELEASE, "wavefront"); __builtin_amdgcn_wave_barrier(); __builtin_amdgcn_fence(__ATOMIC_ACQUIRE, "wavefront");
#pragma unroll
                    for (int i = 0; i < 16; ++i) { const float al2 = WSF[32 * qb + crow(i, hi)]; o[qb][0][i] *= al2; o[qb][1][i] *= al2; }
                    __builtin_amdgcn_fence(__ATOMIC_RELEASE, "wavefront"); __builtin_amdgcn_wave_barrier(); __builtin_amdgcn_fence(__ATOMIC_ACQUIRE, "wavefront");
                }
                }
                float ps = 0.f;
#pragma unroll
                for (int i = 0; i < 16; ++i) { s[qb][i] = __builtin_amdgcn_exp2f((VAR == 0) ? s[qb][i] : s[qb][i] - m_run[qb]); ps += s[qb][i]; }
                l_run[qb] += ps;
                u32x4 pw0, pw1;
                pw0.x = cvt_pk(s[qb][0], s[qb][1]); pw0.y = cvt_pk(s[qb][2], s[qb][3]); pw0.z = cvt_pk(s[qb][4], s[qb][5]); pw0.w = cvt_pk(s[qb][6], s[qb][7]);
                pw1.x = cvt_pk(s[qb][8], s[qb][9]); pw1.y = cvt_pk(s[qb][10], s[qb][11]); pw1.z = cvt_pk(s[qb][12], s[qb][13]); pw1.w = cvt_pk(s[qb][14], s[qb][15]);
                pf[qb][0] = __builtin_bit_cast(bf16x8, pw0); pf[qb][1] = __builtin_bit_cast(bf16x8, pw1);
            }
#pragma unroll
            for (int d0 = 0; d0 < 2; ++d0) {
#pragma unroll
                for (int ss = 0; ss < 2; ++ss) {
                    LAS const unsigned char* vp = Vb + (16 * ss + 4 * hi + tq_q) * A_VP + (32 * d0 + 16 * blk + 4 * tq_p) * 2;
                    const s16x4 lo = __builtin_amdgcn_ds_read_tr16_b64_v4i16((LAS s16x4*)vp);
                    const s16x4 hh = __builtin_amdgcn_ds_read_tr16_b64_v4i16((LAS s16x4*)(vp + 8 * A_VP));
                    const bf16x8 vf = (bf16x8){lo[0], lo[1], lo[2], lo[3], hh[0], hh[1], hh[2], hh[3]};
#pragma unroll
                    for (int qb = 0; qb < QB; ++qb) o[qb][d0] = __builtin_amdgcn_mfma_f32_32x32x16_bf16(pf[qb][ss], vf, o[qb][d0], 0, 0, 0);
                }
            }
        }
        if (VAR == 0) {
#pragma unroll
            for (int qb = 0; qb < QB; ++qb) {
                if (__any(mxt[qb] > 64.0f)) {
                    const float dl = fmaxf(xhalf_max(mxt[qb]), 0.f), al = __builtin_amdgcn_exp2f(-dl);
                    l_run[qb] *= al; m_run[qb] += dl;
                    if (hi == 0) WSF[32 * qb + r32] = al;
                    __builtin_amdgcn_fence(__ATOMIC_RELEASE, "wavefront"); __builtin_amdgcn_wave_barrier(); __builtin_amdgcn_fence(__ATOMIC_ACQUIRE, "wavefront");
#pragma unroll
                    for (int i = 0; i < 16; ++i) { const float al2 = WSF[32 * qb + crow(i, hi)]; o[qb][0][i] *= al2; o[qb][1][i] *= al2; }
                    __builtin_amdgcn_fence(__ATOMIC_RELEASE, "wavefront"); __builtin_amdgcn_wave_barrier(); __builtin_amdgcn_fence(__ATOMIC_ACQUIRE, "wavefront");
                }
                mxt[qb] = -INFINITY;
            }
        }
        if (NBUF == 2) { if (t + 1 < NT) store_tile((t + 1) & 1); }
        else if (t + 1 < NT) { __syncthreads(); store_tile(0); }
        __syncthreads();
    }
#pragma unroll
    for (int qb = 0; qb < QB; ++qb) {
        const float lt = xhalf_sum(l_run[qb]);
        if (hi == 0) WSF[32 * qb + r32] = 1.0f / lt;
        if (VAR == 3) { if (hi == 0) P.LSE[(tb + res + (size_t)r * (qw + r32)) * 12 + g * 4 + h] = m_run[qb] + __builtin_amdgcn_logf(lt); }
    }
    __builtin_amdgcn_fence(__ATOMIC_RELEASE, "wavefront"); __builtin_amdgcn_wave_barrier(); __builtin_amdgcn_fence(__ATOMIC_ACQUIRE, "wavefront");
#pragma unroll
    for (int qb = 0; qb < QB; ++qb) {
#pragma unroll
        for (int i = 0; i < 16; ++i) {
            const int qi = qw + 32 * qb + crow(i, hi); const float al = WSF[32 * qb + crow(i, hi)];
            bf16_t* op;
            if (VAR == 3) op = P.ZQw + (tb + res + (size_t)r * qi) * ZC + C_DQ + g * 256 + h * 64;
            else op = P.Y + (tb + qi) * DM + VAR * 256 + h * 64;
            const unsigned a0 = cvt_pk(o[qb][0][i] * al, 0.f), a1 = cvt_pk(o[qb][1][i] * al, 0.f);
            op[r32] = (bf16_t)(a0 & 0xffffu); op[32 + r32] = (bf16_t)(a1 & 0xffffu);
        }
    }
    __syncthreads();
}

DI int t5_bucket(int rel) {
    const int n = rel < 0 ? -rel : rel;
    const int v = n < 8 ? n : 8 + (n >= 15) + (n >= 27) + (n >= 50) + (n >= 91) + (n >= 166) + (n >= 305) + (n >= 559);
    return (rel > 0 ? 16 : 0) + v;
}
DI void transpose_item(const float* W, int ldw, int coff, const float* kscale, bf16_t* WT, int ldt, LAS float* scr, int kb, int nb, int lane) {
    const int k0 = 64 * kb, n0 = 32 * nb;
    const int rr = lane >> 3, c4 = 4 * (lane & 7);
    f32x4 v[8];
#pragma unroll
    for (int i = 0; i < 8; ++i) v[i] = *(const f32x4*)(W + (size_t)(k0 + 8 * i + rr) * ldw + coff + n0 + c4);
#pragma unroll
    for (int i = 0; i < 8; ++i) {
        const int kk = 8 * i + rr; f32x4 x = v[i];
        if (kscale) x = x * kscale[k0 + kk];
        LAS float* d = scr + kk * 33 + c4; d[0] = x.x; d[1] = x.y; d[2] = x.z; d[3] = x.w;
    }
    __builtin_amdgcn_fence(__ATOMIC_RELEASE, "wavefront"); __builtin_amdgcn_wave_barrier(); __builtin_amdgcn_fence(__ATOMIC_ACQUIRE, "wavefront");
    const int c = lane & 7;
#pragma unroll
    for (int j = 0; j < 4; ++j) { const int n = (lane >> 3) + 8 * j; const LAS float* s = scr + (8 * c) * 33 + n;
        u32x4 o; o.x = cvt_pk(s[0 * 33], s[1 * 33]); o.y = cvt_pk(s[2 * 33], s[3 * 33]); o.z = cvt_pk(s[4 * 33], s[5 * 33]); o.w = cvt_pk(s[6 * 33], s[7 * 33]);
        *(u32x4*)(WT + (size_t)(n0 + n) * ldt + k0 + 8 * c) = o; }
    __builtin_amdgcn_fence(__ATOMIC_RELEASE, "wavefront"); __builtin_amdgcn_wave_barrier(); __builtin_amdgcn_fence(__ATOMIC_ACQUIRE, "wavefront");
}
DI void transpose_mat(const float* W, int K, int N, int ldw, int coff, const float* kscale, bf16_t* WT, int ldt, LAS float* scr, int gw, int NGW, int lane) {
    const int nblk = N / 32, items = (K / 64) * nblk;
    for (int it = gw; it < items; it += NGW) transpose_item(W, ldw, coff, kscale, WT, ldt, scr, it / nblk, it % nblk, lane);
}
template <int RN> DI void ln_rows(const float* in, float* outf, bf16_t* outb, float* stat, const float* gam, const float* bet, int lane) {
    f32x4 v[RN][4]; float mean[RN], rstd[RN];
#pragma unroll
    for (int r = 0; r < RN; ++r)
#pragma unroll
        for (int j = 0; j < 4; ++j) v[r][j] = ((const f32x4*)(in + (size_t)r * DM))[lane + 64 * j];
#pragma unroll
    for (int r = 0; r < RN; ++r) { float s = 0.f;
#pragma unroll
        for (int j = 0; j < 4; ++j) s += (v[r][j].x + v[r][j].y) + (v[r][j].z + v[r][j].w);
        mean[r] = s; }
#pragma unroll
    for (int r = 0; r < RN; ++r) mean[r] = wave_sum(mean[r]);
#pragma unroll
    for (int r = 0; r < RN; ++r) { mean[r] *= (1.f / DM); float s2 = 0.f;
#pragma unroll
        for (int j = 0; j < 4; ++j) { v[r][j] = v[r][j] - mean[r]; s2 += (v[r][j].x * v[r][j].x + v[r][j].y * v[r][j].y) + (v[r][j].z * v[r][j].z + v[r][j].w * v[r][j].w); }
        rstd[r] = s2; }
#pragma unroll
    for (int r = 0; r < RN; ++r) rstd[r] = wave_sum(rstd[r]);
#pragma unroll
    for (int r = 0; r < RN; ++r) { rstd[r] = 1.0f / sqrtf(rstd[r] * (1.f / DM) + 1e-5f); if (stat && lane == 0) { stat[2 * r] = mean[r]; stat[2 * r + 1] = rstd[r]; } }
#pragma unroll
    for (int j = 0; j < 4; ++j) {
        const f32x4 gg = ((const f32x4*)gam)[lane + 64 * j], bb = ((const f32x4*)bet)[lane + 64 * j];
#pragma unroll
        for (int r = 0; r < RN; ++r) {
            const f32x4 y = v[r][j] * rstd[r] * gg + bb;
            if (outf) ((f32x4*)(outf + (size_t)r * DM))[lane + 64 * j] = y;
            if (outb) { u32x2 w2; w2.x = cvt_pk(y.x, y.y); w2.y = cvt_pk(y.z, y.w); ((u32x2*)(outb + (size_t)r * DM))[lane + 64 * j] = w2; }
        }
    }
}

#define XB_TMO      128
#define XB_XCNT(j)  (256  + 64 * (j))
#define XB_XSUB(j)  (1280 + 64 * (j))
#define XB_XGEN(j)  (2304 + 64 * (j))
#define XB_TOP      3328
#define XB_TOPGEN   3392
#define XCD_BAR_WORDS 3456
#define XB_SPIN_CAP (1u << 20)
DI unsigned xb_ld(unsigned* p)              { return __hip_atomic_load(p, __ATOMIC_RELAXED, __HIP_MEMORY_SCOPE_AGENT); }
DI unsigned xb_add(unsigned* p, unsigned v) { return __hip_atomic_fetch_add(p, v, __ATOMIC_RELAXED, __HIP_MEMORY_SCOPE_AGENT); }
DI unsigned xb_xcc_id() { return (unsigned)__builtin_amdgcn_s_getreg((3 << 11) | 20) & 0xFu; }
#define XB_SPIN(cond, bar) do { unsigned _sp = 0; while (cond) { __builtin_amdgcn_s_sleep(1); \
    if ((++_sp & 255u) == 0u) { if (xb_ld(&(bar)[XB_TMO])) break; if (_sp > XB_SPIN_CAP) { atomicAdd(&(bar)[XB_TMO], 1u); break; } } } } while (0)
DI void xcd_barrier_complete(unsigned* bar, unsigned x, unsigned& nloc, unsigned& nx) {
    const unsigned G = gridDim.x;
    unsigned sum, cnt, mine, sp = 0u;
    for (;;) {
        sum = 0u; cnt = 0u; mine = 0u;
#pragma unroll
        for (unsigned j = 0; j < 16; ++j) { const unsigned c = xb_ld(&bar[XB_XCNT(j)]); sum += c; cnt += (c > 0u) ? 1u : 0u; mine = (j == x) ? c : mine; }
        if (sum == G) break;
        __builtin_amdgcn_s_sleep(1);
        if ((++sp & 255u) == 0u) { if (xb_ld(&bar[XB_TMO])) break; if (sp > XB_SPIN_CAP) { atomicAdd(&bar[XB_TMO], 1u); break; } }
    }
    nloc = mine > 0u ? mine : 1u; nx = cnt > 0u ? cnt : 1u;
}
DI void xcd_barrier(unsigned* bar, volatile LAS unsigned* st, bool leader) {
    asm volatile("s_waitcnt vmcnt(0)" ::: "memory");
    __syncthreads();
    if (leader) {
        const unsigned x = xb_xcc_id();
        __builtin_amdgcn_s_waitcnt(0);
        unsigned nloc = st[0], nx = st[1];
        if (nloc == 0u) { xcd_barrier_complete(bar, x, nloc, nx); st[0] = nloc; st[1] = nx; }
        const unsigned old = xb_add(&bar[XB_XSUB(x)], 1u);
        const unsigned gen = old / nloc;
        if (old + 1u == (gen + 1u) * nloc) {
            __builtin_amdgcn_fence(__ATOMIC_RELEASE, "agent");
            asm volatile("s_waitcnt vmcnt(0)" ::: "memory");
            const unsigned og = xb_add(&bar[XB_TOP], 1u);
            const unsigned tg = og / nx;
            if (og + 1u == (tg + 1u) * nx) xb_add(&bar[XB_TOPGEN], 1u);
            else XB_SPIN(xb_ld(&bar[XB_TOPGEN]) == tg, bar);
            __builtin_amdgcn_fence(__ATOMIC_ACQUIRE, "agent");
            xb_add(&bar[XB_XGEN(x)], 1u);
            asm volatile("s_waitcnt vmcnt(0)" ::: "memory");
        } else {
            XB_SPIN(xb_ld(&bar[XB_XGEN(x)]) == gen, bar);
            __builtin_amdgcn_fence(__ATOMIC_ACQUIRE, "agent");
            asm volatile("s_waitcnt vmcnt(0)" ::: "memory");
        }
    }
    __syncthreads();
}

struct Args { const float* in[22]; float* out; unsigned char* ws; int ph_lo, ph_hi; };
constexpr int PH_PER_LAYER = 11, N_PHASES = 1 + NL * PH_PER_LAYER;
constexpr int TAB_OFF = 131072 + 2048;
typedef volatile LAS unsigned long long* tab_t;
DI unsigned long long tab_get(tab_t TAB, int i) {
    const unsigned long long v = TAB[i];
    const unsigned lo = __builtin_amdgcn_readfirstlane((unsigned)v), hi = __builtin_amdgcn_readfirstlane((unsigned)(v >> 32));
    return ((unsigned long long)hi << 32) | lo;
}
#define TABF(i) ((const float*)tab_get(TAB, (i)))
#define TABWS() ((unsigned char*)tab_get(TAB, 23))
#define TABOUT() ((float*)tab_get(TAB, 22))

DI int opaque_s(int v) { asm volatile("" : "+s"(v)); return v; }
DI void conv_layer(tab_t TAB, LAS unsigned char* lds, int l, int gw, int NGW, int gt, int NGT, int wave, int lane) {
    unsigned char* ws = TABWS();
    bf16_t* Wqkv_t = (bf16_t*)(ws + W_QKV); bf16_t* Wuq_t = (bf16_t*)(ws + W_UQ); bf16_t* Wukv_t = (bf16_t*)(ws + W_UKV);
    LAS float* scr = (LAS float*)(lds + wave * 8704);
    { const float* win = TABF(5) + (size_t)l * DM * INC;
      transpose_mat(win, DM, 4000, INC, 0, nullptr, Wqkv_t, DM, scr, gw, NGW, lane);
      transpose_mat(win, DM, 4096, INC, C_G, nullptr, (bf16_t*)(ws + W_G), DM, scr, gw, NGW, lane); }
    transpose_mat(TABF(16) + (size_t)l * DM * FF, DM, FF, FF, 0, nullptr, (bf16_t*)(ws + W_FF1), DM, scr, gw, NGW, lane);
    transpose_mat(TABF(17) + (size_t)l * FF * DM, FF, DM, DM, 0, nullptr, (bf16_t*)(ws + W_FF2), FF, scr, gw, NGW, lane);
    for (int n = 0; n < 4; ++n) transpose_mat(TABF(12) + ((size_t)l * 4 + n) * 256 * DM, 256, DM, DM, 0, nullptr, (bf16_t*)(ws + W_B) + (size_t)n * DM * 256, 256, scr, gw, NGW, lane);
    transpose_mat(TABF(13) + (size_t)l * DM * DM, DM, DM, DM, 0, nullptr, (bf16_t*)(ws + W_OUT), DM, scr, gw, NGW, lane);
    transpose_mat(TABF(19) + (size_t)l * DM * DM, DM, DM, DM, 0, nullptr, (bf16_t*)(ws + W_PG), DM, scr, gw, NGW, lane);
    transpose_mat(TABF(18) + (size_t)l * 256 * DM, 256, DM, DM, 0, nullptr, (bf16_t*)(ws + W_PLE), 256, scr, gw, NGW, lane);
    transpose_mat(TABF(7) + (size_t)l * 256 * 384, 256, 384, 384, 0, TABF(6) + l * 256, Wuq_t, 256, scr, gw, NGW, lane);
    transpose_mat(TABF(9) + (size_t)l * 128 * 512, 128, 512, 512, 0, TABF(8) + l * 128, Wukv_t, 256, scr, gw, NGW, lane);
    for (int i = gt; i < 96 * DM / 2; i += NGT) ((unsigned*)(Wqkv_t + (size_t)4000 * DM))[i] = 0u;
    for (int i = gt; i < 128 * 256 / 2; i += NGT) ((unsigned*)(Wuq_t + (size_t)384 * 256))[i] = 0u;
    for (int i = gt; i < 512 * 64; i += NGT) { const int rr = i >> 6, cc = i & 63; ((unsigned*)(Wukv_t + (size_t)rr * 256 + 128))[cc] = 0u; }
    const float* pl = TABF(1) + (size_t)l * T * 256; bf16_t* PB = (bf16_t*)(ws + WS_PB);
    for (int i = gt; i < T * 256 / 8; i += NGT) {
        const f32x4 v0 = ((const f32x4*)pl)[2 * i], v1 = ((const f32x4*)pl)[2 * i + 1];
        u32x4 o; o.x = cvt_pk(v0.x, v0.y); o.y = cvt_pk(v0.z, v0.w); o.z = cvt_pk(v1.x, v1.y); o.w = cvt_pk(v1.z, v1.w);
        ((u32x4*)PB)[i] = o;
    }
}

__global__ void __launch_bounds__(512) fwd_kernel(Args a) {
    extern __shared__ __attribute__((aligned(16))) unsigned char lds_raw[];
    LAS unsigned char* lds = (LAS unsigned char*)lds_raw;
    cg::grid_group grid = cg::this_grid();
    tab_t TAB = (tab_t)(lds + TAB_OFF);
    if (threadIdx.x == 0) {
#pragma unroll
        for (int i = 0; i < 22; ++i) TAB[i] = (unsigned long long)a.in[i];
        TAB[22] = (unsigned long long)a.out; TAB[23] = (unsigned long long)a.ws;
    }
    volatile LAS unsigned* BST = (volatile LAS unsigned*)(lds + TAB_OFF + 256);
    if (threadIdx.x < 2) BST[threadIdx.x] = 0u;
    if (blockIdx.x == 0) { unsigned* bw = (unsigned*)a.ws; for (int i = threadIdx.x; i < XCD_BAR_WORDS; i += 512) bw[i] = 0u; }
    __syncthreads();
    const int ph_lo = a.ph_lo, ph_hi = a.ph_hi;
    const int wave_s = __builtin_amdgcn_readfirstlane((int)threadIdx.x >> 6);
#define TIDS int tid_ = wave_s * 64 + lane_id(); asm volatile("" : "+v"(tid_)); const int tid = tid_, lane = tid & 63, wave = __builtin_amdgcn_readfirstlane(tid >> 6); int G_ = gridDim.x, bid_ = blockIdx.x; asm volatile("" : "+s"(G_), "+s"(bid_)); const int G = G_, bid = bid_; \
             const int gw = bid * 8 + wave, NGW = G * 8; const int gt = bid * 512 + tid, NGT = G * 512; (void)lane; (void)gw; (void)NGW; (void)gt; (void)NGT; (void)wave;
#define GRIDX opaque_s((int)gridDim.x)
#define BIDX opaque_s((int)blockIdx.x)
#define PHASE(k) asm volatile("" ::: "memory"); if (ph_lo <= (k) && (k) < ph_hi)
#define SEAM0(k) do { if (ph_lo <= (k) && (k) + 1 < ph_hi) { grid.sync(); if (wave_s == 0 && lane_id() == 0) (void)xb_add(&((unsigned*)TABWS())[XB_XCNT(xb_xcc_id())], 1u); } } while (0)
#define SEAM(k) do { if (ph_lo <= (k) && (k) + 1 < ph_hi) xcd_barrier((unsigned*)TABWS(), BST, wave_s == 0 && lane_id() == 0); } while (0)

    PHASE(0) {
        TIDS
        conv_layer(TAB, lds, 0, gw, NGW, gt, NGT, wave, lane);
        unsigned char* ws = TABWS();
        float* COS = (float*)(ws + WS_ROPE); float* SIN = COS + S * 16;
        for (int i = gt; i < S * 16; i += NGT) {
            const int pos = i >> 4, f = i & 15;
            const double b4 = (f & 3) == 0 ? 1.0 : ((f & 3) == 1 ? 0.5623413251903491 : ((f & 3) == 2 ? 0.31622776601683794 : 0.1778279410038923));
            const double p10 = (f >> 2) == 0 ? 1.0 : ((f >> 2) == 1 ? 0.1 : ((f >> 2) == 2 ? 0.01 : 0.001));
            const float inv = (float)(b4 * p10);
            const float ang = (float)pos * inv;
            double rev = (double)ang * 0.15915494309189535; rev -= floor(rev);
            COS[i] = __builtin_amdgcn_cosf((float)rev); SIN[i] = __builtin_amdgcn_sinf((float)rev);
        }
        const float* rel_bias = TABF(4); float* LUTS = (float*)(ws + WS_LUTS); float* LUTD = (float*)(ws + WS_LUTD);
        for (int i = gt; i < 4 * 257; i += NGT) { const int hh = i / 257, rl = i % 257 - 128; LUTS[hh * 260 + rl + 128] = rel_bias[t5_bucket(rl) * 16 + hh] * LOG2E; }
        for (int i = gt; i < 12 * 129; i += NGT) { const int gh = i / 129, rl = i % 129 - 64, gg = gh >> 2; const int rr = gg == 0 ? 1 : (gg == 1 ? 4 : 16);
            LUTD[gh * 132 + rl + 64] = rel_bias[t5_bucket(rl * rr) * 16 + 4 + gh] * LOG2E; }
        const float* x = TABF(0); float* H = TABOUT(); bf16_t* HB = (bf16_t*)(ws + WS_HB); const float* eg = TABF(2); const float* eb = TABF(3);
        float* ST = (float*)(ws + WS_STATS); (void)H;
        for (int m = gw * 8; m < T; m += NGW * 8) ln_rows<8>(x + (size_t)m * DM, nullptr, HB + (size_t)m * DM, ST + (size_t)m * 2, eg, eb, lane);
    }
    SEAM0(0);

    for (int l = 0; l < NL; ++l) {
        const int P0 = 1 + l * PH_PER_LAYER;
        PHASE(P0 + 0) {
            unsigned char* ws = TABWS();
            pg8::Gemm g{(const bf16_t*)(ws + WS_HB), (const bf16_t*)(ws + W_QKV), DM, DM}; pg8::StaticOrder so; so.init(T, ZC, GRIDX, BIDX);
            pg8::EpiStore<0> E{(bf16_t*)(ws + WS_Z), ZC, ZC, nullptr, 0, 1.0f};
            pg8::gemm_phase(lds, g, so, E, wave_s);
        }
        SEAM(P0 + 0);
        PHASE(P0 + 1) {
            { TIDS
              unsigned char* ws = TABWS();
              const bf16_t* ZQ = (const bf16_t*)(ws + WS_Z); float* RSTD = (float*)(ws + WS_RSTD); bf16_t* KR = (bf16_t*)(ws + WS_KR);
              const float* COS = (const float*)(ws + WS_ROPE); const float* SIN = COS + S * 16;
              pg8::StaticOrder so; so.init(T, 512, G, bid); pg8::Unit uu;
              for (int i = 0; so.tile(i, uu); ++i) {
                  const int ch = lane & 7;
#pragma unroll 1
                  for (int it = 0; it < 4; ++it) {
                      const int m = uu.pm * 256 + wave * 32 + it * 8 + (lane >> 3);
                      const bf16_t* zr = ZQ + (size_t)m * ZC;
                      float sq = 0.f, sk = 0.f;
#pragma unroll
                      for (int j = 0; j < 4; ++j) { const u32x4 q = *(const u32x4*)(zr + C_AQ + ch * 32 + 8 * j);
                          sq += bf_lo(q.x) * bf_lo(q.x) + bf_hi(q.x) * bf_hi(q.x) + bf_lo(q.y) * bf_lo(q.y) + bf_hi(q.y) * bf_hi(q.y)
                              + bf_lo(q.z) * bf_lo(q.z) + bf_hi(q.z) * bf_hi(q.z) + bf_lo(q.w) * bf_lo(q.w) + bf_hi(q.w) * bf_hi(q.w); }
#pragma unroll
                      for (int j = 0; j < 2; ++j) { const u32x4 q = *(const u32x4*)(zr + C_AKV + ch * 16 + 8 * j);
                          sk += bf_lo(q.x) * bf_lo(q.x) + bf_hi(q.x) * bf_hi(q.x) + bf_lo(q.y) * bf_lo(q.y) + bf_hi(q.y) * bf_hi(q.y)
                              + bf_lo(q.z) * bf_lo(q.z) + bf_hi(q.z) * bf_hi(q.z) + bf_lo(q.w) * bf_lo(q.w) + bf_hi(q.w) * bf_hi(q.w); }
                      sq += shx<1>(sq); sk += shx<1>(sk); sq += shx<2>(sq); sk += shx<2>(sk); sq += shx<4>(sq); sk += shx<4>(sk);
                      if (ch == 0) { RSTD[(size_t)m * 2] = 1.0f / sqrtf(sq * (1.f / 256.f) + 1e-6f); RSTD[(size_t)m * 2 + 1] = 1.0f / sqrtf(sk * (1.f / 128.f) + 1e-6f); }
                      if (ch < 4 && uu.pn == 0) {
                          const int pos = m & (S - 1);
                          const u32x2 a1 = *(const u32x2*)(zr + C_AKR + 4 * ch), a2 = *(const u32x2*)(zr + C_AKR + 16 + 4 * ch);
                          const f32x4 c = *(const f32x4*)(COS + pos * 16 + 4 * ch), sn = *(const f32x4*)(SIN + pos * 16 + 4 * ch);
                          const float x10 = bf_lo(a1.x), x11 = bf_hi(a1.x), x12 = bf_lo(a1.y), x13 = bf_hi(a1.y), x20 = bf_lo(a2.x), x21 = bf_hi(a2.x), x22 = bf_lo(a2.y), x23 = bf_hi(a2.y);
                          u32x2 o1, o2;
                          o1.x = cvt_pk(x10 * c.x - x20 * sn.x, x11 * c.y - x21 * sn.y); o1.y = cvt_pk(x12 * c.z - x22 * sn.z, x13 * c.w - x23 * sn.w);
                          o2.x = cvt_pk(x10 * sn.x + x20 * c.x, x11 * sn.y + x21 * c.y); o2.y = cvt_pk(x12 * sn.z + x22 * c.z, x13 * sn.w + x23 * c.w);
                          *(u32x2*)(KR + (size_t)m * 32 + 4 * ch) = o1; *(u32x2*)(KR + (size_t)m * 32 + 16 + 4 * ch) = o2;
                      }
                  }
              }
              asm volatile("s_waitcnt vmcnt(0)" ::: "memory");
              __syncthreads();
            }
            asm volatile("" ::: "memory");
            { unsigned char* ws = TABWS();
              pg8::Gemm g{(const bf16_t*)(ws + WS_Z) + C_AQ, (const bf16_t*)(ws + W_UQ), ZC, 256}; pg8::StaticOrder so; so.init(T, 512, GRIDX, BIDX);
              pg8::EpiStore<0> E{(bf16_t*)(ws + WS_QM), 384, 384, (const float*)(ws + WS_RSTD), 2, 0.10206207261596575f * LOG2E};
              pg8::gemm_phase(lds, g, so, E, wave_s); }
            asm volatile("" ::: "memory");
            { unsigned char* ws = TABWS();
              pg8::Gemm g{(const bf16_t*)(ws + WS_Z) + C_AKV, (const bf16_t*)(ws + W_UKV), ZC, 256}; pg8::StaticOrder so; so.init(T, 512, GRIDX, BIDX);
              pg8::EpiStore<0> E{(bf16_t*)(ws + WS_KVM), 512, 512, (const float*)(ws + WS_RSTD) + 1, 2, 1.0f};
              pg8::gemm_phase(lds, g, so, E, wave_s); }
        }
        SEAM(P0 + 1);
        PHASE(P0 + 2) {
            unsigned char* ws = TABWS(); const int G = GRIDX, bid = BIDX;
            bf16_t* ZQ = (bf16_t*)(ws + WS_Z);
            AttnP AP{ZQ, (const bf16_t*)(ws + WS_QM), (const bf16_t*)(ws + WS_KVM), (const bf16_t*)(ws + WS_KR), (bf16_t*)(ws + WS_Y), ZQ, (float*)(ws + WS_LSE),
                     (const float*)(ws + WS_LUTS), (const float*)(ws + WS_LUTD), TABF(11) + (size_t)l * 4 * 465, TABF(10) + l * 4, (const float*)(ws + WS_ROPE)};
            const int xq = bid & 7, jq = bid >> 3, Gq = (G + 7 - xq) >> 3;
            for (int j = jq; j < 32; j += Gq) attn_unit<0>(lds, AP, xq * 32 + j, wave_s);
            for (int j = jq; j < 64; j += Gq) attn_unit<1>(lds, AP, xq * 64 + j, wave_s);
            for (int j = jq; j < 64; j += Gq) attn_unit<2>(lds, AP, xq * 64 + j, wave_s);
            for (int j = jq; j < 192; j += Gq) attn_unit<3>(lds, AP, xq * 192 + j, wave_s);
        }
        SEAM(P0 + 2);
        PHASE(P0 + 3) {
            TIDS
            unsigned char* ws = TABWS();
            const bf16_t* ZQ = (const bf16_t*)(ws + WS_Z); const float* LSE = (const float*)(ws + WS_LSE); bf16_t* Y = (bf16_t*)(ws + WS_Y);
            for (int i = gt; i < T * 32; i += NGT) {
                const int m = i >> 5, hh = (i >> 3) & 3, ch = i & 7;
                const float l0 = LSE[(size_t)m * 12 + hh], l1 = LSE[(size_t)m * 12 + 4 + hh], l2 = LSE[(size_t)m * 12 + 8 + hh];
                const float mx = fmaxf(l0, fmaxf(l1, l2));
                float w0 = __builtin_amdgcn_exp2f(l0 - mx), w1 = __builtin_amdgcn_exp2f(l1 - mx), w2 = __builtin_amdgcn_exp2f(l2 - mx);
                const float inv = 1.0f / (w0 + w1 + w2); w0 *= inv; w1 *= inv; w2 *= inv;
                const bf16_t* zp = ZQ + (size_t)m * ZC + C_DQ + hh * 64 + ch * 8;
                const u32x4 a0 = *(const u32x4*)zp, a1 = *(const u32x4*)(zp + 256), a2 = *(const u32x4*)(zp + 512);
                u32x4 o;
                o.x = cvt_pk(w0 * bf_lo(a0.x) + w1 * bf_lo(a1.x) + w2 * bf_lo(a2.x), w0 * bf_hi(a0.x) + w1 * bf_hi(a1.x) + w2 * bf_hi(a2.x));
                o.y = cvt_pk(w0 * bf_lo(a0.y) + w1 * bf_lo(a1.y) + w2 * bf_lo(a2.y), w0 * bf_hi(a0.y) + w1 * bf_hi(a1.y) + w2 * bf_hi(a2.y));
                o.z = cvt_pk(w0 * bf_lo(a0.z) + w1 * bf_lo(a1.z) + w2 * bf_lo(a2.z), w0 * bf_hi(a0.z) + w1 * bf_hi(a1.z) + w2 * bf_hi(a2.z));
                o.w = cvt_pk(w0 * bf_lo(a0.w) + w1 * bf_lo(a1.w) + w2 * bf_lo(a2.w), w0 * bf_hi(a0.w) + w1 * bf_hi(a1.w) + w2 * bf_hi(a2.w));
                *(u32x4*)(Y + (size_t)m * DM + 768 + hh * 64 + ch * 8) = o;
            }
        }
        SEAM(P0 + 3);
        PHASE(P0 + 4) {
            unsigned char* ws = TABWS();
            pg8::Gemm g{(const bf16_t*)(ws + WS_HB), (const bf16_t*)(ws + W_G), DM, DM}; pg8::StaticOrder so; so.init(T, ZC, GRIDX, BIDX);
            pg8::EpiStore<1> E{(bf16_t*)(ws + WS_Z), ZC, ZC, nullptr, 0, 1.0f};
            pg8::gemm_phase(lds, g, so, E, wave_s);
        }
        SEAM(P0 + 4);
        PHASE(P0 + 5) {
            unsigned char* ws = TABWS();
            pg8::Gemm g{(const bf16_t*)(ws + WS_Y), (const bf16_t*)(ws + W_B), DM, 256}; pg8::MergeOrder mo; mo.s.init(T, DM, GRIDX, BIDX);
            pg8::EpiMerge E{(bf16_t*)(ws + WS_MG), (const bf16_t*)(ws + WS_Z)};
            pg8::gemm_phase(lds, g, mo, E, wave_s);
        }
        SEAM(P0 + 5);
        PHASE(P0 + 6) {
            unsigned char* ws = TABWS();
            pg8::Gemm g{(const bf16_t*)(ws + WS_MG), (const bf16_t*)(ws + W_OUT), DM, DM}; pg8::StaticOrder so; so.init(T, DM, GRIDX, BIDX);
            float* Hout = TABOUT();
            pg8::EpiResid<false> E{l == 0 ? TABF(0) : (const float*)Hout, Hout, nullptr, (const float*)(ws + WS_STATS), l == 0 ? TABF(2) : TABF(20) + (l - 1) * DM, l == 0 ? TABF(3) : TABF(21) + (l - 1) * DM};
            pg8::gemm_phase(lds, g, so, E, wave_s);
        }
        SEAM(P0 + 6);
        PHASE(P0 + 7) {
            TIDS
            unsigned char* ws = TABWS(); float* H = TABOUT(); bf16_t* HB = (bf16_t*)(ws + WS_HB); const float* gg = TABF(14) + l * DM; const float* bb = TABF(15) + l * DM;
            float* ST = (float*)(ws + WS_STATS);
            for (int m = gw * 8; m < T; m += NGW * 8) ln_rows<8>(H + (size_t)m * DM, nullptr, HB + (size_t)m * DM, ST + (size_t)m * 2, gg, bb, lane);
        }
        SEAM(P0 + 7);
        PHASE(P0 + 8) {
            { unsigned char* ws = TABWS();
              pg8::Gemm g{(const bf16_t*)(ws + WS_HB), (const bf16_t*)(ws + W_FF1), DM, DM}; pg8::StaticOrder so; so.init(T, FF, GRIDX, BIDX);
              pg8::EpiStore<2> E{(bf16_t*)(ws + WS_Z), FF, FF, nullptr, 0, 1.0f};
              pg8::gemm_phase(lds, g, so, E, wave_s); }
            asm volatile("" ::: "memory");
            { unsigned char* ws = TABWS();
              pg8::Gemm g{(const bf16_t*)(ws + WS_HB), (const bf16_t*)(ws + W_PG), DM, DM}; pg8::StaticOrder so; so.init(T, DM, GRIDX, BIDX);
              pg8::EpiStore<1> E{(bf16_t*)(ws + WS_Y), DM, DM, nullptr, 0, 1.0f};
              pg8::gemm_phase(lds, g, so, E, wave_s); }
            asm volatile("" ::: "memory");
            { unsigned char* ws = TABWS();
              pg8::Gemm g{(const bf16_t*)(ws + WS_PB), (const bf16_t*)(ws + W_PLE), 256, 256}; pg8::StaticOrder so; so.init(T, DM, GRIDX, BIDX);
              pg8::EpiMulInto E{(bf16_t*)(ws + WS_Y)};
              pg8::gemm_phase(lds, g, so, E, wave_s); }
        }
        SEAM(P0 + 8);
        PHASE(P0 + 9) {
            unsigned char* ws = TABWS();
            pg8::Gemm g{(const bf16_t*)(ws + WS_Z), (const bf16_t*)(ws + W_FF2), FF, FF}; pg8::StaticOrder so; so.init(T, DM, GRIDX, BIDX);
            float* Hout = TABOUT();
            pg8::EpiResid<true> E{(const float*)Hout, Hout, (const bf16_t*)(ws + WS_Y), (const float*)(ws + WS_STATS), TABF(14) + l * DM, TABF(15) + l * DM};
            pg8::gemm_phase(lds, g, so, E, wave_s);
        }
        SEAM(P0 + 9);
        PHASE(P0 + 10) {
            TIDS
            unsigned char* ws = TABWS(); float* H = TABOUT(); bf16_t* HB = (bf16_t*)(ws + WS_HB); const float* gg = TABF(20) + l * DM; const float* bb = TABF(21) + l * DM;
            float* ST = (float*)(ws + WS_STATS);
            if (l + 1 < NL) { for (int m = gw * 8; m < T; m += NGW * 8) ln_rows<8>(H + (size_t)m * DM, nullptr, HB + (size_t)m * DM, ST + (size_t)m * 2, gg, bb, lane); }
            else { for (int m = gw * 8; m < T; m += NGW * 8) ln_rows<8>(H + (size_t)m * DM, H + (size_t)m * DM, nullptr, nullptr, gg, bb, lane); }
            if (l + 1 < NL) conv_layer(TAB, lds, l + 1, gw, NGW, gt, NGT, wave, lane);
        }
        if (l + 1 < NL) SEAM(P0 + 10);
    }
}

extern "C" void kernel_launch(void* const* d_in, const int* in_sizes, int n_in, void* d_out, int out_size, void* d_ws, size_t ws_size, hipStream_t stream) {
    static int grid = 0;
    if (grid == 0) {
        if (n_in != 22 || out_size != T * DM || ws_size < WS_END) { fprintf(stderr, "kernel_launch: unexpected shapes (n_in %d out %d ws %zu)\n", n_in, out_size, ws_size); grid = -1; return; }
        int dev = 0, cus = 0, per = 0;
        (void)hipGetDevice(&dev); (void)hipDeviceGetAttribute(&cus, hipDeviceAttributeMultiprocessorCount, dev);
        (void)hipFuncSetAttribute((const void*)fwd_kernel, hipFuncAttributeMaxDynamicSharedMemorySize, LDS_BYTES);
        (void)hipOccupancyMaxActiveBlocksPerMultiprocessor(&per, (const void*)fwd_kernel, 512, LDS_BYTES);
        if (per < 1) per = 1;
        grid = cus * per;
        fprintf(stderr, "kernel_launch: grid %d (cus %d x %d)\n", grid, cus, per);
    }
    if (grid < 0) return;
    Args a{};
    for (int i = 0; i < 22; ++i) a.in[i] = (const float*)d_in[i];
    a.out = (float*)d_out; a.ws = (unsigned char*)d_ws;
#if N_LAUNCH_MODE == 1
    a.ph_lo = 0; a.ph_hi = N_PHASES;
    void* args[] = {&a};
    hipError_t e = hipLaunchCooperativeKernel((void*)fwd_kernel, dim3(grid), dim3(512), args, LDS_BYTES, stream);
    if (e != hipSuccess) fprintf(stderr, "cooperative launch failed: %s (grid %d)\n", hipGetErrorString(e), grid);
#else
    for (int k = 0; k < N_PHASES; ++k) { a.ph_lo = k; a.ph_hi = k + 1; hipLaunchKernelGGL(fwd_kernel, dim3(grid), dim3(512), LDS_BYTES, stream, a); }
#endif
}
```

```cpp
#include <hip/hip_runtime.h>
#include <hip/hip_cooperative_groups.h>
#include <cstdio>
#include <cstdint>
namespace cg = cooperative_groups;

#define LAS __attribute__((address_space(3)))
#define DI __device__ __forceinline__
typedef unsigned short bf16_t;
typedef short bf16x8 __attribute__((ext_vector_type(8)));
typedef short s16x4 __attribute__((ext_vector_type(4)));
typedef float f32x4 __attribute__((ext_vector_type(4)));
typedef float f32x2 __attribute__((ext_vector_type(2)));
typedef float f32x16 __attribute__((ext_vector_type(16)));
typedef unsigned u32x4 __attribute__((ext_vector_type(4)));
typedef unsigned u32x2 __attribute__((ext_vector_type(2)));
typedef __bf16 bf16x2_t __attribute__((ext_vector_type(2)));

#ifndef N_LAUNCH_MODE
#define N_LAUNCH_MODE 1
#endif

constexpr int T = 32768, S = 8192, DM = 1024, FF = 4096, INC = 8096, ZC = 4096, NL = 2;
constexpr int C_AQ = 0, C_AKV = 256, C_AKR = 384, C_BQ = 416, C_BK = 672, C_BV = 800, C_CQ = 928, C_CK = 1184, C_CV = 1440,
              C_DQ = 1696, C_DK = 2464, C_DV = 3232, C_G = 4000;
constexpr float LOG2E = 1.4426950408889634f;
constexpr float ALPHA = 1.4142135623730951f;

constexpr size_t MiB = 1u << 20;
constexpr size_t WS_RSTD = 64 * 1024, WS_LUTS = 320 * 1024, WS_LUTD = 328 * 1024, WS_LSE = 512 * 1024;
constexpr size_t WS_W = 2 * MiB;
constexpr size_t W_QKV = WS_W, W_G = WS_W + 8 * MiB, W_FF1 = WS_W + 16 * MiB, W_FF2 = WS_W + 24 * MiB, W_B = WS_W + 32 * MiB, W_OUT = WS_W + 34 * MiB,
                 W_PG = WS_W + 36 * MiB, W_PLE = WS_W + 38 * MiB, W_UQ = WS_W + 38 * MiB + 512 * 1024, W_UKV = WS_W + 38 * MiB + 768 * 1024;
constexpr size_t WS_ROPE = 41 * MiB, WS_PB = 42 * MiB, WS_HB = 58 * MiB, WS_Z = 122 * MiB, WS_Y = 378 * MiB, WS_M = 442 * MiB;
constexpr size_t WS_QM = WS_M, WS_KVM = WS_M + 24 * MiB, WS_KR = WS_M + 56 * MiB, WS_MG = WS_M;
constexpr size_t WS_STATS = 506 * MiB;
constexpr size_t WS_END = 512 * MiB;

constexpr int LDS_BYTES = 135168;

DI unsigned cvt_pk(float lo, float hi) { f32x2 v = {lo, hi}; bf16x2_t b = __builtin_convertvector(v, bf16x2_t); return __builtin_bit_cast(unsigned, b); }
DI float bf_lo(unsigned u) { return __uint_as_float(u << 16); }
DI float bf_hi(unsigned u) { return __uint_as_float(u & 0xffff0000u); }
DI float xhalf_max(float m) { auto rr = __builtin_amdgcn_permlane32_swap(__float_as_uint(m), __float_as_uint(m), false, false); return fmaxf(__uint_as_float(rr[0]), __uint_as_float(rr[1])); }
DI float xhalf_sum(float m) { auto rr = __builtin_amdgcn_permlane32_swap(__float_as_uint(m), __float_as_uint(m), false, false); return __uint_as_float(rr[0]) + __uint_as_float(rr[1]); }
template <int O> DI float shx(float v) { return __int_as_float(__builtin_amdgcn_ds_swizzle(__float_as_int(v), (O << 10) | 0x1f)); }
DI float wave_sum(float v) {
    v += shx<1>(v); v += shx<2>(v); v += shx<4>(v); v += shx<8>(v); v += shx<16>(v); v = xhalf_sum(v);
    return v;
}
DI float sigmoid_f(float x) { return __builtin_amdgcn_rcpf(1.0f + __builtin_amdgcn_exp2f(-x * LOG2E)); }
DI int lane_id() { int l; asm volatile("v_mbcnt_lo_u32_b32 %0, -1, 0\n\tv_mbcnt_hi_u32_b32 %0, -1, %0" : "=v"(l)); return l; }
DI int crow(int r, int hi) { return (r & 3) + 8 * (r >> 2) + 4 * hi; }

namespace pg8 {
constexpr int BM = 256, BK = 64, HALF = 128, HTB = HALF * BK * 2, STAGE_BYTES = 8 * HTB, NXCD = 8, WGM = 8;
DI int lds_byte(int r, int c) { const int st = (r >> 4) * 2 + (c >> 5), rr = r & 15, cc = c & 31, ob = rr * 64 + cc * 2; return st * 1024 + (ob ^ (((ob >> 9) & 1) << 5)); }
DI void stage_rc(int b, int& R, int& C) { const int st = b / 1024, sb = b % 1024, swz = sb ^ (((sb >> 9) & 1) << 5); R = (st >> 1) * 16 + swz / 64; C = (st & 1) * 32 + (swz % 64) / 2; }
DI int perm32(int rho) { const int n = rho >> 4, i = rho & 15; return 8 * (i >> 2) + 4 * n + (i & 3); }

struct Unit { int pm, pn, z; };
struct Gemm { const bf16_t* A; const bf16_t* Bt; int lda; int K; };

struct StaticOrder {
    int nM, nN, nwg, G, c;
    DI void init(int M, int N, int G_, int c_) { nM = M / BM; nN = N / BM; nwg = nM * nN; G = G_; c = c_; }
    DI bool tile(int i, Unit& u) const {
        const long L = (long)i * G + c; if (L >= nwg) return false;
        int wgid = (int)L; { const int q = nwg / NXCD, r = nwg % NXCD, xcd = wgid % NXCD, off = wgid / NXCD; wgid = (xcd < r ? xcd * (q + 1) : r * (q + 1) + (xcd - r) * q) + off; }
        const int nig = WGM * nN, gid = wgid / nig, fm = gid * WGM, gsz = (nM - fm) < WGM ? (nM - fm) : WGM;
        u.pm = fm + ((wgid % nig) % gsz); u.pn = (wgid % nig) / gsz; u.z = 0; return true;
    }
    DI bool next(int i, Unit& u) const { return tile(i, u); }
    DI size_t aoff(const Unit& u, const Gemm& g) const { return (size_t)u.pm * BM * g.lda * 2; }
    DI size_t boff(const Unit& u, const Gemm& g) const { return (size_t)u.pn * BM * g.K * 2; }
};
struct MergeOrder {
    StaticOrder s;
    DI bool next(int i, Unit& u) const { if (!s.tile(i >> 2, u)) return false; u.z = i & 3; return true; }
    DI size_t aoff(const Unit& u, const Gemm& g) const { return (size_t)u.pm * BM * g.lda * 2 + (size_t)u.z * 256 * 2; }
    DI size_t boff(const Unit& u, const Gemm& g) const { return (size_t)(u.z * 4 + u.pn) * BM * g.K * 2; }
};

#define EPI_ROWS_BEGIN \
    _Pragma("unroll") for (int ai = 0; ai < 2; ++ai) _Pragma("unroll") for (int m = 0; m < 4; ++m) { const int row = u.pm * BM + ai * HALF + wr * 64 + m * 16 + fr;
#define EPI_COLS_BEGIN \
    _Pragma("unroll") for (int bj = 0; bj < 2; ++bj) { const int col = u.pn * BM + bj * HALF + wc * 32 + 8 * fq; f32x4 v0 = acc[ai][bj][m][0], v1 = acc[ai][bj][m][1];
#define EPI_END } asm volatile("" ::: "memory"); }

template <int ACT  > struct EpiStore {
    bf16_t* O; int ldc; int ncv; const float* rs; int rss; float cmul;
    DI void operator()(const f32x4 (&acc)[2][2][4][2], const Unit& u, int wr, int wc, int fr, int fq) const {
        float scv[2][4];
#pragma unroll
        for (int ai = 0; ai < 2; ++ai)
#pragma unroll
            for (int m = 0; m < 4; ++m) scv[ai][m] = rs ? rs[(size_t)(u.pm * BM + ai * HALF + wr * 64 + m * 16 + fr) * rss] * cmul : 1.0f;
        EPI_ROWS_BEGIN
            const float sc = scv[ai][m]; bf16_t* rowp = O + (size_t)row * ldc;
            EPI_COLS_BEGIN
                if (col < ncv) {
                    v0 = v0 * sc; v1 = v1 * sc;
                    if (ACT == 1) {
#pragma unroll
                        for (int j = 0; j < 4; ++j) { v0[j] = sigmoid_f(v0[j]); v1[j] = sigmoid_f(v1[j]); }
                    }
                    if (ACT == 2) {
#pragma unroll
                        for (int j = 0; j < 4; ++j) { const float a = fmaxf(v0[j], 0.f), b = fmaxf(v1[j], 0.f); v0[j] = a * a; v1[j] = b * b; }
                    }
                    u32x4 w; w.x = cvt_pk(v0[0], v0[1]); w.y = cvt_pk(v0[2], v0[3]); w.z = cvt_pk(v1[0], v1[1]); w.w = cvt_pk(v1[2], v1[3]);
                    *(u32x4*)(rowp + col) = w;
                }
            }
            asm volatile("" ::: "memory");
        }
    }
};
#define EPI_ROW(ai, m) (u.pm * BM + (ai) * HALF + wr * 64 + (m) * 16 + fr)
#define EPI_COL(bj) (u.pn * BM + (bj) * HALF + wc * 32 + 8 * fq)
DI void mul_bf8(f32x4& v0, f32x4& v1, const u32x4 g) {
    v0[0] *= bf_lo(g.x); v0[1] *= bf_hi(g.x); v0[2] *= bf_lo(g.y); v0[3] *= bf_hi(g.y); v1[0] *= bf_lo(g.z); v1[1] *= bf_hi(g.z); v1[2] *= bf_lo(g.w); v1[3] *= bf_hi(g.w); }
DI void add_bf8(f32x4& v0, f32x4& v1, const u32x4 g) {
    v0[0] += bf_lo(g.x); v0[1] += bf_hi(g.x); v0[2] += bf_lo(g.y); v0[3] += bf_hi(g.y); v1[0] += bf_lo(g.z); v1[1] += bf_hi(g.z); v1[2] += bf_lo(g.w); v1[3] += bf_hi(g.w); }
DI u32x4 pack_bf8(const f32x4 v0, const f32x4 v1) { u32x4 w; w.x = cvt_pk(v0[0], v0[1]); w.y = cvt_pk(v0[2], v0[3]); w.z = cvt_pk(v1[0], v1[1]); w.w = cvt_pk(v1[2], v1[3]); return w; }
struct EpiMerge {
    bf16_t* MG; const bf16_t* GT;
    DI void operator()(const f32x4 (&acc)[2][2][4][2], const Unit& u, int wr, int wc, int fr, int fq) const {
#pragma unroll
        for (int ai = 0; ai < 2; ++ai)
#pragma unroll
            for (int mh = 0; mh < 2; ++mh) {
                u32x4 gv[2][2], ov[2][2];
#pragma unroll
                for (int mm = 0; mm < 2; ++mm)
#pragma unroll
                    for (int bj = 0; bj < 2; ++bj) {
                        const size_t row = EPI_ROW(ai, 2 * mh + mm); const int col = EPI_COL(bj);
                        gv[mm][bj] = *(const u32x4*)(GT + row * ZC + u.z * DM + col);
                        if (u.z != 0) ov[mm][bj] = *(const u32x4*)(MG + row * DM + col);
                    }
#pragma unroll
                for (int mm = 0; mm < 2; ++mm)
#pragma unroll
                    for (int bj = 0; bj < 2; ++bj) {
                        const size_t row = EPI_ROW(ai, 2 * mh + mm); const int col = EPI_COL(bj);
                        f32x4 v0 = acc[ai][bj][2 * mh + mm][0], v1 = acc[ai][bj][2 * mh + mm][1];
                        mul_bf8(v0, v1, gv[mm][bj]);
                        if (u.z != 0) add_bf8(v0, v1, ov[mm][bj]);
                        *(u32x4*)(MG + row * DM + col) = pack_bf8(v0, v1);
                    }
                asm volatile("" ::: "memory");
            }
    }
};
template <bool EXTRA> struct EpiResid {
    const float* Xin; float* Xout; const bf16_t* E; const float* stats; const float* gam; const float* bet;
    DI void operator()(const f32x4 (&acc)[2][2][4][2], const Unit& u, int wr, int wc, int fr, int fq) const {
        f32x4 g0[2], g1[2], b0[2], b1[2];
#pragma unroll
        for (int bj = 0; bj < 2; ++bj) { const int col = EPI_COL(bj);
            g0[bj] = *(const f32x4*)(gam + col) * ALPHA; g1[bj] = *(const f32x4*)(gam + col + 4) * ALPHA;
            b0[bj] = *(const f32x4*)(bet + col) * ALPHA; b1[bj] = *(const f32x4*)(bet + col + 4) * ALPHA; }
#pragma unroll
        for (int ai = 0; ai < 2; ++ai)
#pragma unroll
            for (int mh = 0; mh < 2; ++mh) {
                f32x4 x0[2][2], x1[2][2]; u32x4 ev[2][2]; f32x2 st[2];
#pragma unroll
                for (int mm = 0; mm < 2; ++mm) {
                    const size_t row = EPI_ROW(ai, 2 * mh + mm);
                    st[mm] = *(const f32x2*)(stats + row * 2);
#pragma unroll
                    for (int bj = 0; bj < 2; ++bj) {
                        const int col = EPI_COL(bj);
                        x0[mm][bj] = *(const f32x4*)(Xin + row * DM + col); x1[mm][bj] = *(const f32x4*)(Xin + row * DM + col + 4);
                        if (EXTRA) ev[mm][bj] = *(const u32x4*)(E + row * DM + col);
                    }
                }
#pragma unroll
                for (int mm = 0; mm < 2; ++mm)
#pragma unroll
                    for (int bj = 0; bj < 2; ++bj) {
                        const size_t row = EPI_ROW(ai, 2 * mh + mm); const int col = EPI_COL(bj);
                        const float mean = st[mm].x, rstd = st[mm].y;
                        f32x4 v0 = acc[ai][bj][2 * mh + mm][0] + ((x0[mm][bj] - mean) * rstd) * g0[bj] + b0[bj];
                        f32x4 v1 = acc[ai][bj][2 * mh + mm][1] + ((x1[mm][bj] - mean) * rstd) * g1[bj] + b1[bj];
                        if (EXTRA) add_bf8(v0, v1, ev[mm][bj]);
                        *(f32x4*)(Xout + row * DM + col) = v0; *(f32x4*)(Xout + row * DM + col + 4) = v1;
                    }
                asm volatile("" ::: "memory");
            }
    }
};
struct EpiMulInto {
    bf16_t* P;
    DI void operator()(const f32x4 (&acc)[2][2][4][2], const Unit& u, int wr, int wc, int fr, int fq) const {
#pragma unroll
        for (int ai = 0; ai < 2; ++ai) {
            u32x4 gv[4][2];
#pragma unroll
            for (int m = 0; m < 4; ++m)
#pragma unroll
                for (int bj = 0; bj < 2; ++bj) gv[m][bj] = *(const u32x4*)(P + (size_t)EPI_ROW(ai, m) * DM + EPI_COL(bj));
#pragma unroll
            for (int m = 0; m < 4; ++m)
#pragma unroll
                for (int bj = 0; bj < 2; ++bj) {
                    f32x4 v0 = acc[ai][bj][m][0], v1 = acc[ai][bj][m][1];
                    mul_bf8(v0, v1, gv[m][bj]);
                    *(u32x4*)(P + (size_t)EPI_ROW(ai, m) * DM + EPI_COL(bj)) = pack_bf8(v0, v1);
                }
            asm volatile("" ::: "memory");
        }
    }
};

template <class Epi, class Sched>
DI void gemm_phase(LAS unsigned char* lds, const Gemm g, const Sched& S_, const Epi& E, const int wave_s) {
    int tid_ = wave_s * 64 + lane_id(); asm volatile("" : "+v"(tid_));
    const int tid = tid_, wid = __builtin_amdgcn_readfirstlane(tid >> 6), lane = tid & 63, wr = wid >> 2, wc = wid & 3, fr = lane & 15, fq = lane >> 4;
    const int K = g.K, nt = K / BK;
    unsigned voffA[2], voffB[2];
#pragma unroll
    for (int i = 0; i < 2; ++i) { int R, C; stage_rc(tid * 16 + i * 8192, R, C); const int Rb = (R & ~31) + perm32(R & 31);
        voffA[i] = (unsigned)(R * g.lda + C) * 2u; voffB[i] = (unsigned)(Rb * K + C) * 2u; }
    const size_t kstep = (size_t)(BK * 2);
    const size_t hstepA = (size_t)HALF * g.lda * 2, hstepB = (size_t)HALF * K * 2;
    const unsigned ldsw = (unsigned)wid * 1024u;
    const int aoff = lds_byte(wr * 64 + fr, fq * 8), boff = lds_byte(wc * 32 + fr, fq * 8);
#define PG8_SA(b, h) (((b) * 2 + (h)) * HTB)
#define PG8_SB(b, h) ((4 + (b) * 2 + (h)) * HTB)
#define PG8_STAGE(bufoff, gbase, voff) do { _Pragma("unroll") for (int _i = 0; _i < 2; ++_i) \
        __builtin_amdgcn_global_load_lds((const unsigned*)((const char*)(gbase) + (voff)[_i]), (LAS unsigned*)(lds + (bufoff) + ldsw + _i * 8192), 16, 0, 0); } while (0)
#define PG8_LDA(dst, b, h) do { _Pragma("unroll") for (int m = 0; m < 4; ++m) _Pragma("unroll") for (int k = 0; k < 2; ++k) dst[m][k] = *(const LAS bf16x8*)(lds + PG8_SA(b, h) + aoff + m * 2048 + k * 1024); } while (0)
#define PG8_LDB(dst, b, h) do { _Pragma("unroll") for (int n = 0; n < 2; ++n) _Pragma("unroll") for (int k = 0; k < 2; ++k) dst[n][k] = *(const LAS bf16x8*)(lds + PG8_SB(b, h) + boff + n * 2048 + k * 1024); } while (0)
#define PG8_MMA(ai, bj, At, Bt) do { __builtin_amdgcn_s_setprio(1); _Pragma("unroll") for (int m = 0; m < 4; ++m) _Pragma("unroll") for (int n = 0; n < 2; ++n) _Pragma("unroll") for (int k = 0; k < 2; ++k) \
        acc[ai][bj][m][n] = __builtin_amdgcn_mfma_f32_16x16x32_bf16(Bt[n][k], At[m][k], acc[ai][bj][m][n], 0, 0, 0); __builtin_amdgcn_s_setprio(0); } while (0)
#define PG8_WAIT_V(n) asm volatile("s_waitcnt vmcnt(" #n ")" ::: "memory")
#define PG8_WAIT_L(n) asm volatile("s_waitcnt lgkmcnt(" #n ")" ::: "memory")
#define PG8_BAR __builtin_amdgcn_s_barrier()
#define PG8_SCHED __builtin_amdgcn_sched_barrier(0)
    Unit cur, nxt; int ui = 0;
    if (!S_.next(0, cur)) return;
    f32x4 acc[2][2][4][2];
#pragma unroll
    for (int a = 0; a < 2; ++a)
#pragma unroll
        for (int b = 0; b < 2; ++b)
#pragma unroll
            for (int m = 0; m < 4; ++m)
#pragma unroll
                for (int n = 0; n < 2; ++n) acc[a][b][m][n] = (f32x4){0.f, 0.f, 0.f, 0.f};
    bf16x8 At[4][2], B0[2][2], B1[2][2];
    const char* cA = (const char*)g.A + S_.aoff(cur, g); const char* cB = (const char*)g.Bt + S_.boff(cur, g);
    PG8_STAGE(PG8_SB(0, 0), cB, voffB); PG8_STAGE(PG8_SB(0, 1), cB + hstepB, voffB); PG8_STAGE(PG8_SA(0, 0), cA, voffA); PG8_STAGE(PG8_SA(0, 1), cA + hstepA, voffA);
    if (wr == 1) PG8_BAR;
    PG8_WAIT_V(2); PG8_BAR;
    PG8_STAGE(PG8_SB(1, 0), cB + kstep, voffB); PG8_STAGE(PG8_SA(1, 0), cA + kstep, voffA); PG8_STAGE(PG8_SB(1, 1), cB + hstepB + kstep, voffB);
    PG8_WAIT_V(6); PG8_BAR;
    for (;;) {
        const bool has_next = S_.next(ui + 1, nxt);
        const char* nA = has_next ? (const char*)g.A + S_.aoff(nxt, g) : cA; const char* nB = has_next ? (const char*)g.Bt + S_.boff(nxt, g) : cB;
        for (int t = 0; t < nt; t += 2) {
            const bool last = (t == nt - 2);
            const char* a1 = cA + (size_t)(t + 1) * kstep;
            const char* a2 = last ? nA : cA + (size_t)(t + 2) * kstep; const char* b2 = last ? nB : cB + (size_t)(t + 2) * kstep;
            const char* a3 = a2 + kstep; const char* b3 = b2 + kstep;
            PG8_LDB(B0, 0, 0); PG8_LDB(B1, 0, 1); PG8_SCHED; PG8_LDA(At, 0, 0); PG8_STAGE(PG8_SA(1, 1), a1 + hstepA, voffA);
            PG8_WAIT_V(8); PG8_WAIT_L(0); PG8_BAR; PG8_MMA(0, 0, At, B0); PG8_MMA(0, 1, At, B1); PG8_BAR; PG8_SCHED;
            PG8_LDA(At, 0, 1); PG8_STAGE(PG8_SB(0, 0), b2, voffB); PG8_STAGE(PG8_SB(0, 1), b2 + hstepB, voffB); PG8_STAGE(PG8_SA(0, 0), a2, voffA);
            PG8_WAIT_V(8); PG8_WAIT_L(0); PG8_BAR; PG8_MMA(1, 0, At, B0); PG8_MMA(1, 1, At, B1); PG8_BAR; PG8_SCHED;
            PG8_LDB(B0, 1, 0); PG8_LDB(B1, 1, 1); PG8_SCHED; PG8_LDA(At, 1, 0); PG8_STAGE(PG8_SA(0, 1), a2 + hstepA, voffA);
            PG8_WAIT_V(8); PG8_WAIT_L(0); PG8_BAR; PG8_MMA(0, 0, At, B0); PG8_MMA(0, 1, At, B1); PG8_BAR; PG8_SCHED;
            PG8_LDA(At, 1, 1); PG8_STAGE(PG8_SB(1, 0), b3, voffB); PG8_STAGE(PG8_SB(1, 1), b3 + hstepB, voffB); PG8_STAGE(PG8_SA(1, 0), a3, voffA);
            PG8_WAIT_V(8); PG8_WAIT_L(0); PG8_BAR; PG8_MMA(1, 0, At, B0); PG8_MMA(1, 1, At, B1); PG8_BAR; PG8_SCHED;
        }
        if (wr == 0) PG8_BAR;
        { const int l2 = lane_id(); E(acc, cur, wr, wc, l2 & 15, l2 >> 4); }
        if (!has_next) break;
#pragma unroll
        for (int a = 0; a < 2; ++a)
#pragma unroll
            for (int b = 0; b < 2; ++b)
#pragma unroll
                for (int m = 0; m < 4; ++m)
#pragma unroll
                    for (int n = 0; n < 2; ++n) acc[a][b][m][n] = (f32x4){0.f, 0.f, 0.f, 0.f};
        cur = nxt; cA = nA; cB = nB; ++ui;
        if (wr == 1) PG8_BAR;
    }
    PG8_WAIT_V(0);
    PG8_BAR;
#undef PG8_SA
#undef PG8_SB
#undef PG8_STAGE
#undef PG8_LDA
#undef PG8_LDB
#undef PG8_MMA
#undef PG8_WAIT_V
#undef PG8_WAIT_L
#undef PG8_BAR
#undef PG8_SCHED
}
}

struct AttnP {
    const bf16_t* ZQ; const bf16_t* QM; const bf16_t* KVM; const bf16_t* KR; bf16_t* Y; bf16_t* ZQw; float* LSE;
    const float* LUTS; const float* LUTD; const float* rpb; const float* sink; const float* COS;
};
constexpr int A_VP = 144, A_LUT = 114688, A_WSF = A_LUT + 2048, A_END = A_WSF + 2048;

DI void glds16(const void* gsrc, unsigned lds_dst) { unsigned keep;
    asm volatile("s_mov_b32 %0, m0\n\ts_mov_b32 m0, %2\n\ts_nop 0\n\tglobal_load_lds_dwordx4 %1, off\n\ts_mov_b32 m0, %0" : "=&s"(keep) : "v"(gsrc), "s"(lds_dst) : "memory"); }
DI void glds16s(unsigned voff, const void* sbase, unsigned lds_dst) { unsigned keep;
    const unsigned long long sb = (unsigned long long)sbase;
    const unsigned blo = __builtin_amdgcn_readfirstlane((unsigned)sb), bhi = __builtin_amdgcn_readfirstlane((unsigned)(sb >> 32));
    const unsigned long long sbu = ((unsigned long long)bhi << 32) | blo;
    asm volatile("s_mov_b32 %0, m0\n\ts_mov_b32 m0, %3\n\ts_nop 0\n\tglobal_load_lds_dwordx4 %1, %2\n\ts_mov_b32 m0, %0" : "=&s"(keep) : "v"(voff), "s"(sbu), "s"(lds_dst) : "memory"); }
template <int VAR> DI void attn_unit(LAS unsigned char* lds, const AttnP& P, const int u, const int wave_s) {
    constexpr int NKS = (VAR == 0) ? 6 : 4, QB = (VAR == 0) ? 2 : 1, QPW = 32 * QB;
    constexpr int A_TK = (VAR == 0) ? 128 : (VAR == 1 ? 256 : 384), NBUF = (VAR == 0) ? 2 : 1, A_KP = (VAR == 0) ? 208 : 144, NLD = A_TK / 64;
    constexpr int A_KB = 0, A_VB = (VAR == 0) ? 2 * 24576 : NBUF * A_TK * A_KP;
    static_assert(A_VB + ((VAR == 0) ? 2 * 16384 : NBUF * A_TK * A_VP) <= A_LUT, "attention tiles vs LDS map");
    int tid_ = wave_s * 64 + lane_id(); asm volatile("" : "+v"(tid_));
    const int tid = tid_, lane = tid & 63, r32 = lane & 31, hi = lane >> 5, w = __builtin_amdgcn_readfirstlane(tid >> 6);
    LAS float* LUT = (LAS float*)(lds + A_LUT);
    LAS float* WSF = (LAS float*)(lds + A_WSF) + w * 64;
    int b, h, qt, g = 0, r = 1, res = 0, L = S, j0 = 0;
    if (VAR == 0) { qt = u & 15; h = (u >> 4) & 3; b = u >> 6; j0 = 512 * qt; }
    else if (VAR == 3) { qt = u & 31; h = (u >> 5) & 3; b = u / 384; g = (u >> 7) % 3; r = (g == 0) ? 1 : (g == 1 ? 4 : 16); L = S / r; const int tpr = 32 / r; res = qt / tpr; j0 = 256 * (qt % tpr); }
    else { qt = u & 31; h = (u >> 5) & 3; b = u >> 7; j0 = 256 * qt; }
    const size_t tb = (size_t)b * S;
    const int qw = j0 + QPW * w;
    if (VAR == 1) { for (int i = tid; i < 257; i += 512) LUT[i] = P.LUTS[h * 260 + i]; }
    if (VAR == 2) { for (int i = tid; i < 465; i += 512) LUT[i] = P.rpb[h * 465 + i] * LOG2E; }
    if (VAR == 3) { for (int i = tid; i < 129; i += 512) LUT[i] = P.LUTD[(g * 4 + h) * 132 + i]; }
    bf16x8 qf[QB][NKS];
#pragma unroll
    for (int qb = 0; qb < QB; ++qb) {
        const int qi = qw + 32 * qb + r32;
        const bf16_t* qp;
        if (VAR == 0) qp = P.QM + (tb + qi) * 384 + h * 96;
        else if (VAR == 1) qp = P.ZQ + (tb + qi) * ZC + C_BQ + h * 64;
        else if (VAR == 2) qp = P.ZQ + (tb + qi) * ZC + C_CQ + h * 64;
        else qp = P.ZQ + (tb + res + (size_t)r * qi) * ZC + C_DQ + g * 256 + h * 64;
#pragma unroll
        for (int ks = 0; ks < NKS; ++ks) qf[qb][ks] = *(const bf16x8*)(qp + 16 * ks + 8 * hi);
        if (VAR == 0) {
            const float* cp = P.COS + qi * 16 + 8 * hi; const float* sp = cp + S * 16;
            const f32x4 c0 = *(const f32x4*)cp, c1 = *(const f32x4*)(cp + 4), s0 = *(const f32x4*)sp, s1 = *(const f32x4*)(sp + 4);
            const u32x4 a4 = __builtin_bit_cast(u32x4, qf[qb][4]), a5 = __builtin_bit_cast(u32x4, qf[qb][5]);
            u32x4 o4, o5;
#define ROPE2(k, ca, cb, sa, sb) { const float x1l = bf_lo(a4[k]), x1h = bf_hi(a4[k]), x2l = bf_lo(a5[k]), x2h = bf_hi(a5[k]); \
                o4[k] = cvt_pk(x1l * ca - x2l * sa, x1h * cb - x2h * sb); o5[k] = cvt_pk(x1l * sa + x2l * ca, x1h * sb + x2h * cb); }
            ROPE2(0, c0[0], c0[1], s0[0], s0[1]) ROPE2(1, c0[2], c0[3], s0[2], s0[3]) ROPE2(2, c1[0], c1[1], s1[0], s1[1]) ROPE2(3, c1[2], c1[3], s1[2], s1[3])
#undef ROPE2
            qf[qb][4] = __builtin_bit_cast(bf16x8, o4); qf[qb][5] = __builtin_bit_cast(bf16x8, o5);
        }
    }
    int NT, kfirst;
    if (VAR == 0) { NT = S / A_TK; kfirst = 0; }
    else if (VAR == 1) { NT = 2; kfirst = j0 - 128; }
    else if (VAR == 2) { const int f = min(max(4 * qt - 4, 0), 120); NT = 2; kfirst = 64 * f; }
    else { NT = 1; kfirst = j0 - 64; }
    float m_run[QB], l_run[QB];
    f32x16 o[QB][2];
#pragma unroll
    for (int qb = 0; qb < QB; ++qb) {
        m_run[qb] = (VAR == 0) ? 0.f : -1e30f; l_run[qb] = 0.f;
        if (VAR == 1) { m_run[qb] = P.sink[h] * LOG2E; l_run[qb] = (hi == 0) ? 1.0f : 0.0f; }
#pragma unroll
        for (int i = 0; i < 16; ++i) { o[qb][0][i] = 0.f; o[qb][1][i] = 0.f; }
    }
    const float c2 = 0.125f * LOG2E;
    const int qrow = (qw >> 6), qc = (qw & 63) + r32;
    const int r0 = min(max(qrow - 4, 0), 120), cs = min(max(qc - 8, 0), 48);
    const int srow = tid >> 3, sch = tid & 7, srow2 = tid >> 2, sch2 = tid & 3;
    u32x4 kreg[NLD], vreg[NLD], rreg;
    auto load_tile = [&](int t) {
#pragma unroll
        for (int i = 0; i < NLD; ++i) {
            const int kidx = kfirst + A_TK * t + srow + 64 * i;
            if (VAR == 0) {
                const bf16_t* kp = P.KVM + (tb + kidx) * 512 + h * 128 + sch * 8;
                kreg[i] = *(const u32x4*)kp; vreg[i] = *(const u32x4*)(kp + 64);
            } else if (VAR == 1) {
                const int kc = min(max(kidx, 0), S - 1); const bf16_t* base = P.ZQ + (tb + kc) * ZC + (h >> 1) * 64 + sch * 8;
                kreg[i] = *(const u32x4*)(base + C_BK); vreg[i] = *(const u32x4*)(base + C_BV);
            } else if (VAR == 2) {
                const int kc = min(kidx, S - 1); const bf16_t* base = P.ZQ + (tb + kc) * ZC + h * 64 + sch * 8;
                kreg[i] = *(const u32x4*)(base + C_CK); vreg[i] = *(const u32x4*)(base + C_CV);
            } else {
                const int kc = min(max(kidx, 0), L - 1); const bf16_t* base = P.ZQ + (tb + res + (size_t)r * kc) * ZC + g * 256 + h * 64 + sch * 8;
                kreg[i] = *(const u32x4*)(base + C_DK); vreg[i] = *(const u32x4*)(base + C_DV);
            }
        }
        if (VAR == 0) rreg = *(const u32x4*)(P.KR + (tb + kfirst + A_TK * t + srow2) * 32 + sch2 * 8);
    };
    auto store_tile = [&](int buf) {
#pragma unroll
        for (int i = 0; i < NLD; ++i) {
            *(LAS u32x4*)(lds + A_KB + buf * A_TK * A_KP + (srow + 64 * i) * A_KP + sch * 16) = kreg[i];
            *(LAS u32x4*)(lds + A_VB + buf * A_TK * A_VP + (srow + 64 * i) * A_VP + sch * 16) = vreg[i];
        }
        if (VAR == 0) *(LAS u32x4*)(lds + A_KB + buf * A_TK * A_KP + srow2 * A_KP + 128 + sch2 * 16) = rreg;
    };
    const unsigned lds_base = (unsigned)(size_t)lds;
    const unsigned dl_k = (unsigned)((lane & 31) * 1024 + (lane >> 5) * 16), dl_r = (unsigned)((lane & 31) * 64 + (lane >> 5) * 16),
                   dl_v = (unsigned)((lane >> 3) * 1024 + (((lane & 7) ^ ((lane >> 3) & 7)) << 4));
    auto dma_tile = [&](int t, int buf) {
        const size_t krow0 = tb + kfirst + A_TK * t;
#pragma unroll
        for (int q = 0; q < 3; ++q) {
            const int i = w + 8 * q, sbk = i / 6, cp = i % 6;
            const unsigned dst = (unsigned)__builtin_amdgcn_readfirstlane((int)(lds_base + A_KB + buf * 24576 + (sbk * 12 + 2 * cp) * 512));
            if (cp < 4) glds16s(dl_k, P.KVM + (krow0 + 32 * sbk) * 512 + h * 128 + 16 * cp, dst);
            else        glds16s(dl_r, P.KR + (krow0 + 32 * sbk) * 32 + 16 * (cp - 4), dst);
        }
#pragma unroll
        for (int q = 0; q < 2; ++q) {
            const int j = w + 8 * q;
            glds16s(dl_v, P.KVM + (krow0 + 8 * j) * 512 + h * 128 + 64, (unsigned)__builtin_amdgcn_readfirstlane((int)(lds_base + A_VB + buf * 16384 + j * 1024)));
        }
    };
    if constexpr (VAR == 0) { dma_tile(0, 0); asm volatile("s_waitcnt vmcnt(0)" ::: "memory"); } else { load_tile(0); store_tile(0); }
    __syncthreads();
    const int tq = lane & 15, tq_q = tq >> 2, tq_p = tq & 3, blk = (lane >> 4) & 1;
    float mxt[QB];
    if (VAR == 0) {
#pragma unroll
        for (int qb = 0; qb < QB; ++qb) {
            f32x16 s0;
#pragma unroll
            for (int i = 0; i < 16; ++i) s0[i] = 0.f;
#pragma unroll
            for (int ks = 0; ks < NKS; ++ks) {
                const bf16x8 kf = *(LAS const bf16x8*)(lds + A_KB + ((2 * ks + hi) * 32 + r32) * 16);
                s0 = __builtin_amdgcn_mfma_f32_32x32x16_bf16(kf, qf[qb][ks], s0, 0, 0, 0);
            }
            float mx = s0[0];
#pragma unroll
            for (int i = 1; i < 16; ++i) mx = fmaxf(mx, s0[i]);
            m_run[qb] = xhalf_max(mx); mxt[qb] = -INFINITY;
        }
    }
    f32x16 negm;
#pragma unroll
    for (int i = 0; i < 16; ++i) negm[i] = -fmaxf(m_run[0], m_run[QB - 1]);
    auto mla_tile = [&](const int buf) {
#define SBAR0() __builtin_amdgcn_sched_barrier(0)
#define PINV(x) asm volatile("" : "+v"(x))
#define EX(v, i) v[i] = __builtin_amdgcn_exp2f(v[i])
            LAS const unsigned char* Kt = lds + A_KB + buf * 24576 + (hi * 32 + r32) * 16;
            LAS const unsigned char* Vt = lds + A_VB + buf * 16384 + (4 * hi + tq_q) * 128 + 8 * (tq_p & 1);
            const int vsw = (4 * hi + tq_q) & 7, vch = 2 * blk + (tq_p >> 1);
            f32x16 sc0 = negm, sc1 = negm, sn0, sn1;
#pragma unroll
            for (int ks = 0; ks < NKS; ++ks) {
                const bf16x8 kfx = *(LAS const bf16x8*)(Kt + 1024 * ks);
                sc0 = __builtin_amdgcn_mfma_f32_32x32x16_bf16(kfx, qf[0][ks], sc0, 0, 0, 0);
                sc1 = __builtin_amdgcn_mfma_f32_32x32x16_bf16(kfx, qf[1][ks], sc1, 0, 0, 0);
            }
            SBAR0();
#pragma unroll
            for (int sb = 0; sb < A_TK / 32; ++sb) {
                bf16x8 vf[2][2];
#pragma unroll
                for (int d0 = 0; d0 < 1; ++d0)
#pragma unroll
                    for (int ss = 0; ss < 2; ++ss) {
                        LAS const unsigned char* vp = Vt + (32 * sb + 16 * ss) * 128 + (((4 * d0 + vch) ^ vsw) << 4);
                        const s16x4 lo = __builtin_amdgcn_ds_read_tr16_b64_v4i16((LAS s16x4*)vp);
                        const s16x4 hh = __builtin_amdgcn_ds_read_tr16_b64_v4i16((LAS s16x4*)(vp + 8 * 128));
                        vf[d0][ss] = (bf16x8){lo[0], lo[1], lo[2], lo[3], hh[0], hh[1], hh[2], hh[3]};
                    }
                if (sb + 1 < A_TK / 32) {
                    LAS const unsigned char* Kn = Kt + (sb + 1) * 6144;
                    bf16x8 k0 = *(LAS const bf16x8*)(Kn), k1 = *(LAS const bf16x8*)(Kn + 1024), k2 = *(LAS const bf16x8*)(Kn + 2048);
                    SBAR0();
                    sn0 = __builtin_amdgcn_mfma_f32_32x32x16_bf16(k0, qf[0][0], negm, 0, 0, 0); EX(sc0, 0); EX(sc0, 1); EX(sc0, 2); PINV(sc0); SBAR0();
                    sn1 = __builtin_amdgcn_mfma_f32_32x32x16_bf16(k0, qf[1][0], negm, 0, 0, 0); EX(sc1, 0); EX(sc1, 1); EX(sc1, 2); PINV(sc1); SBAR0();
                    k0 = *(LAS const bf16x8*)(Kn + 3072);
                    sn0 = __builtin_amdgcn_mfma_f32_32x32x16_bf16(k1, qf[0][1], sn0, 0, 0, 0);  EX(sc0, 3); EX(sc0, 4); EX(sc0, 5); PINV(sc0); SBAR0();
                    sn1 = __builtin_amdgcn_mfma_f32_32x32x16_bf16(k1, qf[1][1], sn1, 0, 0, 0);  EX(sc1, 3); EX(sc1, 4); EX(sc1, 5); PINV(sc1); SBAR0();
                    k1 = *(LAS const bf16x8*)(Kn + 4096);
                    sn0 = __builtin_amdgcn_mfma_f32_32x32x16_bf16(k2, qf[0][2], sn0, 0, 0, 0);  EX(sc0, 6); EX(sc0, 7); EX(sc0, 8); PINV(sc0); SBAR0();
                    sn1 = __builtin_amdgcn_mfma_f32_32x32x16_bf16(k2, qf[1][2], sn1, 0, 0, 0);  EX(sc1, 6); EX(sc1, 7); EX(sc1, 8); PINV(sc1); SBAR0();
                    k2 = *(LAS const bf16x8*)(Kn + 5120);
                    sn0 = __builtin_amdgcn_mfma_f32_32x32x16_bf16(k0, qf[0][3], sn0, 0, 0, 0);  EX(sc0, 9); EX(sc0, 10); EX(sc0, 11); PINV(sc0); SBAR0();
                    sn1 = __builtin_amdgcn_mfma_f32_32x32x16_bf16(k0, qf[1][3], sn1, 0, 0, 0);  EX(sc1, 9); EX(sc1, 10); EX(sc1, 11); PINV(sc1); SBAR0();
                    sn0 = __builtin_amdgcn_mfma_f32_32x32x16_bf16(k1, qf[0][4], sn0, 0, 0, 0);  EX(sc0, 12); EX(sc0, 13); PINV(sc0); SBAR0();
                    sn1 = __builtin_amdgcn_mfma_f32_32x32x16_bf16(k1, qf[1][4], sn1, 0, 0, 0);  EX(sc1, 12); EX(sc1, 13); PINV(sc1); SBAR0();
                    sn0 = __builtin_amdgcn_mfma_f32_32x32x16_bf16(k2, qf[0][5], sn0, 0, 0, 0);  EX(sc0, 14); EX(sc0, 15); PINV(sc0); SBAR0();
                    sn1 = __builtin_amdgcn_mfma_f32_32x32x16_bf16(k2, qf[1][5], sn1, 0, 0, 0);  EX(sc1, 14); EX(sc1, 15); PINV(sc1); SBAR0();
                } else {
#pragma unroll
                    for (int i = 0; i < 16; ++i) { EX(sc0, i); EX(sc1, i); }
                    SBAR0();
                }
                u32x4 pa0, pa1, pb0, pb1;
                pa0.x = cvt_pk(sc0[0], sc0[1]); pa0.y = cvt_pk(sc0[2], sc0[3]); pa0.z = cvt_pk(sc0[4], sc0[5]); pa0.w = cvt_pk(sc0[6], sc0[7]);
                pa1.x = cvt_pk(sc0[8], sc0[9]); pa1.y = cvt_pk(sc0[10], sc0[11]); pa1.z = cvt_pk(sc0[12], sc0[13]); pa1.w = cvt_pk(sc0[14], sc0[15]);
                pb0.x = cvt_pk(sc1[0], sc1[1]); pb0.y = cvt_pk(sc1[2], sc1[3]); pb0.z = cvt_pk(sc1[4], sc1[5]); pb0.w = cvt_pk(sc1[6], sc1[7]);
                pb1.x = cvt_pk(sc1[8], sc1[9]); pb1.y = cvt_pk(sc1[10], sc1[11]); pb1.z = cvt_pk(sc1[12], sc1[13]); pb1.w = cvt_pk(sc1[14], sc1[15]);
                const bf16x8 pf00 = __builtin_bit_cast(bf16x8, pa0), pf01 = __builtin_bit_cast(bf16x8, pa1), pf10 = __builtin_bit_cast(bf16x8, pb0), pf11 = __builtin_bit_cast(bf16x8, pb1);
                float ps0 = l_run[0], ps1 = l_run[1];
#pragma unroll
                for (int d0 = 0; d0 < 2; ++d0)
#pragma unroll
                    for (int ss = 0; ss < 2; ++ss) {
                        bf16x8 vfx;
                        if (d0 == 0) vfx = vf[0][ss];
                        else { LAS const unsigned char* vp = Vt + (32 * sb + 16 * ss) * 128 + (((4 + vch) ^ vsw) << 4);
                               const s16x4 lo = __builtin_amdgcn_ds_read_tr16_b64_v4i16((LAS s16x4*)vp);
                               const s16x4 hh = __builtin_amdgcn_ds_read_tr16_b64_v4i16((LAS s16x4*)(vp + 8 * 128));
                               vfx = (bf16x8){lo[0], lo[1], lo[2], lo[3], hh[0], hh[1], hh[2], hh[3]}; }
                        o[0][d0] = __builtin_amdgcn_mfma_f32_32x32x16_bf16(ss == 0 ? pf00 : pf01, vfx, o[0][d0], 0, 0, 0);
                        o[1][d0] = __builtin_amdgcn_mfma_f32_32x32x16_bf16(ss == 0 ? pf10 : pf11, vfx, o[1][d0], 0, 0, 0);
                        const int q4 = 4 * (2 * d0 + ss);
                        ps0 += sc0[q4]; ps0 += sc0[q4 + 1]; ps0 += sc0[q4 + 2]; ps0 += sc0[q4 + 3];
                        ps1 += sc1[q4]; ps1 += sc1[q4 + 1]; ps1 += sc1[q4 + 2]; ps1 += sc1[q4 + 3];
                    }
                l_run[0] = ps0; l_run[1] = ps1;
                if (sb + 1 < A_TK / 32) { sc0 = sn0; sc1 = sn1; }
                SBAR0();
            }
#undef SBAR0
#undef PINV
#undef EX
            if (__any(fmaxf(l_run[0], l_run[1]) > 1.8446744e19f)) {
                const float dn = 5.421010862427522e-20f;
                l_run[0] *= dn; l_run[1] *= dn;
#pragma unroll
                for (int i = 0; i < 16; ++i) { o[0][0][i] *= dn; o[0][1][i] *= dn; o[1][0][i] *= dn; o[1][1][i] *= dn; negm[i] -= 64.0f; }
            }
    };
#define LDS_BAR() asm volatile("s_waitcnt lgkmcnt(0)\n\ts_barrier" ::: "memory")
    if constexpr (VAR == 0) {
        for (int t = 0; t < NT; ++t) {
            if (t + 1 < NT) dma_tile(t + 1, (t + 1) & 1);
            mla_tile(t & 1);
            asm volatile("s_waitcnt vmcnt(0)" ::: "memory");
            LDS_BAR();
        }
    } else
    for (int t = 0; t < NT; ++t) {
        if (t + 1 < NT) load_tile(t + 1);
        const int buf = (NBUF == 2) ? (t & 1) : 0;
        if constexpr (VAR == 0) { mla_tile(buf); } else
#pragma unroll 2
        for (int sb = 0; sb < A_TK / 32; ++sb) {
            const int kb = kfirst + A_TK * t + 32 * sb;
            bool act = true;
            if (VAR == 1) act = (kb + 31 >= max(qw - 128, 0)) && (kb <= min(qw + 159, S - 1));
            if (VAR == 2) { const int kr = kb >> 6; act = (kr >= r0) && (kr < r0 + 8); }
            if (VAR == 3) act = (kb + 31 >= max(qw - 64, 0)) && (kb <= min(qw + 95, L - 1));
            if (!act) continue;
            LAS const unsigned char* Kb = lds + A_KB + buf * A_TK * A_KP + (32 * sb) * A_KP;
            LAS const unsigned char* Vb = lds + A_VB + buf * A_TK * A_VP + (32 * sb) * A_VP;
            f32x16 s[QB];
#pragma unroll
            for (int qb = 0; qb < QB; ++qb)
#pragma unroll
                for (int i = 0; i < 16; ++i) s[qb][i] = (VAR == 0) ? -m_run[qb] : 0.f;
#pragma unroll
            for (int ks = 0; ks < NKS; ++ks) {
                const bf16x8 kf = *(LAS const bf16x8*)(Kb + r32 * A_KP + (16 * ks + 8 * hi) * 2);
#pragma unroll
                for (int qb = 0; qb < QB; ++qb) s[qb] = __builtin_amdgcn_mfma_f32_32x32x16_bf16(kf, qf[qb][ks], s[qb], 0, 0, 0);
            }
            bf16x8 pf[QB][2];
#pragma unroll
            for (int qb = 0; qb < QB; ++qb) {
                if (VAR == 1 || VAR == 3) {
                    const int HALFW = (VAR == 1) ? 128 : 64, LL = (VAR == 1) ? S : L;
                    const int qpos = qw + r32;
#pragma unroll
                    for (int i = 0; i < 16; ++i) {
                        const int kp = kb + crow(i, hi), rel = kp - qpos;
                        const bool ok = (rel >= -HALFW) && (rel <= HALFW) && (kp >= 0) && (kp < LL);
                        const int idx = min(max(rel + HALFW, 0), 2 * HALFW);
                        s[qb][i] = ok ? (s[qb][i] * c2 + LUT[idx]) : -INFINITY;
                    }
                }
                if (VAR == 2) {
                    const int dr = (kb >> 6) - qrow + 7;
#pragma unroll
                    for (int i = 0; i < 16; ++i) {
                        const int ck = (kb & 63) + crow(i, hi), d = ck - qc;
                        const bool ok = (ck >= cs) && (ck < cs + 16);
                        const int idx = dr * 31 + min(max(d + 15, 0), 30);
                        s[qb][i] = ok ? (s[qb][i] * c2 + LUT[idx]) : -INFINITY;
                    }
                }
                float mx = s[qb][0];
#pragma unroll
                for (int i = 1; i < 16; ++i) mx = fmaxf(mx, s[qb][i]);
                if (VAR == 0) mxt[qb] = fmaxf(mxt[qb], mx);
                else {
                mx = xhalf_max(mx);
                const float mnew = fmaxf(m_run[qb], mx);
                if (__any(mnew != m_run[qb])) {
                    const float al = __builtin_amdgcn_exp2f(m_run[qb] - mnew);
                    l_run[qb] *= al; m_run[qb] = mnew;
                    if (hi == 0) WSF[32 * qb + r32] = al;
                    __builtin_amdgcn_fence(__ATOMIC_RELEASE, "wavefront"); __builtin_amdgcn_wave_barrier(); __builtin_amdgcn_fence(__ATOMIC_ACQUIRE, "wavefront");
#pragma unroll
                    for (int i = 0; i < 16; ++i) { const float al2 = WSF[32 * qb + crow(i, hi)]; o[qb][0][i] *= al2; o[qb][1][i] *= al2; }
                    __builtin_amdgcn_fence(__ATOMIC_RELEASE, "wavefront"); __builtin_amdgcn_wave_barrier(); __builtin_amdgcn_fence(__ATOMIC_ACQUIRE, "wavefront");
                }
                }
                float ps = 0.f;
#pragma unroll
                for (int i = 0; i < 16; ++i) { s[qb][i] = __builtin_amdgcn_exp2f((VAR == 0) ? s[qb][i] : s[qb][i] - m_run[qb]); ps += s[qb][i]; }
                l_run[qb] += ps;
                u32x4 pw0, pw1;
                pw0.x = cvt_pk(s[qb][0], s[qb][1]); pw0.y = cvt_pk(s[qb][2], s[qb][3]); pw0.z = cvt_pk(s[qb][4], s[qb][5]); pw0.w = cvt_pk(s[qb][6], s[qb][7]);
                pw1.x = cvt_pk(s[qb][8], s[qb][9]); pw1.y = cvt_pk(s[qb][10], s[qb][11]); pw1.z = cvt_pk(s[qb][12], s[qb][13]); pw1.w = cvt_pk(s[qb][14], s[qb][15]);
                pf[qb][0] = __builtin_bit_cast(bf16x8, pw0); pf[qb][1] = __builtin_bit_cast(bf16x8, pw1);
            }
#pragma unroll
            for (int d0 = 0; d0 < 2; ++d0) {
#pragma unroll
                for (int ss = 0; ss < 2; ++ss) {
                    LAS const unsigned char* vp = Vb + (16 * ss + 4 * hi + tq_q) * A_VP + (32 * d0 + 16 * blk + 4 * tq_p) * 2;
                    const s16x4 lo = __builtin_amdgcn_ds_read_tr16_b64_v4i16((LAS s16x4*)vp);
                    const s16x4 hh = __builtin_amdgcn_ds_read_tr16_b64_v4i16((LAS s16x4*)(vp + 8 * A_VP));
                    const bf16x8 vf = (bf16x8){lo[0], lo[1], lo[2], lo[3], hh[0], hh[1], hh[2], hh[3]};
#pragma unroll
                    for (int qb = 0; qb < QB; ++qb) o[qb][d0] = __builtin_amdgcn_mfma_f32_32x32x16_bf16(pf[qb][ss], vf, o[qb][d0], 0, 0, 0);
                }
            }
        }
        if (VAR == 0) {
#pragma unroll
            for (int qb = 0; qb < QB; ++qb) {
                if (__any(mxt[qb] > 64.0f)) {
                    const float dl = fmaxf(xhalf_max(mxt[qb]), 0.f), al = __builtin_amdgcn_exp2f(-dl);
                    l_run[qb] *= al; m_run[qb] += dl;
                    if (hi == 0) WSF[32 * qb + r32] = al;
                    __builtin_amdgcn_fence(__ATOMIC_RELEASE, "wavefront"); __builtin_amdgcn_wave_barrier(); __builtin_amdgcn_fence(__ATOMIC_ACQUIRE, "wavefront");
#pragma unroll
                    for (int i = 0; i < 16; ++i) { const float al2 = WSF[32 * qb + crow(i, hi)]; o[qb][0][i] *= al2; o[qb][1][i] *= al2; }
                    __builtin_amdgcn_fence(__ATOMIC_RELEASE, "wavefront"); __builtin_amdgcn_wave_barrier(); __builtin_amdgcn_fence(__ATOMIC_ACQUIRE, "wavefront");
                }
                mxt[qb] = -INFINITY;
            }
        }
        if (NBUF == 2) { if (t + 1 < NT) store_tile((t + 1) & 1); }
        else if (t + 1 < NT) { __syncthreads(); store_tile(0); }
        __syncthreads();
    }
#pragma unroll
    for (int qb = 0; qb < QB; ++qb) {
        const float lt = xhalf_sum(l_run[qb]);
        if (hi == 0) WSF[32 * qb + r32] = 1.0f / lt;
        if (VAR == 3) { if (hi == 0) P.LSE[(tb + res + (size_t)r * (qw + r32)) * 12 + g * 4 + h] = m_run[qb] + __builtin_amdgcn_logf(lt); }
    }
    __builtin_amdgcn_fence(__ATOMIC_RELEASE, "wavefront"); __builtin_amdgcn_wave_barrier(); __builtin_amdgcn_fence(__ATOMIC_ACQUIRE, "wavefront");
#pragma unroll
    for (int qb = 0; qb < QB; ++qb) {
#pragma unroll
        for (int i = 0; i < 16; ++i) {
            const int qi = qw + 32 * qb + crow(i, hi); const float al = WSF[32 * qb + crow(i, hi)];
            bf16_t* op;
            if (VAR == 3) op = P.ZQw + (tb + res + (size_t)r * qi) * ZC + C_DQ + g * 256 + h * 64;
            else op = P.Y + (tb + qi) * DM + VAR * 256 + h * 64;
            const unsigned a0 = cvt_pk(o[qb][0][i] * al, 0.f), a1 = cvt_pk(o[qb][1][i] * al, 0.f);
            op[r32] = (bf16_t)(a0 & 0xffffu); op[32 + r32] = (bf16_t)(a1 & 0xffffu);
        }
    }
    __syncthreads();
}

DI int t5_bucket(int rel) {
    const int n = rel < 0 ? -rel : rel;
    const int v = n < 8 ? n : 8 + (n >= 15) + (n >= 27) + (n >= 50) + (n >= 91) + (n >= 166) + (n >= 305) + (n >= 559);
    return (rel > 0 ? 16 : 0) + v;
}
DI void transpose_item(const float* W, int ldw, int coff, const float* kscale, bf16_t* WT, int ldt, LAS float* scr, int kb, int nb, int lane) {
    const int k0 = 64 * kb, n0 = 32 * nb;
    const int rr = lane >> 3, c4 = 4 * (lane & 7);
    f32x4 v[8];
#pragma unroll
    for (int i = 0; i < 8; ++i) v[i] = *(const f32x4*)(W + (size_t)(k0 + 8 * i + rr) * ldw + coff + n0 + c4);
#pragma unroll
    for (int i = 0; i < 8; ++i) {
        const int kk = 8 * i + rr; f32x4 x = v[i];
        if (kscale) x = x * kscale[k0 + kk];
        LAS float* d = scr + kk * 33 + c4; d[0] = x.x; d[1] = x.y; d[2] = x.z; d[3] = x.w;
    }
    __builtin_amdgcn_fence(__ATOMIC_RELEASE, "wavefront"); __builtin_amdgcn_wave_barrier(); __builtin_amdgcn_fence(__ATOMIC_ACQUIRE, "wavefront");
    const int c = lane & 7;
#pragma unroll
    for (int j = 0; j < 4; ++j) { const int n = (lane >> 3) + 8 * j; const LAS float* s = scr + (8 * c) * 33 + n;
        u32x4 o; o.x = cvt_pk(s[0 * 33], s[1 * 33]); o.y = cvt_pk(s[2 * 33], s[3 * 33]); o.z = cvt_pk(s[4 * 33], s[5 * 33]); o.w = cvt_pk(s[6 * 33], s[7 * 33]);
        *(u32x4*)(WT + (size_t)(n0 + n) * ldt + k0 + 8 * c) = o; }
    __builtin_amdgcn_fence(__ATOMIC_RELEASE, "wavefront"); __builtin_amdgcn_wave_barrier(); __builtin_amdgcn_fence(__ATOMIC_ACQUIRE, "wavefront");
}
DI void transpose_mat(const float* W, int K, int N, int ldw, int coff, const float* kscale, bf16_t* WT, int ldt, LAS float* scr, int gw, int NGW, int lane) {
    const int nblk = N / 32, items = (K / 64) * nblk;
    for (int it = gw; it < items; it += NGW) transpose_item(W, ldw, coff, kscale, WT, ldt, scr, it / nblk, it % nblk, lane);
}
template <int RN> DI void ln_rows(const float* in, float* outf, bf16_t* outb, float* stat, const float* gam, const float* bet, int lane) {
    f32x4 v[RN][4]; float mean[RN], rstd[RN];
#pragma unroll
    for (int r = 0; r < RN; ++r)
#pragma unroll
        for (int j = 0; j < 4; ++j) v[r][j] = ((const f32x4*)(in + (size_t)r * DM))[lane + 64 * j];
#pragma unroll
    for (int r = 0; r < RN; ++r) { float s = 0.f;
#pragma unroll
        for (int j = 0; j < 4; ++j) s += (v[r][j].x + v[r][j].y) + (v[r][j].z + v[r][j].w);
        mean[r] = s; }
#pragma unroll
    for (int r = 0; r < RN; ++r) mean[r] = wave_sum(mean[r]);
#pragma unroll
    for (int r = 0; r < RN; ++r) { mean[r] *= (1.f / DM); float s2 = 0.f;
#pragma unroll
        for (int j = 0; j < 4; ++j) { v[r][j] = v[r][j] - mean[r]; s2 += (v[r][j].x * v[r][j].x + v[r][j].y * v[r][j].y) + (v[r][j].z * v[r][j].z + v[r][j].w * v[r][j].w); }
        rstd[r] = s2; }
#pragma unroll
    for (int r = 0; r < RN; ++r) rstd[r] = wave_sum(rstd[r]);
#pragma unroll
    for (int r = 0; r < RN; ++r) { rstd[r] = 1.0f / sqrtf(rstd[r] * (1.f / DM) + 1e-5f); if (stat && lane == 0) { stat[2 * r] = mean[r]; stat[2 * r + 1] = rstd[r]; } }
#pragma unroll
    for (int j = 0; j < 4; ++j) {
        const f32x4 gg = ((const f32x4*)gam)[lane + 64 * j], bb = ((const f32x4*)bet)[lane + 64 * j];
#pragma unroll
        for (int r = 0; r < RN; ++r) {
            const f32x4 y = v[r][j] * rstd[r] * gg + bb;
            if (outf) ((f32x4*)(outf + (size_t)r * DM))[lane + 64 * j] = y;
            if (outb) { u32x2 w2; w2.x = cvt_pk(y.x, y.y); w2.y = cvt_pk(y.z, y.w); ((u32x2*)(outb + (size_t)r * DM))[lane + 64 * j] = w2; }
        }
    }
}

#define XB_TMO      128
#define XB_XCNT(j)  (256  + 64 * (j))
#define XB_XSUB(j)  (1280 + 64 * (j))
#define XB_XGEN(j)  (2304 + 64 * (j))
#define XB_TOP      3328
#define XB_TOPGEN   3392
#define XCD_BAR_WORDS 3456
#define XB_SPIN_CAP (1u << 20)
DI unsigned xb_ld(unsigned* p)              { return __hip_atomic_load(p, __ATOMIC_RELAXED, __HIP_MEMORY_SCOPE_AGENT); }
DI unsigned xb_add(unsigned* p, unsigned v) { return __hip_atomic_fetch_add(p, v, __ATOMIC_RELAXED, __HIP_MEMORY_SCOPE_AGENT); }
DI unsigned xb_xcc_id() { return (unsigned)__builtin_amdgcn_s_getreg((3 << 11) | 20) & 0xFu; }
#define XB_SPIN(cond, bar) do { unsigned _sp = 0; while (cond) { __builtin_amdgcn_s_sleep(1); \
    if ((++_sp & 255u) == 0u) { if (xb_ld(&(bar)[XB_TMO])) break; if (_sp > XB_SPIN_CAP) { atomicAdd(&(bar)[XB_TMO], 1u); break; } } } } while (0)
DI void xcd_barrier_complete(unsigned* bar, unsigned x, unsigned& nloc, unsigned& nx) {
    const unsigned G = gridDim.x;
    unsigned sum, cnt, mine, sp = 0u;
    for (;;) {
        sum = 0u; cnt = 0u; mine = 0u;
#pragma unroll
        for (unsigned j = 0; j < 16; ++j) { const unsigned c = xb_ld(&bar[XB_XCNT(j)]); sum += c; cnt += (c > 0u) ? 1u : 0u; mine = (j == x) ? c : mine; }
        if (sum == G) break;
        __builtin_amdgcn_s_sleep(1);
        if ((++sp & 255u) == 0u) { if (xb_ld(&bar[XB_TMO])) break; if (sp > XB_SPIN_CAP) { atomicAdd(&bar[XB_TMO], 1u); break; } }
    }
    nloc = mine > 0u ? mine : 1u; nx = cnt > 0u ? cnt : 1u;
}
DI void xcd_barrier(unsigned* bar, volatile LAS unsigned* st, bool leader) {
    asm volatile("s_waitcnt vmcnt(0)" ::: "memory");
    __syncthreads();
    if (leader) {
        const unsigned x = xb_xcc_id();
        __builtin_amdgcn_s_waitcnt(0);
        unsigned nloc = st[0], nx = st[1];
        if (nloc == 0u) { xcd_barrier_complete(bar, x, nloc, nx); st[0] = nloc; st[1] = nx; }
        const unsigned old = xb_add(&bar[XB_XSUB(x)], 1u);
        const unsigned gen = old / nloc;
        if (old + 1u == (gen + 1u) * nloc) {
            __builtin_amdgcn_fence(__ATOMIC_RELEASE, "agent");
            asm volatile("s_waitcnt vmcnt(0)" ::: "memory");
            const unsigned og = xb_add(&bar[XB_TOP], 1u);
            const unsigned tg = og / nx;
            if (og + 1u == (tg + 1u) * nx) xb_add(&bar[XB_TOPGEN], 1u);
            else XB_SPIN(xb_ld(&bar[XB_TOPGEN]) == tg, bar);
            __builtin_amdgcn_fence(__ATOMIC_ACQUIRE, "agent");
            xb_add(&bar[XB_XGEN(x)], 1u);
            asm volatile("s_waitcnt vmcnt(0)" ::: "memory");
        } else {
            XB_SPIN(xb_ld(&bar[XB_XGEN(x)]) == gen, bar);
            __builtin_amdgcn_fence(__ATOMIC_ACQUIRE, "agent");
            asm volatile("s_waitcnt vmcnt(0)" ::: "memory");
        }
    }
    __syncthreads();
}

struct Args { const float* in[22]; float* out; unsigned char* ws; int ph_lo, ph_hi; };
constexpr int PH_PER_LAYER = 11, N_PHASES = 1 + NL * PH_PER_LAYER;
constexpr int TAB_OFF = 131072 + 2048;
typedef volatile LAS unsigned long long* tab_t;
DI unsigned long long tab_get(tab_t TAB, int i) {
    const unsigned long long v = TAB[i];
    const unsigned lo = __builtin_amdgcn_readfirstlane((unsigned)v), hi = __builtin_amdgcn_readfirstlane((unsigned)(v >> 32));
    return ((unsigned long long)hi << 32) | lo;
}
#define TABF(i) ((const float*)tab_get(TAB, (i)))
#define TABWS() ((unsigned char*)tab_get(TAB, 23))
#define TABOUT() ((float*)tab_get(TAB, 22))

DI int opaque_s(int v) { asm volatile("" : "+s"(v)); return v; }
DI void conv_layer(tab_t TAB, LAS unsigned char* lds, int l, int gw, int NGW, int gt, int NGT, int wave, int lane) {
    unsigned char* ws = TABWS();
    bf16_t* Wqkv_t = (bf16_t*)(ws + W_QKV); bf16_t* Wuq_t = (bf16_t*)(ws + W_UQ); bf16_t* Wukv_t = (bf16_t*)(ws + W_UKV);
    LAS float* scr = (LAS float*)(lds + wave * 8704);
    { const float* win = TABF(5) + (size_t)l * DM * INC;
      transpose_mat(win, DM, 4000, INC, 0, nullptr, Wqkv_t, DM, scr, gw, NGW, lane);
      transpose_mat(win, DM, 4096, INC, C_G, nullptr, (bf16_t*)(ws + W_G), DM, scr, gw, NGW, lane); }
    transpose_mat(TABF(16) + (size_t)l * DM * FF, DM, FF, FF, 0, nullptr, (bf16_t*)(ws + W_FF1), DM, scr, gw, NGW, lane);
    transpose_mat(TABF(17) + (size_t)l * FF * DM, FF, DM, DM, 0, nullptr, (bf16_t*)(ws + W_FF2), FF, scr, gw, NGW, lane);
    for (int n = 0; n < 4; ++n) transpose_mat(TABF(12) + ((size_t)l * 4 + n) * 256 * DM, 256, DM, DM, 0, nullptr, (bf16_t*)(ws + W_B) + (size_t)n * DM * 256, 256, scr, gw, NGW, lane);
    transpose_mat(TABF(13) + (size_t)l * DM * DM, DM, DM, DM, 0, nullptr, (bf16_t*)(ws + W_OUT), DM, scr, gw, NGW, lane);
    transpose_mat(TABF(19) + (size_t)l * DM * DM, DM, DM, DM, 0, nullptr, (bf16_t*)(ws + W_PG), DM, scr, gw, NGW, lane);
    transpose_mat(TABF(18) + (size_t)l * 256 * DM, 256, DM, DM, 0, nullptr, (bf16_t*)(ws + W_PLE), 256, scr, gw, NGW, lane);
    transpose_mat(TABF(7) + (size_t)l * 256 * 384, 256, 384, 384, 0, TABF(6) + l * 256, Wuq_t, 256, scr, gw, NGW, lane);
    transpose_mat(TABF(9) + (size_t)l * 128 * 512, 128, 512, 512, 0, TABF(8) + l * 128, Wukv_t, 256, scr, gw, NGW, lane);
    for (int i = gt; i < 96 * DM / 2; i += NGT) ((unsigned*)(Wqkv_t + (size_t)4000 * DM))[i] = 0u;
    for (int i = gt; i < 128 * 256 / 2; i += NGT) ((unsigned*)(Wuq_t + (size_t)384 * 256))[i] = 0u;
    for (int i = gt; i < 512 * 64; i += NGT) { const int rr = i >> 6, cc = i & 63; ((unsigned*)(Wukv_t + (size_t)rr * 256 + 128))[cc] = 0u; }
    const float* pl = TABF(1) + (size_t)l * T * 256; bf16_t* PB = (bf16_t*)(ws + WS_PB);
    for (int i = gt; i < T * 256 / 8; i += NGT) {
        const f32x4 v0 = ((const f32x4*)pl)[2 * i], v1 = ((const f32x4*)pl)[2 * i + 1];
        u32x4 o; o.x = cvt_pk(v0.x, v0.y); o.y = cvt_pk(v0.z, v0.w); o.z = cvt_pk(v1.x, v1.y); o.w = cvt_pk(v1.z, v1.w);
        ((u32x4*)PB)[i] = o;
    }
}

__global__ void __launch_bounds__(512) fwd_kernel(Args a) {
    extern __shared__ __attribute__((aligned(16))) unsigned char lds_raw[];
    LAS unsigned char* lds = (LAS unsigned char*)lds_raw;
    cg::grid_group grid = cg::this_grid();
    tab_t TAB = (tab_t)(lds + TAB_OFF);
    if (threadIdx.x == 0) {
#pragma unroll
        for (int i = 0; i < 22; ++i) TAB[i] = (unsigned long long)a.in[i];
        TAB[22] = (unsigned long long)a.out; TAB[23] = (unsigned long long)a.ws;
    }
    volatile LAS unsigned* BST = (volatile LAS unsigned*)(lds + TAB_OFF + 256);
    if (threadIdx.x < 2) BST[threadIdx.x] = 0u;
    if (blockIdx.x == 0) { unsigned* bw = (unsigned*)a.ws; for (int i = threadIdx.x; i < XCD_BAR_WORDS; i += 512) bw[i] = 0u; }
    __syncthreads();
    const int ph_lo = a.ph_lo, ph_hi = a.ph_hi;
    const int wave_s = __builtin_amdgcn_readfirstlane((int)threadIdx.x >> 6);
#define TIDS int tid_ = wave_s * 64 + lane_id(); asm volatile("" : "+v"(tid_)); const int tid = tid_, lane = tid & 63, wave = __builtin_amdgcn_readfirstlane(tid >> 6); int G_ = gridDim.x, bid_ = blockIdx.x; asm volatile("" : "+s"(G_), "+s"(bid_)); const int G = G_, bid = bid_; \
             const int gw = bid * 8 + wave, NGW = G * 8; const int gt = bid * 512 + tid, NGT = G * 512; (void)lane; (void)gw; (void)NGW; (void)gt; (void)NGT; (void)wave;
#define GRIDX opaque_s((int)gridDim.x)
#define BIDX opaque_s((int)blockIdx.x)
#define PHASE(k) asm volatile("" ::: "memory"); if (ph_lo <= (k) && (k) < ph_hi)
#define SEAM0(k) do { if (ph_lo <= (k) && (k) + 1 < ph_hi) { grid.sync(); if (wave_s == 0 && lane_id() == 0) (void)xb_add(&((unsigned*)TABWS())[XB_XCNT(xb_xcc_id())], 1u); } } while (0)
#define SEAM(k) do { if (ph_lo <= (k) && (k) + 1 < ph_hi) xcd_barrier((unsigned*)TABWS(), BST, wave_s == 0 && lane_id() == 0); } while (0)

    PHASE(0) {
        TIDS
        conv_layer(TAB, lds, 0, gw, NGW, gt, NGT, wave, lane);
        unsigned char* ws = TABWS();
        float* COS = (float*)(ws + WS_ROPE); float* SIN = COS + S * 16;
        for (int i = gt; i < S * 16; i += NGT) {
            const int pos = i >> 4, f = i & 15;
            const double b4 = (f & 3) == 0 ? 1.0 : ((f & 3) == 1 ? 0.5623413251903491 : ((f & 3) == 2 ? 0.31622776601683794 : 0.1778279410038923));
            const double p10 = (f >> 2) == 0 ? 1.0 : ((f >> 2) == 1 ? 0.1 : ((f >> 2) == 2 ? 0.01 : 0.001));
            const float inv = (float)(b4 * p10);
            const float ang = (float)pos * inv;
            double rev = (double)ang * 0.15915494309189535; rev -= floor(rev);
            COS[i] = __builtin_amdgcn_cosf((float)rev); SIN[i] = __builtin_amdgcn_sinf((float)rev);
        }
        const float* rel_bias = TABF(4); float* LUTS = (float*)(ws + WS_LUTS); float* LUTD = (float*)(ws + WS_LUTD);
        for (int i = gt; i < 4 * 257; i += NGT) { const int hh = i / 257, rl = i % 257 - 128; LUTS[hh * 260 + rl + 128] = rel_bias[t5_bucket(rl) * 16 + hh] * LOG2E; }
        for (int i = gt; i < 12 * 129; i += NGT) { const int gh = i / 129, rl = i % 129 - 64, gg = gh >> 2; const int rr = gg == 0 ? 1 : (gg == 1 ? 4 : 16);
            LUTD[gh * 132 + rl + 64] = rel_bias[t5_bucket(rl * rr) * 16 + 4 + gh] * LOG2E; }
        const float* x = TABF(0); float* H = TABOUT(); bf16_t* HB = (bf16_t*)(ws + WS_HB); const float* eg = TABF(2); const float* eb = TABF(3);
        float* ST = (float*)(ws + WS_STATS); (void)H;
        for (int m = gw * 8; m < T; m += NGW * 8) ln_rows<8>(x + (size_t)m * DM, nullptr, HB + (size_t)m * DM, ST + (size_t)m * 2, eg, eb, lane);
    }
    SEAM0(0);

    for (int l = 0; l < NL; ++l) {
        const int P0 = 1 + l * PH_PER_LAYER;
        PHASE(P0 + 0) {
            unsigned char* ws = TABWS();
            pg8::Gemm g{(const bf16_t*)(ws + WS_HB), (const bf16_t*)(ws + W_QKV), DM, DM}; pg8::StaticOrder so; so.init(T, ZC, GRIDX, BIDX);
            pg8::EpiStore<0> E{(bf16_t*)(ws + WS_Z), ZC, ZC, nullptr, 0, 1.0f};
            pg8::gemm_phase(lds, g, so, E, wave_s);
        }
        SEAM(P0 + 0);
        PHASE(P0 + 1) {
            { TIDS
              unsigned char* ws = TABWS();
              const bf16_t* ZQ = (const bf16_t*)(ws + WS_Z); float* RSTD = (float*)(ws + WS_RSTD); bf16_t* KR = (bf16_t*)(ws + WS_KR);
              const float* COS = (const float*)(ws + WS_ROPE); const float* SIN = COS + S * 16;
              pg8::StaticOrder so; so.init(T, 512, G, bid); pg8::Unit uu;
              for (int i = 0; so.tile(i, uu); ++i) {
                  const int ch = lane & 7;
#pragma unroll 1
                  for (int it = 0; it < 4; ++it) {
                      const int m = uu.pm * 256 + wave * 32 + it * 8 + (lane >> 3);
                      const bf16_t* zr = ZQ + (size_t)m * ZC;
                      float sq = 0.f, sk = 0.f;
#pragma unroll
                      for (int j = 0; j < 4; ++j) { const u32x4 q = *(const u32x4*)(zr + C_AQ + ch * 32 + 8 * j);
                          sq += bf_lo(q.x) * bf_lo(q.x) + bf_hi(q.x) * bf_hi(q.x) + bf_lo(q.y) * bf_lo(q.y) + bf_hi(q.y) * bf_hi(q.y)
                              + bf_lo(q.z) * bf_lo(q.z) + bf_hi(q.z) * bf_hi(q.z) + bf_lo(q.w) * bf_lo(q.w) + bf_hi(q.w) * bf_hi(q.w); }
#pragma unroll
                      for (int j = 0; j < 2; ++j) { const u32x4 q = *(const u32x4*)(zr + C_AKV + ch * 16 + 8 * j);
                          sk += bf_lo(q.x) * bf_lo(q.x) + bf_hi(q.x) * bf_hi(q.x) + bf_lo(q.y) * bf_lo(q.y) + bf_hi(q.y) * bf_hi(q.y)
                              + bf_lo(q.z) * bf_lo(q.z) + bf_hi(q.z) * bf_hi(q.z) + bf_lo(q.w) * bf_lo(q.w) + bf_hi(q.w) * bf_hi(q.w); }
                      sq += shx<1>(sq); sk += shx<1>(sk); sq += shx<2>(sq); sk += shx<2>(sk); sq += shx<4>(sq); sk += shx<4>(sk);
                      if (ch == 0) { RSTD[(size_t)m * 2] = 1.0f / sqrtf(sq * (1.f / 256.f) + 1e-6f); RSTD[(size_t)m * 2 + 1] = 1.0f / sqrtf(sk * (1.f / 128.f) + 1e-6f); }
                      if (ch < 4 && uu.pn == 0) {
                          const int pos = m & (S - 1);
                          const u32x2 a1 = *(const u32x2*)(zr + C_AKR + 4 * ch), a2 = *(const u32x2*)(zr + C_AKR + 16 + 4 * ch);
                          const f32x4 c = *(const f32x4*)(COS + pos * 16 + 4 * ch), sn = *(const f32x4*)(SIN + pos * 16 + 4 * ch);
                          const float x10 = bf_lo(a1.x), x11 = bf_hi(a1.x), x12 = bf_lo(a1.y), x13 = bf_hi(a1.y), x20 = bf_lo(a2.x), x21 = bf_hi(a2.x), x22 = bf_lo(a2.y), x23 = bf_hi(a2.y);
                          u32x2 o1, o2;
                          o1.x = cvt_pk(x10 * c.x - x20 * sn.x, x11 * c.y - x21 * sn.y); o1.y = cvt_pk(x12 * c.z - x22 * sn.z, x13 * c.w - x23 * sn.w);
                          o2.x = cvt_pk(x10 * sn.x + x20 * c.x, x11 * sn.y + x21 * c.y); o2.y = cvt_pk(x12 * sn.z + x22 * c.z, x13 * sn.w + x23 * c.w);
                          *(u32x2*)(KR + (size_t)m * 32 + 4 * ch) = o1; *(u32x2*)(KR + (size_t)m * 32 + 16 + 4 * ch) = o2;
                      }
                  }
              }
              asm volatile("s_waitcnt vmcnt(0)" ::: "memory");
              __syncthreads();
            }
            asm volatile("" ::: "memory");
            { unsigned char* ws = TABWS();
              pg8::Gemm g{(const bf16_t*)(ws + WS_Z) + C_AQ, (const bf16_t*)(ws + W_UQ), ZC, 256}; pg8::StaticOrder so; so.init(T, 512, GRIDX, BIDX);
              pg8::EpiStore<0> E{(bf16_t*)(ws + WS_QM), 384, 384, (const float*)(ws + WS_RSTD), 2, 0.10206207261596575f * LOG2E};
              pg8::gemm_phase(lds, g, so, E, wave_s); }
            asm volatile("" ::: "memory");
            { unsigned char* ws = TABWS();
              pg8::Gemm g{(const bf16_t*)(ws + WS_Z) + C_AKV, (const bf16_t*)(ws + W_UKV), ZC, 256}; pg8::StaticOrder so; so.init(T, 512, GRIDX, BIDX);
              pg8::EpiStore<0> E{(bf16_t*)(ws + WS_KVM), 512, 512, (const float*)(ws + WS_RSTD) + 1, 2, 1.0f};
              pg8::gemm_phase(lds, g, so, E, wave_s); }
        }
        SEAM(P0 + 1);
        PHASE(P0 + 2) {
            unsigned char* ws = TABWS(); const int G = GRIDX, bid = BIDX;
            bf16_t* ZQ = (bf16_t*)(ws + WS_Z);
            AttnP AP{ZQ, (const bf16_t*)(ws + WS_QM), (const bf16_t*)(ws + WS_KVM), (const bf16_t*)(ws + WS_KR), (bf16_t*)(ws + WS_Y), ZQ, (float*)(ws + WS_LSE),
                     (const float*)(ws + WS_LUTS), (const float*)(ws + WS_LUTD), TABF(11) + (size_t)l * 4 * 465, TABF(10) + l * 4, (const float*)(ws + WS_ROPE)};
            const int xq = bid & 7, jq = bid >> 3, Gq = (G + 7 - xq) >> 3;
            for (int j = jq; j < 32; j += Gq) attn_unit<0>(lds, AP, xq * 32 + j, wave_s);
            for (int j = jq; j < 64; j += Gq) attn_unit<1>(lds, AP, xq * 64 + j, wave_s);
            for (int j = jq; j < 64; j += Gq) attn_unit<2>(lds, AP, xq * 64 + j, wave_s);
            for (int j = jq; j < 192; j += Gq) attn_unit<3>(lds, AP, xq * 192 + j, wave_s);
        }
        SEAM(P0 + 2);
        PHASE(P0 + 3) {
            TIDS
            unsigned char* ws = TABWS();
            const bf16_t* ZQ = (const bf16_t*)(ws + WS_Z); const float* LSE = (const float*)(ws + WS_LSE); bf16_t* Y = (bf16_t*)(ws + WS_Y);
            for (int i = gt; i < T * 32; i += NGT) {
                const int m = i >> 5, hh = (i >> 3) & 3, ch = i & 7;
                const float l0 = LSE[(size_t)m * 12 + hh], l1 = LSE[(size_t)m * 12 + 4 + hh], l2 = LSE[(size_t)m * 12 + 8 + hh];
                const float mx = fmaxf(l0, fmaxf(l1, l2));
                float w0 = __builtin_amdgcn_exp2f(l0 - mx), w1 = __builtin_amdgcn_exp2f(l1 - mx), w2 = __builtin_amdgcn_exp2f(l2 - mx);
                const float inv = 1.0f / (w0 + w1 + w2); w0 *= inv; w1 *= inv; w2 *= inv;
                const bf16_t* zp = ZQ + (size_t)m * ZC + C_DQ + hh * 64 + ch * 8;
                const u32x4 a0 = *(const u32x4*)zp, a1 = *(const u32x4*)(zp + 256), a2 = *(const u32x4*)(zp + 512);
                u32x4 o;
                o.x = cvt_pk(w0 * bf_lo(a0.x) + w1 * bf_lo(a1.x) + w2 * bf_lo(a2.x), w0 * bf_hi(a0.x) + w1 * bf_hi(a1.x) + w2 * bf_hi(a2.x));
                o.y = cvt_pk(w0 * bf_lo(a0.y) + w1 * bf_lo(a1.y) + w2 * bf_lo(a2.y), w0 * bf_hi(a0.y) + w1 * bf_hi(a1.y) + w2 * bf_hi(a2.y));
                o.z = cvt_pk(w0 * bf_lo(a0.z) + w1 * bf_lo(a1.z) + w2 * bf_lo(a2.z), w0 * bf_hi(a0.z) + w1 * bf_hi(a1.z) + w2 * bf_hi(a2.z));
                o.w = cvt_pk(w0 * bf_lo(a0.w) + w1 * bf_lo(a1.w) + w2 * bf_lo(a2.w), w0 * bf_hi(a0.w) + w1 * bf_hi(a1.w) + w2 * bf_hi(a2.w));
                *(u32x4*)(Y + (size_t)m * DM + 768 + hh * 64 + ch * 8) = o;
            }
        }
        SEAM(P0 + 3);
        PHASE(P0 + 4) {
            unsigned char* ws = TABWS();
            pg8::Gemm g{(const bf16_t*)(ws + WS_HB), (const bf16_t*)(ws + W_G), DM, DM}; pg8::StaticOrder so; so.init(T, ZC, GRIDX, BIDX);
            pg8::EpiStore<1> E{(bf16_t*)(ws + WS_Z), ZC, ZC, nullptr, 0, 1.0f};
            pg8::gemm_phase(lds, g, so, E, wave_s);
        }
        SEAM(P0 + 4);
        PHASE(P0 + 5) {
            unsigned char* ws = TABWS();
            pg8::Gemm g{(const bf16_t*)(ws + WS_Y), (const bf16_t*)(ws + W_B), DM, 256}; pg8::MergeOrder mo; mo.s.init(T, DM, GRIDX, BIDX);
            pg8::EpiMerge E{(bf16_t*)(ws + WS_MG), (const bf16_t*)(ws + WS_Z)};
            pg8::gemm_phase(lds, g, mo, E, wave_s);
        }
        SEAM(P0 + 5);
        PHASE(P0 + 6) {
            unsigned char* ws = TABWS();
            pg8::Gemm g{(const bf16_t*)(ws + WS_MG), (const bf16_t*)(ws + W_OUT), DM, DM}; pg8::StaticOrder so; so.init(T, DM, GRIDX, BIDX);
            float* Hout = TABOUT();
            pg8::EpiResid<false> E{l == 0 ? TABF(0) : (const float*)Hout, Hout, nullptr, (const float*)(ws + WS_STATS), l == 0 ? TABF(2) : TABF(20) + (l - 1) * DM, l == 0 ? TABF(3) : TABF(21) + (l - 1) * DM};
            pg8::gemm_phase(lds, g, so, E, wave_s);
        }
        SEAM(P0 + 6);
        PHASE(P0 + 7) {
            TIDS
            unsigned char* ws = TABWS(); float* H = TABOUT(); bf16_t* HB = (bf16_t*)(ws + WS_HB); const float* gg = TABF(14) + l * DM; const float* bb = TABF(15) + l * DM;
            float* ST = (float*)(ws + WS_STATS);
            for (int m = gw * 8; m < T; m += NGW * 8) ln_rows<8>(H + (size_t)m * DM, nullptr, HB + (size_t)m * DM, ST + (size_t)m * 2, gg, bb, lane);
        }
        SEAM(P0 + 7);
        PHASE(P0 + 8) {
            { unsigned char* ws = TABWS();
              pg8::Gemm g{(const bf16_t*)(ws + WS_HB), (const bf16_t*)(ws + W_FF1), DM, DM}; pg8::StaticOrder so; so.init(T, FF, GRIDX, BIDX);
              pg8::EpiStore<2> E{(bf16_t*)(ws + WS_Z), FF, FF, nullptr, 0, 1.0f};
              pg8::gemm_phase(lds, g, so, E, wave_s); }
            asm volatile("" ::: "memory");
            { unsigned char* ws = TABWS();
              pg8::Gemm g{(const bf16_t*)(ws + WS_HB), (const bf16_t*)(ws + W_PG), DM, DM}; pg8::StaticOrder so; so.init(T, DM, GRIDX, BIDX);
              pg8::EpiStore<1> E{(bf16_t*)(ws + WS_Y), DM, DM, nullptr, 0, 1.0f};
              pg8::gemm_phase(lds, g, so, E, wave_s); }
            asm volatile("" ::: "memory");
            { unsigned char* ws = TABWS();
              pg8::Gemm g{(const bf16_t*)(ws + WS_PB), (const bf16_t*)(ws + W_PLE), 256, 256}; pg8::StaticOrder so; so.init(T, DM, GRIDX, BIDX);
              pg8::EpiMulInto E{(bf16_t*)(ws + WS_Y)};
              pg8::gemm_phase(lds, g, so, E, wave_s); }
        }
        SEAM(P0 + 8);
        PHASE(P0 + 9) {
            unsigned char* ws = TABWS();
            pg8::Gemm g{(const bf16_t*)(ws + WS_Z), (const bf16_t*)(ws + W_FF2), FF, FF}; pg8::StaticOrder so; so.init(T, DM, GRIDX, BIDX);
            float* Hout = TABOUT();
            pg8::EpiResid<true> E{(const float*)Hout, Hout, (const bf16_t*)(ws + WS_Y), (const float*)(ws + WS_STATS), TABF(14) + l * DM, TABF(15) + l * DM};
            pg8::gemm_phase(lds, g, so, E, wave_s);
        }
        SEAM(P0 + 9);
        PHASE(P0 + 10) {
            TIDS
            unsigned char* ws = TABWS(); float* H = TABOUT(); bf16_t* HB = (bf16_t*)(ws + WS_HB); const float* gg = TABF(20) + l * DM; const float* bb = TABF(21) + l * DM;
            float* ST = (float*)(ws + WS_STATS);
            if (l + 1 < NL) { for (int m = gw * 8; m < T; m += NGW * 8) ln_rows<8>(H + (size_t)m * DM, nullptr, HB + (size_t)m * DM, ST + (size_t)m * 2, gg, bb, lane); }
            else { for (int m = gw * 8; m < T; m += NGW * 8) ln_rows<8>(H + (size_t)m * DM, H + (size_t)m * DM, nullptr, nullptr, gg, bb, lane); }
            if (l + 1 < NL) conv_layer(TAB, lds, l + 1, gw, NGW, gt, NGT, wave, lane);
        }
        if (l + 1 < NL) SEAM(P0 + 10);
    }
}

extern "C" void kernel_launch(void* const* d_in, const int* in_sizes, int n_in, void* d_out, int out_size, void* d_ws, size_t ws_size, hipStream_t stream) {
    static int grid = 0;
    if (grid == 0) {
        if (n_in != 22 || out_size != T * DM || ws_size < WS_END) { fprintf(stderr, "kernel_launch: unexpected shapes (n_in %d out %d ws %zu)\n", n_in, out_size, ws_size); grid = -1; return; }
        int dev = 0, cus = 0, per = 0;
        (void)hipGetDevice(&dev); (void)hipDeviceGetAttribute(&cus, hipDeviceAttributeMultiprocessorCount, dev);
        (void)hipFuncSetAttribute((const void*)fwd_kernel, hipFuncAttributeMaxDynamicSharedMemorySize, LDS_BYTES);
        (void)hipOccupancyMaxActiveBlocksPerMultiprocessor(&per, (const void*)fwd_kernel, 512, LDS_BYTES);
        if (per < 1) per = 1;
        grid = cus * per;
        fprintf(stderr, "kernel_launch: grid %d (cus %d x %d)\n", grid, cus, per);
    }
    if (grid < 0) return;
    Args a{};
    for (int i = 0; i < 22; ++i) a.in[i] = (const float*)d_in[i];
    a.out = (float*)d_out; a.ws = (unsigned char*)d_ws;
#if N_LAUNCH_MODE == 1
    a.ph_lo = 0; a.ph_hi = N_PHASES;
    void* args[] = {&a};
    hipError_t e = hipLaunchCooperativeKernel((void*)fwd_kernel, dim3(grid), dim3(512), args, LDS_BYTES, stream);
    if (e != hipSuccess) fprintf(stderr, "cooperative launch failed: %s (grid %d)\n", hipGetErrorString(e), grid);
#else
    for (int k = 0; k < N_PHASES; ++k) { a.ph_lo = k; a.ph_hi = k + 1; hipLaunchKernelGGL(fwd_kernel, dim3(grid), dim3(512), LDS_BYTES, stream, a); }
#endif
}
```

```cpp
#include <hip/hip_runtime.h>
#include <hip/hip_cooperative_groups.h>
#include <cstdio>
#include <cstdint>
namespace cg = cooperative_groups;

#define LAS __attribute__((address_space(3)))
#define DI __device__ __forceinline__
typedef unsigned short bf16_t;
typedef short bf16x8 __attribute__((ext_vector_type(8)));
typedef short s16x4 __attribute__((ext_vector_type(4)));
typedef float f32x4 __attribute__((ext_vector_type(4)));
typedef float f32x2 __attribute__((ext_vector_type(2)));
typedef float f32x16 __attribute__((ext_vector_type(16)));
typedef unsigned u32x4 __attribute__((ext_vector_type(4)));
typedef unsigned u32x2 __attribute__((ext_vector_type(2)));
typedef __bf16 bf16x2_t __attribute__((ext_vector_type(2)));

#ifndef N_LAUNCH_MODE
#define N_LAUNCH_MODE 1
#endif

constexpr int T = 32768, S = 8192, DM = 1024, FF = 4096, INC = 8096, ZC = 4096, NL = 2;
constexpr int C_AQ = 0, C_AKV = 256, C_AKR = 384, C_BQ = 416, C_BK = 672, C_BV = 800, C_CQ = 928, C_CK = 1184, C_CV = 1440,
              C_DQ = 1696, C_DK = 2464, C_DV = 3232, C_G = 4000;
constexpr float LOG2E = 1.4426950408889634f;
constexpr float ALPHA = 1.4142135623730951f;

constexpr size_t MiB = 1u << 20;
constexpr size_t WS_RSTD = 64 * 1024, WS_LUTS = 320 * 1024, WS_LUTD = 328 * 1024, WS_LSE = 512 * 1024;
constexpr size_t WS_W = 2 * MiB;
constexpr size_t W_QKV = WS_W, W_G = WS_W + 8 * MiB, W_FF1 = WS_W + 16 * MiB, W_FF2 = WS_W + 24 * MiB, W_B = WS_W + 32 * MiB, W_OUT = WS_W + 34 * MiB,
                 W_PG = WS_W + 36 * MiB, W_PLE = WS_W + 38 * MiB, W_UQ = WS_W + 38 * MiB + 512 * 1024, W_UKV = WS_W + 38 * MiB + 768 * 1024;
constexpr size_t WS_ROPE = 41 * MiB, WS_PB = 42 * MiB, WS_HB = 58 * MiB, WS_Z = 122 * MiB, WS_Y = 378 * MiB, WS_M = 442 * MiB;
constexpr size_t WS_QM = WS_M, WS_KVM = WS_M + 24 * MiB, WS_KR = WS_M + 56 * MiB, WS_MG = WS_M;
constexpr size_t WS_STATS = 506 * MiB;
constexpr size_t WS_END = 512 * MiB;

constexpr int LDS_BYTES = 135168;

DI unsigned cvt_pk(float lo, float hi) { f32x2 v = {lo, hi}; bf16x2_t b = __builtin_convertvector(v, bf16x2_t); return __builtin_bit_cast(unsigned, b); }
DI float bf_lo(unsigned u) { return __uint_as_float(u << 16); }
DI float bf_hi(unsigned u) { return __uint_as_float(u & 0xffff0000u); }
DI float xhalf_max(float m) { auto rr = __builtin_amdgcn_permlane32_swap(__float_as_uint(m), __float_as_uint(m), false, false); return fmaxf(__uint_as_float(rr[0]), __uint_as_float(rr[1])); }
DI float xhalf_sum(float m) { auto rr = __builtin_amdgcn_permlane32_swap(__float_as_uint(m), __float_as_uint(m), false, false); return __uint_as_float(rr[0]) + __uint_as_float(rr[1]); }
template <int O> DI float shx(float v) { return __int_as_float(__builtin_amdgcn_ds_swizzle(__float_as_int(v), (O << 10) | 0x1f)); }
DI float wave_sum(float v) {
    v += shx<1>(v); v += shx<2>(v); v += shx<4>(v); v += shx<8>(v); v += shx<16>(v); v = xhalf_sum(v);
    return v;
}
DI float sigmoid_f(float x) { return __builtin_amdgcn_rcpf(1.0f + __builtin_amdgcn_exp2f(-x * LOG2E)); }
DI int lane_id() { int l; asm volatile("v_mbcnt_lo_u32_b32 %0, -1, 0\n\tv_mbcnt_hi_u32_b32 %0, -1, %0" : "=v"(l)); return l; }
DI int crow(int r, int hi) { return (r & 3) + 8 * (r >> 2) + 4 * hi; }

namespace pg8 {
constexpr int BM = 256, BK = 64, HALF = 128, HTB = HALF * BK * 2, STAGE_BYTES = 8 * HTB, NXCD = 8, WGM = 8;
DI int lds_byte(int r, int c) { const int st = (r >> 4) * 2 + (c >> 5), rr = r & 15, cc = c & 31, ob = rr * 64 + cc * 2; return st * 1024 + (ob ^ (((ob >> 9) & 1) << 5)); }
DI void stage_rc(int b, int& R, int& C) { const int st = b / 1024, sb = b % 1024, swz = sb ^ (((sb >> 9) & 1) << 5); R = (st >> 1) * 16 + swz / 64; C = (st & 1) * 32 + (swz % 64) / 2; }
DI int perm32(int rho) { const int n = rho >> 4, i = rho & 15; return 8 * (i >> 2) + 4 * n + (i & 3); }

struct Unit { int pm, pn, z; };
struct Gemm { const bf16_t* A; const bf16_t* Bt; int lda; int K; };

struct StaticOrder {
    int nM, nN, nwg, G, c;
    DI void init(int M, int N, int G_, int c_) { nM = M / BM; nN = N / BM; nwg = nM * nN; G = G_; c = c_; }
    DI bool tile(int i, Unit& u) const {
        const long L = (long)i * G + c; if (L >= nwg) return false;
        int wgid = (int)L; { const int q = nwg / NXCD, r = nwg % NXCD, xcd = wgid % NXCD, off = wgid / NXCD; wgid = (xcd < r ? xcd * (q + 1) : r * (q + 1) + (xcd - r) * q) + off; }
        const int nig = WGM * nN, gid = wgid / nig, fm = gid * WGM, gsz = (nM - fm) < WGM ? (nM - fm) : WGM;
        u.pm = fm + ((wgid % nig) % gsz); u.pn = (wgid % nig) / gsz; u.z = 0; return true;
    }
    DI bool next(int i, Unit& u) const { return tile(i, u); }
    DI size_t aoff(const Unit& u, const Gemm& g) const { return (size_t)u.pm * BM * g.lda * 2; }
    DI size_t boff(const Unit& u, const Gemm& g) const { return (size_t)u.pn * BM * g.K * 2; }
};
struct MergeOrder {
    StaticOrder s;
    DI bool next(int i, Unit& u) const { if (!s.tile(i >> 2, u)) return false; u.z = i & 3; return true; }
    DI size_t aoff(const Unit& u, const Gemm& g) const { return (size_t)u.pm * BM * g.lda * 2 + (size_t)u.z * 256 * 2; }
    DI size_t boff(const Unit& u, const Gemm& g) const { return (size_t)(u.z * 4 + u.pn) * BM * g.K * 2; }
};

#define EPI_ROWS_BEGIN \
    _Pragma("unroll") for (int ai = 0; ai < 2; ++ai) _Pragma("unroll") for (int m = 0; m < 4; ++m) { const int row = u.pm * BM + ai * HALF + wr * 64 + m * 16 + fr;
#define EPI_COLS_BEGIN \
    _Pragma("unroll") for (int bj = 0; bj < 2; ++bj) { const int col = u.pn * BM + bj * HALF + wc * 32 + 8 * fq; f32x4 v0 = acc[ai][bj][m][0], v1 = acc[ai][bj][m][1];
#define EPI_END } asm volatile("" ::: "memory"); }

template <int ACT  > struct EpiStore {
    bf16_t* O; int ldc; int ncv; const float* rs; int rss; float cmul;
    DI void operator()(const f32x4 (&acc)[2][2][4][2], const Unit& u, int wr, int wc, int fr, int fq) const {
        float scv[2][4];
#pragma unroll
        for (int ai = 0; ai < 2; ++ai)
#pragma unroll
            for (int m = 0; m < 4; ++m) scv[ai][m] = rs ? rs[(size_t)(u.pm * BM + ai * HALF + wr * 64 + m * 16 + fr) * rss] * cmul : 1.0f;
        EPI_ROWS_BEGIN
            const float sc = scv[ai][m]; bf16_t* rowp = O + (size_t)row * ldc;
            EPI_COLS_BEGIN
                if (col < ncv) {
                    v0 = v0 * sc; v1 = v1 * sc;
                    if (ACT == 1) {
#pragma unroll
                        for (int j = 0; j < 4; ++j) { v0[j] = sigmoid_f(v0[j]); v1[j] = sigmoid_f(v1[j]); }
                    }
                    if (ACT == 2) {
#pragma unroll
                        for (int j = 0; j < 4; ++j) { const float a = fmaxf(v0[j], 0.f), b = fmaxf(v1[j], 0.f); v0[j] = a * a; v1[j] = b * b; }
                    }
                    u32x4 w; w.x = cvt_pk(v0[0], v0[1]); w.y = cvt_pk(v0[2], v0[3]); w.z = cvt_pk(v1[0], v1[1]); w.w = cvt_pk(v1[2], v1[3]);
                    *(u32x4*)(rowp + col) = w;
                }
            }
            asm volatile("" ::: "memory");
        }
    }
};
#define EPI_ROW(ai, m) (u.pm * BM + (ai) * HALF + wr * 64 + (m) * 16 + fr)
#define EPI_COL(bj) (u.pn * BM + (bj) * HALF + wc * 32 + 8 * fq)
DI void mul_bf8(f32x4& v0, f32x4& v1, const u32x4 g) {
    v0[0] *= bf_lo(g.x); v0[1] *= bf_hi(g.x); v0[2] *= bf_lo(g.y); v0[3] *= bf_hi(g.y); v1[0] *= bf_lo(g.z); v1[1] *= bf_hi(g.z); v1[2] *= bf_lo(g.w); v1[3] *= bf_hi(g.w); }
DI void add_bf8(f32x4& v0, f32x4& v1, const u32x4 g) {
    v0[0] += bf_lo(g.x); v0[1] += bf_hi(g.x); v0[2] += bf_lo(g.y); v0[3] += bf_hi(g.y); v1[0] += bf_lo(g.z); v1[1] += bf_hi(g.z); v1[2] += bf_lo(g.w); v1[3] += bf_hi(g.w); }
DI u32x4 pack_bf8(const f32x4 v0, const f32x4 v1) { u32x4 w; w.x = cvt_pk(v0[0], v0[1]); w.y = cvt_pk(v0[2], v0[3]); w.z = cvt_pk(v1[0], v1[1]); w.w = cvt_pk(v1[2], v1[3]); return w; }
struct EpiMerge {
    bf16_t* MG; const bf16_t* GT;
    DI void operator()(const f32x4 (&acc)[2][2][4][2], const Unit& u, int wr, int wc, int fr, int fq) const {
#pragma unroll
        for (int ai = 0; ai < 2; ++ai)
#pragma unroll
            for (int mh = 0; mh < 2; ++mh) {
                u32x4 gv[2][2], ov[2][2];
#pragma unroll
                for (int mm = 0; mm < 2; ++mm)
#pragma unroll
                    for (int bj = 0; bj < 2; ++bj) {
                        const size_t row = EPI_ROW(ai, 2 * mh + mm); const int col = EPI_COL(bj);
                        gv[mm][bj] = *(const u32x4*)(GT + row * ZC + u.z * DM + col);
                        if (u.z != 0) ov[mm][bj] = *(const u32x4*)(MG + row * DM + col);
                    }
#pragma unroll
                for (int mm = 0; mm < 2; ++mm)
#pragma unroll
                    for (int bj = 0; bj < 2; ++bj) {
                        const size_t row = EPI_ROW(ai, 2 * mh + mm); const int col = EPI_COL(bj);
                        f32x4 v0 = acc[ai][bj][2 * mh + mm][0], v1 = acc[ai][bj][2 * mh + mm][1];
                        mul_bf8(v0, v1, gv[mm][bj]);
                        if (u.z != 0) add_bf8(v0, v1, ov[mm][bj]);
                        *(u32x4*)(MG + row * DM + col) = pack_bf8(v0, v1);
                    }
                asm volatile("" ::: "memory");
            }
    }
};
template <bool EXTRA> struct EpiResid {
    const float* Xin; float* Xout; const bf16_t* E; const float* stats; const float* gam; const float* bet;
    DI void operator()(const f32x4 (&acc)[2][2][4][2], const Unit& u, int wr, int wc, int fr, int fq) const {
        f32x4 g0[2], g1[2], b0[2], b1[2];
#pragma unroll
        for (int bj = 0; bj < 2; ++bj) { const int col = EPI_COL(bj);
            g0[bj] = *(const f32x4*)(gam + col) * ALPHA; g1[bj] = *(const f32x4*)(gam + col + 4) * ALPHA;
            b0[bj] = *(const f32x4*)(bet + col) * ALPHA; b1[bj] = *(const f32x4*)(bet + col + 4) * ALPHA; }
#pragma unroll
        for (int ai = 0; ai < 2; ++ai)
#pragma unroll
            for (int mh = 0; mh < 2; ++mh) {
                f32x4 x0[2][2], x1[2][2]; u32x4 ev[2][2]; f32x2 st[2];
#pragma unroll
                for (int mm = 0; mm < 2; ++mm) {
                    const size_t row = EPI_ROW(ai, 2 * mh + mm);
                    st[mm] = *(const f32x2*)(stats + row * 2);
#pragma unroll
                    for (int bj = 0; bj < 2; ++bj) {
                        const int col = EPI_COL(bj);
                        x0[mm][bj] = *(const f32x4*)(Xin + row * DM + col); x1[mm][bj] = *(const f32x4*)(Xin + row * DM + col + 4);
                        if (EXTRA) ev[mm][bj] = *(const u32x4*)(E + row * DM + col);
                    }
                }
#pragma unroll
                for (int mm = 0; mm < 2; ++mm)
#pragma unroll
                    for (int bj = 0; bj < 2; ++bj) {
                        const size_t row = EPI_ROW(ai, 2 * mh + mm); const int col = EPI_COL(bj);
                        const float mean = st[mm].x, rstd = st[mm].y;
                        f32x4 v0 = acc[ai][bj][2 * mh + mm][0] + ((x0[mm][bj] - mean) * rstd) * g0[bj] + b0[bj];
                        f32x4 v1 = acc[ai][bj][2 * mh + mm][1] + ((x1[mm][bj] - mean) * rstd) * g1[bj] + b1[bj];
                        if (EXTRA) add_bf8(v0, v1, ev[mm][bj]);
                        *(f32x4*)(Xout + row * DM + col) = v0; *(f32x4*)(Xout + row * DM + col + 4) = v1;
                    }
                asm volatile("" ::: "memory");
            }
    }
};
struct EpiMulInto {
    bf16_t* P;
    DI void operator()(const f32x4 (&acc)[2][2][4][2], const Unit& u, int wr, int wc, int fr, int fq) const {
#pragma unroll
        for (int ai = 0; ai < 2; ++ai) {
            u32x4 gv[4][2];
#pragma unroll
            for (int m = 0; m < 4; ++m)
#pragma unroll
                for (int bj = 0; bj < 2; ++bj) gv[m][bj] = *(const u32x4*)(P + (size_t)EPI_ROW(ai, m) * DM + EPI_COL(bj));
#pragma unroll
            for (int m = 0; m < 4; ++m)
#pragma unroll
                for (int bj = 0; bj < 2; ++bj) {
                    f32x4 v0 = acc[ai][bj][m][0], v1 = acc[ai][bj][m][1];
                    mul_bf8(v0, v1, gv[m][bj]);
                    *(u32x4*)(P + (size_t)EPI_ROW(ai, m) * DM + EPI_COL(bj)) = pack_bf8(v0, v1);
                }
            asm volatile("" ::: "memory");
        }
    }
};

template <class Epi, class Sched>
DI void gemm_phase(LAS unsigned char* lds, const Gemm g, const Sched& S_, const Epi& E, const int wave_s) {
    int tid_ = wave_s * 64 + lane_id(); asm volatile("" : "+v"(tid_));
    const int tid = tid_, wid = __builtin_amdgcn_readfirstlane(tid >> 6), lane = tid & 63, wr = wid >> 2, wc = wid & 3, fr = lane & 15, fq = lane >> 4;
    const int K = g.K, nt = K / BK;
    unsigned voffA[2], voffB[2];
#pragma unroll
    for (int i = 0; i < 2; ++i) { int R, C; stage_rc(tid * 16 + i * 8192, R, C); const int Rb = (R & ~31) + perm32(R & 31);
        voffA[i] = (unsigned)(R * g.lda + C) * 2u; voffB[i] = (unsigned)(Rb * K + C) * 2u; }
    const size_t kstep = (size_t)(BK * 2);
    const size_t hstepA = (size_t)HALF * g.lda * 2, hstepB = (size_t)HALF * K * 2;
    const unsigned ldsw = (unsigned)wid * 1024u;
    const int aoff = lds_byte(wr * 64 + fr, fq * 8), boff = lds_byte(wc * 32 + fr, fq * 8);
#define PG8_SA(b, h) (((b) * 2 + (h)) * HTB)
#define PG8_SB(b, h) ((4 + (b) * 2 + (h)) * HTB)
#define PG8_STAGE(bufoff, gbase, voff) do { _Pragma("unroll") for (int _i = 0; _i < 2; ++_i) \
        __builtin_amdgcn_global_load_lds((const unsigned*)((const char*)(gbase) + (voff)[_i]), (LAS unsigned*)(lds + (bufoff) + ldsw + _i * 8192), 16, 0, 0); } while (0)
#define PG8_LDA(dst, b, h) do { _Pragma("unroll") for (int m = 0; m < 4; ++m) _Pragma("unroll") for (int k = 0; k < 2; ++k) dst[m][k] = *(const LAS bf16x8*)(lds + PG8_SA(b, h) + aoff + m * 2048 + k * 1024); } while (0)
#define PG8_LDB(dst, b, h) do { _Pragma("unroll") for (int n = 0; n < 2; ++n) _Pragma("unroll") for (int k = 0; k < 2; ++k) dst[n][k] = *(const LAS bf16x8*)(lds + PG8_SB(b, h) + boff + n * 2048 + k * 1024); } while (0)
#define PG8_MMA(ai, bj, At, Bt) do { __builtin_amdgcn_s_setprio(1); _Pragma("unroll") for (int m = 0; m < 4; ++m) _Pragma("unroll") for (int n = 0; n < 2; ++n) _Pragma("unroll") for (int k = 0; k < 2; ++k) \
        acc[ai][bj][m][n] = __builtin_amdgcn_mfma_f32_16x16x32_bf16(Bt[n][k], At[m][k], acc[ai][bj][m][n], 0, 0, 0); __builtin_amdgcn_s_setprio(0); } while (0)
#define PG8_WAIT_V(n) asm volatile("s_waitcnt vmcnt(" #n ")" ::: "memory")
#define PG8_WAIT_L(n) asm volatile("s_waitcnt lgkmcnt(" #n ")" ::: "memory")
#define PG8_BAR __builtin_amdgcn_s_barrier()
#define PG8_SCHED __builtin_amdgcn_sched_barrier(0)
    Unit cur, nxt; int ui = 0;
    if (!S_.next(0, cur)) return;
    f32x4 acc[2][2][4][2];
#pragma unroll
    for (int a = 0; a < 2; ++a)
#pragma unroll
        for (int b = 0; b < 2; ++b)
#pragma unroll
            for (int m = 0; m < 4; ++m)
#pragma unroll
                for (int n = 0; n < 2; ++n) acc[a][b][m][n] = (f32x4){0.f, 0.f, 0.f, 0.f};
    bf16x8 At[4][2], B0[2][2], B1[2][2];
    const char* cA = (const char*)g.A + S_.aoff(cur, g); const char* cB = (const char*)g.Bt + S_.boff(cur, g);
    PG8_STAGE(PG8_SB(0, 0), cB, voffB); PG8_STAGE(PG8_SB(0, 1), cB + hstepB, voffB); PG8_STAGE(PG8_SA(0, 0), cA, voffA); PG8_STAGE(PG8_SA(0, 1), cA + hstepA, voffA);
    if (wr == 1) PG8_BAR;
    PG8_WAIT_V(2); PG8_BAR;
    PG8_STAGE(PG8_SB(1, 0), cB + kstep, voffB); PG8_STAGE(PG8_SA(1, 0), cA + kstep, voffA); PG8_STAGE(PG8_SB(1, 1), cB + hstepB + kstep, voffB);
    PG8_WAIT_V(6); PG8_BAR;
    for (;;) {
        const bool has_next = S_.next(ui + 1, nxt);
        const char* nA = has_next ? (const char*)g.A + S_.aoff(nxt, g) : cA; const char* nB = has_next ? (const char*)g.Bt + S_.boff(nxt, g) : cB;
        for (int t = 0; t < nt; t += 2) {
            const bool last = (t == nt - 2);
            const char* a1 = cA + (size_t)(t + 1) * kstep;
            const char* a2 = last ? nA : cA + (size_t)(t + 2) * kstep; const char* b2 = last ? nB : cB + (size_t)(t + 2) * kstep;
            const char* a3 = a2 + kstep; const char* b3 = b2 + kstep;
            PG8_LDB(B0, 0, 0); PG8_LDB(B1, 0, 1); PG8_SCHED; PG8_LDA(At, 0, 0); PG8_STAGE(PG8_SA(1, 1), a1 + hstepA, voffA);
            PG8_WAIT_V(8); PG8_WAIT_L(0); PG8_BAR; PG8_MMA(0, 0, At, B0); PG8_MMA(0, 1, At, B1); PG8_BAR; PG8_SCHED;
            PG8_LDA(At, 0, 1); PG8_STAGE(PG8_SB(0, 0), b2, voffB); PG8_STAGE(PG8_SB(0, 1), b2 + hstepB, voffB); PG8_STAGE(PG8_SA(0, 0), a2, voffA);
            PG8_WAIT_V(8); PG8_WAIT_L(0); PG8_BAR; PG8_MMA(1, 0, At, B0); PG8_MMA(1, 1, At, B1); PG8_BAR; PG8_SCHED;
            PG8_LDB(B0, 1, 0); PG8_LDB(B1, 1, 1); PG8_SCHED; PG8_LDA(At, 1, 0); PG8_STAGE(PG8_SA(0, 1), a2 + hstepA, voffA);
            PG8_WAIT_V(8); PG8_WAIT_L(0); PG8_BAR; PG8_MMA(0, 0, At, B0); PG8_MMA(0, 1, At, B1); PG8_BAR; PG8_SCHED;
            PG8_LDA(At, 1, 1); PG8_STAGE(PG8_SB(1, 0), b3, voffB); PG8_STAGE(PG8_SB(1, 1), b3 + hstepB, voffB); PG8_STAGE(PG8_SA(1, 0), a3, voffA);
            PG8_WAIT_V(8); PG8_WAIT_L(0); PG8_BAR; PG8_MMA(1, 0, At, B0); PG8_MMA(1, 1, At, B1); PG8_BAR; PG8_SCHED;
        }
        if (wr == 0) PG8_BAR;
        { const int l2 = lane_id(); E(acc, cur, wr, wc, l2 & 15, l2 >> 4); }
        if (!has_next) break;
#pragma unroll
        for (int a = 0; a < 2; ++a)
#pragma unroll
            for (int b = 0; b < 2; ++b)
#pragma unroll
                for (int m = 0; m < 4; ++m)
#pragma unroll
                    for (int n = 0; n < 2; ++n) acc[a][b][m][n] = (f32x4){0.f, 0.f, 0.f, 0.f};
        cur = nxt; cA = nA; cB = nB; ++ui;
        if (wr == 1) PG8_BAR;
    }
    PG8_WAIT_V(0);
    PG8_BAR;
#undef PG8_SA
#undef PG8_SB
#undef PG8_STAGE
#undef PG8_LDA
#undef PG8_LDB
#undef PG8_MMA
#undef PG8_WAIT_V
#undef PG8_WAIT_L
#undef PG8_BAR
#undef PG8_SCHED
}
}

struct AttnP {
    const bf16_t* ZQ; const bf16_t* QM; const bf16_t* KVM; const bf16_t* KR; bf16_t* Y; bf16_t* ZQw; float* LSE;
    const float* LUTS; const float* LUTD; const float* rpb; const float* sink; const float* COS;
};
constexpr int A_VP = 144, A_LUT = 114688, A_WSF = A_LUT + 2048, A_END = A_WSF + 2048;

DI void glds16(const void* gsrc, unsigned lds_dst) { unsigned keep;
    asm volatile("s_mov_b32 %0, m0\n\ts_mov_b32 m0, %2\n\ts_nop 0\n\tglobal_load_lds_dwordx4 %1, off\n\ts_mov_b32 m0, %0" : "=&s"(keep) : "v"(gsrc), "s"(lds_dst) : "memory"); }
DI void glds16s(unsigned voff, const void* sbase, unsigned lds_dst) { unsigned keep;
    const unsigned long long sb = (unsigned long long)sbase;
    const unsigned blo = __builtin_amdgcn_readfirstlane((unsigned)sb), bhi = __builtin_amdgcn_readfirstlane((unsigned)(sb >> 32));
    const unsigned long long sbu = ((unsigned long long)bhi << 32) | blo;
    asm volatile("s_mov_b32 %0, m0\n\ts_mov_b32 m0, %3\n\ts_nop 0\n\tglobal_load_lds_dwordx4 %1, %2\n\ts_mov_b32 m0, %0" : "=&s"(keep) : "v"(voff), "s"(sbu), "s"(lds_dst) : "memory"); }
template <int VAR> DI void attn_unit(LAS unsigned char* lds, const AttnP& P, const int u, const int wave_s) {
    constexpr int NKS = (VAR == 0) ? 6 : 4, QB = (VAR == 0) ? 2 : 1, QPW = 32 * QB;
    constexpr int A_TK = (VAR == 0) ? 128 : (VAR == 1 ? 256 : 384), NBUF = (VAR == 0) ? 2 : 1, A_KP = (VAR == 0) ? 208 : 144, NLD = A_TK / 64;
    constexpr int A_KB = 0, A_VB = (VAR == 0) ? 2 * 24576 : NBUF * A_TK * A_KP;
    static_assert(A_VB + ((VAR == 0) ? 2 * 16384 : NBUF * A_TK * A_VP) <= A_LUT, "attention tiles vs LDS map");
    int tid_ = wave_s * 64 + lane_id(); asm volatile("" : "+v"(tid_));
    const int tid = tid_, lane = tid & 63, r32 = lane & 31, hi = lane >> 5, w = __builtin_amdgcn_readfirstlane(tid >> 6);
    LAS float* LUT = (LAS float*)(lds + A_LUT);
    LAS float* WSF = (LAS float*)(lds + A_WSF) + w * 64;
    int b, h, qt, g = 0, r = 1, res = 0, L = S, j0 = 0;
    if (VAR == 0) { qt = u & 15; h = (u >> 4) & 3; b = u >> 6; j0 = 512 * qt; }
    else if (VAR == 3) { qt = u & 31; h = (u >> 5) & 3; b = u / 384; g = (u >> 7) % 3; r = (g == 0) ? 1 : (g == 1 ? 4 : 16); L = S / r; const int tpr = 32 / r; res = qt / tpr; j0 = 256 * (qt % tpr); }
    else { qt = u & 31; h = (u >> 5) & 3; b = u >> 7; j0 = 256 * qt; }
    const size_t tb = (size_t)b * S;
    const int qw = j0 + QPW * w;
    const int na_row0 = 4 * qt + 2 * (w >> 2), na_col0 = 16 * (w & 3), na_cb = min(max(na_col0 - 8, 0), 32);
#define NA_TOK(qidx) ((na_row0 + ((qidx) >> 4)) * 64 + na_col0 + ((qidx) & 15))
    if (VAR == 1) { for (int i = tid; i < 257; i += 512) LUT[i] = P.LUTS[h * 260 + i]; }
    if (VAR == 2) { for (int i = tid; i < 465; i += 512) LUT[i] = P.rpb[h * 465 + i] * LOG2E; }
    if (VAR == 3) { for (int i = tid; i < 129; i += 512) LUT[i] = P.LUTD[(g * 4 + h) * 132 + i]; }
    bf16x8 qf[QB][NKS];
#pragma unroll
    for (int qb = 0; qb < QB; ++qb) {
        const int qi = (VAR == 2) ? NA_TOK(r32) : qw + 32 * qb + r32;
        const bf16_t* qp;
        if (VAR == 0) qp = P.QM + (tb + qi) * 384 + h * 96;
        else if (VAR == 1) qp = P.ZQ + (tb + qi) * ZC + C_BQ + h * 64;
        else if (VAR == 2) qp = P.ZQ + (tb + qi) * ZC + C_CQ + h * 64;
        else qp = P.ZQ + (tb + res + (size_t)r * qi) * ZC + C_DQ + g * 256 + h * 64;
#pragma unroll
        for (int ks = 0; ks < NKS; ++ks) qf[qb][ks] = *(const bf16x8*)(qp + 16 * ks + 8 * hi);
        if (VAR == 0) {
            const float* cp = P.COS + qi * 16 + 8 * hi; const float* sp = cp + S * 16;
            const f32x4 c0 = *(const f32x4*)cp, c1 = *(const f32x4*)(cp + 4), s0 = *(const f32x4*)sp, s1 = *(const f32x4*)(sp + 4);
            const u32x4 a4 = __builtin_bit_cast(u32x4, qf[qb][4]), a5 = __builtin_bit_cast(u32x4, qf[qb][5]);
            u32x4 o4, o5;
#define ROPE2(k, ca, cb, sa, sb) { const float x1l = bf_lo(a4[k]), x1h = bf_hi(a4[k]), x2l = bf_lo(a5[k]), x2h = bf_hi(a5[k]); \
                o4[k] = cvt_pk(x1l * ca - x2l * sa, x1h * cb - x2h * sb); o5[k] = cvt_pk(x1l * sa + x2l * ca, x1h * sb + x2h * cb); }
            ROPE2(0, c0[0], c0[1], s0[0], s0[1]) ROPE2(1, c0[2], c0[3], s0[2], s0[3]) ROPE2(2, c1[0], c1[1], s1[0], s1[1]) ROPE2(3, c1[2], c1[3], s1[2], s1[3])
#undef ROPE2
            qf[qb][4] = __builtin_bit_cast(bf16x8, o4); qf[qb][5] = __builtin_bit_cast(bf16x8, o5);
        }
    }
    int NT, kfirst;
    if (VAR == 0) { NT = S / A_TK; kfirst = 0; }
    else if (VAR == 1) { NT = 2; kfirst = j0 - 128; }
    else if (VAR == 2) { const int f = min(max(4 * qt - 4, 0), 120); NT = 2; kfirst = 64 * f; }
    else { NT = 1; kfirst = j0 - 64; }
    float m_run[QB], l_run[QB];
    f32x16 o[QB][2];
#pragma unroll
    for (int qb = 0; qb < QB; ++qb) {
        m_run[qb] = (VAR == 0) ? 0.f : -1e30f; l_run[qb] = 0.f;
        if (VAR == 1) { m_run[qb] = P.sink[h] * LOG2E; l_run[qb] = (hi == 0) ? 1.0f : 0.0f; }
#pragma unroll
        for (int i = 0; i < 16; ++i) { o[qb][0][i] = 0.f; o[qb][1][i] = 0.f; }
    }
    const float c2 = 0.125f * LOG2E;
    const int qrow = na_row0 + (r32 >> 4), qc = na_col0 + (r32 & 15);
    const int r0 = min(max(qrow - 4, 0), 120), cs = min(max(qc - 8, 0), 48);
    const int srow = tid >> 3, sch = tid & 7, srow2 = tid >> 2, sch2 = tid & 3;
    u32x4 kreg[NLD], vreg[NLD], rreg;
    auto load_tile = [&](int t) {
#pragma unroll
        for (int i = 0; i < NLD; ++i) {
            const int kidx = kfirst + A_TK * t + srow + 64 * i;
            if (VAR == 0) {
                const bf16_t* kp = P.KVM + (tb + kidx) * 512 + h * 128 + sch * 8;
                kreg[i] = *(const u32x4*)kp; vreg[i] = *(const u32x4*)(kp + 64);
            } else if (VAR == 1) {
                const int kc = min(max(kidx, 0), S - 1); const bf16_t* base = P.ZQ + (tb + kc) * ZC + (h >> 1) * 64 + sch * 8;
                kreg[i] = *(const u32x4*)(base + C_BK); vreg[i] = *(const u32x4*)(base + C_BV);
            } else if (VAR == 2) {
                const int kc = min(kidx, S - 1); const bf16_t* base = P.ZQ + (tb + kc) * ZC + h * 64 + sch * 8;
                kreg[i] = *(const u32x4*)(base + C_CK); vreg[i] = *(const u32x4*)(base + C_CV);
            } else {
                const int kc = min(max(kidx, 0), L - 1); const bf16_t* base = P.ZQ + (tb + res + (size_t)r * kc) * ZC + g * 256 + h * 64 + sch * 8;
                kreg[i] = *(const u32x4*)(base + C_DK); vreg[i] = *(const u32x4*)(base + C_DV);
            }
        }
        if (VAR == 0) rreg = *(const u32x4*)(P.KR + (tb + kfirst + A_TK * t + srow2) * 32 + sch2 * 8);
    };
    auto store_tile = [&](int buf) {
#pragma unroll
        for (int i = 0; i < NLD; ++i) {
            *(LAS u32x4*)(lds + A_KB + buf * A_TK * A_KP + (srow + 64 * i) * A_KP + sch * 16) = kreg[i];
            *(LAS u32x4*)(lds + A_VB + buf * A_TK * A_VP + (srow + 64 * i) * A_VP + sch * 16) = vreg[i];
        }
        if (VAR == 0) *(LAS u32x4*)(lds + A_KB + buf * A_TK * A_KP + srow2 * A_KP + 128 + sch2 * 16) = rreg;
    };
    const unsigned lds_base = (unsigned)(size_t)lds;
    const unsigned dl_k = (unsigned)((lane & 31) * 1024 + (lane >> 5) * 16), dl_r = (unsigned)((lane & 31) * 64 + (lane >> 5) * 16),
                   dl_v = (unsigned)((lane >> 3) * 1024 + (((lane & 7) ^ ((lane >> 3) & 7)) << 4));
    auto dma_tile = [&](int t, int buf) {
        const size_t krow0 = tb + kfirst + A_TK * t;
#pragma unroll
        for (int q = 0; q < 3; ++q) {
            const int i = w + 8 * q, sbk = i / 6, cp = i % 6;
            const unsigned dst = (unsigned)__builtin_amdgcn_readfirstlane((int)(lds_base + A_KB + buf * 24576 + (sbk * 12 + 2 * cp) * 512));
            if (cp < 4) glds16s(dl_k, P.KVM + (krow0 + 32 * sbk) * 512 + h * 128 + 16 * cp, dst);
            else        glds16s(dl_r, P.KR + (krow0 + 32 * sbk) * 32 + 16 * (cp - 4), dst);
        }
#pragma unroll
        for (int q = 0; q < 2; ++q) {
            const int j = w + 8 * q;
            glds16s(dl_v, P.KVM + (krow0 + 8 * j) * 512 + h * 128 + 64, (unsigned)__builtin_amdgcn_readfirstlane((int)(lds_base + A_VB + buf * 16384 + j * 1024)));
        }
    };
    if constexpr (VAR == 0) { dma_tile(0, 0); asm volatile("s_waitcnt vmcnt(0)" ::: "memory"); } else { load_tile(0); store_tile(0); }
    __syncthreads();
    const int tq = lane & 15, tq_q = tq >> 2, tq_p = tq & 3, blk = (lane >> 4) & 1;
    float mxt[QB];
    if (VAR == 0) {
#pragma unroll
        for (int qb = 0; qb < QB; ++qb) {
            f32x16 s0;
#pragma unroll
            for (int i = 0; i < 16; ++i) s0[i] = 0.f;
#pragma unroll
            for (int ks = 0; ks < NKS; ++ks) {
                const bf16x8 kf = *(LAS const bf16x8*)(lds + A_KB + ((2 * ks + hi) * 32 + r32) * 16);
                s0 = __builtin_amdgcn_mfma_f32_32x32x16_bf16(kf, qf[qb][ks], s0, 0, 0, 0);
            }
            float mx = s0[0];
#pragma unroll
            for (int i = 1; i < 16; ++i) mx = fmaxf(mx, s0[i]);
            m_run[qb] = xhalf_max(mx); mxt[qb] = -INFINITY;
        }
    }
    f32x16 negm;
#pragma unroll
    for (int i = 0; i < 16; ++i) negm[i] = -fmaxf(m_run[0], m_run[QB - 1]);
    auto mla_tile = [&](const int buf) {
#define SBAR0() __builtin_amdgcn_sched_barrier(0)
#define PINV(x) asm volatile("" : "+v"(x))
#define EX(v, i) v[i] = __builtin_amdgcn_exp2f(v[i])
            LAS const unsigned char* Kt = lds + A_KB + buf * 24576 + (hi * 32 + r32) * 16;
            LAS const unsigned char* Vt = lds + A_VB + buf * 16384 + (4 * hi + tq_q) * 128 + 8 * (tq_p & 1);
            const int vsw = (4 * hi + tq_q) & 7, vch = 2 * blk + (tq_p >> 1);
            f32x16 sc0 = negm, sc1 = negm, sn0, sn1;
#pragma unroll
            for (int ks = 0; ks < NKS; ++ks) {
                const bf16x8 kfx = *(LAS const bf16x8*)(Kt + 1024 * ks);
                sc0 = __builtin_amdgcn_mfma_f32_32x32x16_bf16(kfx, qf[0][ks], sc0, 0, 0, 0);
                sc1 = __builtin_amdgcn_mfma_f32_32x32x16_bf16(kfx, qf[1][ks], sc1, 0, 0, 0);
            }
            SBAR0();
#pragma unroll
            for (int sb = 0; sb < A_TK / 32; ++sb) {
                bf16x8 vf[2][2];
#pragma unroll
                for (int d0 = 0; d0 < 1; ++d0)
#pragma unroll
                    for (int ss = 0; ss < 2; ++ss) {
                        LAS const unsigned char* vp = Vt + (32 * sb + 16 * ss) * 128 + (((4 * d0 + vch) ^ vsw) << 4);
                        const s16x4 lo = __builtin_amdgcn_ds_read_tr16_b64_v4i16((LAS s16x4*)vp);
                        const s16x4 hh = __builtin_amdgcn_ds_read_tr16_b64_v4i16((LAS s16x4*)(vp + 8 * 128));
                        vf[d0][ss] = (bf16x8){lo[0], lo[1], lo[2], lo[3], hh[0], hh[1], hh[2], hh[3]};
                    }
                if (sb + 1 < A_TK / 32) {
                    LAS const unsigned char* Kn = Kt + (sb + 1) * 6144;
                    bf16x8 k0 = *(LAS const bf16x8*)(Kn), k1 = *(LAS const bf16x8*)(Kn + 1024), k2 = *(LAS const bf16x8*)(Kn + 2048);
                    SBAR0();
                    sn0 = __builtin_amdgcn_mfma_f32_32x32x16_bf16(k0, qf[0][0], negm, 0, 0, 0); EX(sc0, 0); EX(sc0, 1); EX(sc0, 2); PINV(sc0); SBAR0();
                    sn1 = __builtin_amdgcn_mfma_f32_32x32x16_bf16(k0, qf[1][0], negm, 0, 0, 0); EX(sc1, 0); EX(sc1, 1); EX(sc1, 2); PINV(sc1); SBAR0();
                    k0 = *(LAS const bf16x8*)(Kn + 3072);
                    sn0 = __builtin_amdgcn_mfma_f32_32x32x16_bf16(k1, qf[0][1], sn0, 0, 0, 0);  EX(sc0, 3); EX(sc0, 4); EX(sc0, 5); PINV(sc0); SBAR0();
                    sn1 = __builtin_amdgcn_mfma_f32_32x32x16_bf16(k1, qf[1][1], sn1, 0, 0, 0);  EX(sc1, 3); EX(sc1, 4); EX(sc1, 5); PINV(sc1); SBAR0();
                    k1 = *(LAS const bf16x8*)(Kn + 4096);
                    sn0 = __builtin_amdgcn_mfma_f32_32x32x16_bf16(k2, qf[0][2], sn0, 0, 0, 0);  EX(sc0, 6); EX(sc0, 7); EX(sc0, 8); PINV(sc0); SBAR0();
                    sn1 = __builtin_amdgcn_mfma_f32_32x32x16_bf16(k2, qf[1][2], sn1, 0, 0, 0);  EX(sc1, 6); EX(sc1, 7); EX(sc1, 8); PINV(sc1); SBAR0();
                    k2 = *(LAS const bf16x8*)(Kn + 5120);
                    sn0 = __builtin_amdgcn_mfma_f32_32x32x16_bf16(k0, qf[0][3], sn0, 0, 0, 0);  EX(sc0, 9); EX(sc0, 10); EX(sc0, 11); PINV(sc0); SBAR0();
                    sn1 = __builtin_amdgcn_mfma_f32_32x32x16_bf16(k0, qf[1][3], sn1, 0, 0, 0);  EX(sc1, 9); EX(sc1, 10); EX(sc1, 11); PINV(sc1); SBAR0();
                    sn0 = __builtin_amdgcn_mfma_f32_32x32x16_bf16(k1, qf[0][4], sn0, 0, 0, 0);  EX(sc0, 12); EX(sc0, 13); PINV(sc0); SBAR0();
                    sn1 = __builtin_amdgcn_mfma_f32_32x32x16_bf16(k1, qf[1][4], sn1, 0, 0, 0);  EX(sc1, 12); EX(sc1, 13); PINV(sc1); SBAR0();
                    sn0 = __builtin_amdgcn_mfma_f32_32x32x16_bf16(k2, qf[0][5], sn0, 0, 0, 0);  EX(sc0, 14); EX(sc0, 15); PINV(sc0); SBAR0();
                    sn1 = __builtin_amdgcn_mfma_f32_32x32x16_bf16(k2, qf[1][5], sn1, 0, 0, 0);  EX(sc1, 14); EX(sc1, 15); PINV(sc1); SBAR0();
                } else {
#pragma unroll
                    for (int i = 0; i < 16; ++i) { EX(sc0, i); EX(sc1, i); }
                    SBAR0();
                }
                u32x4 pa0, pa1, pb0, pb1;
                pa0.x = cvt_pk(sc0[0], sc0[1]); pa0.y = cvt_pk(sc0[2], sc0[3]); pa0.z = cvt_pk(sc0[4], sc0[5]); pa0.w = cvt_pk(sc0[6], sc0[7]);
                pa1.x = cvt_pk(sc0[8], sc0[9]); pa1.y = cvt_pk(sc0[10], sc0[11]); pa1.z = cvt_pk(sc0[12], sc0[13]); pa1.w = cvt_pk(sc0[14], sc0[15]);
                pb0.x = cvt_pk(sc1[0], sc1[1]); pb0.y = cvt_pk(sc1[2], sc1[3]); pb0.z = cvt_pk(sc1[4], sc1[5]); pb0.w = cvt_pk(sc1[6], sc1[7]);
                pb1.x = cvt_pk(sc1[8], sc1[9]); pb1.y = cvt_pk(sc1[10], sc1[11]); pb1.z = cvt_pk(sc1[12], sc1[13]); pb1.w = cvt_pk(sc1[14], sc1[15]);
                const bf16x8 pf00 = __builtin_bit_cast(bf16x8, pa0), pf01 = __builtin_bit_cast(bf16x8, pa1), pf10 = __builtin_bit_cast(bf16x8, pb0), pf11 = __builtin_bit_cast(bf16x8, pb1);
                float ps0 = l_run[0], ps1 = l_run[1];
#pragma unroll
                for (int d0 = 0; d0 < 2; ++d0)
#pragma unroll
                    for (int ss = 0; ss < 2; ++ss) {
                        bf16x8 vfx;
                        if (d0 == 0) vfx = vf[0][ss];
                        else { LAS const unsigned char* vp = Vt + (32 * sb + 16 * ss) * 128 + (((4 + vch) ^ vsw) << 4);
                               const s16x4 lo = __builtin_amdgcn_ds_read_tr16_b64_v4i16((LAS s16x4*)vp);
                               const s16x4 hh = __builtin_amdgcn_ds_read_tr16_b64_v4i16((LAS s16x4*)(vp + 8 * 128));
                               vfx = (bf16x8){lo[0], lo[1], lo[2], lo[3], hh[0], hh[1], hh[2], hh[3]}; }
                        o[0][d0] = __builtin_amdgcn_mfma_f32_32x32x16_bf16(ss == 0 ? pf00 : pf01, vfx, o[0][d0], 0, 0, 0);
                        o[1][d0] = __builtin_amdgcn_mfma_f32_32x32x16_bf16(ss == 0 ? pf10 : pf11, vfx, o[1][d0], 0, 0, 0);
                        const int q4 = 4 * (2 * d0 + ss);
                        ps0 += sc0[q4]; ps0 += sc0[q4 + 1]; ps0 += sc0[q4 + 2]; ps0 += sc0[q4 + 3];
                        ps1 += sc1[q4]; ps1 += sc1[q4 + 1]; ps1 += sc1[q4 + 2]; ps1 += sc1[q4 + 3];
                    }
                l_run[0] = ps0; l_run[1] = ps1;
                if (sb + 1 < A_TK / 32) { sc0 = sn0; sc1 = sn1; }
                SBAR0();
            }
#undef SBAR0
#undef PINV
#undef EX
            if (__any(fmaxf(l_run[0], l_run[1]) > 1.8446744e19f)) {
                const float dn = 5.421010862427522e-20f;
                l_run[0] *= dn; l_run[1] *= dn;
#pragma unroll
                for (int i = 0; i < 16; ++i) { o[0][0][i] *= dn; o[0][1][i] *= dn; o[1][0][i] *= dn; o[1][1][i] *= dn; negm[i] -= 64.0f; }
            }
    };
#define LDS_BAR() asm volatile("s_waitcnt lgkmcnt(0)\n\ts_barrier" ::: "memory")
    if constexpr (VAR == 0) {
        for (int t = 0; t < NT; ++t) {
            if (t + 1 < NT) dma_tile(t + 1, (t + 1) & 1);
            mla_tile(t & 1);
            asm volatile("s_waitcnt vmcnt(0)" ::: "memory");
            LDS_BAR();
        }
    } else
    for (int t = 0; t < NT; ++t) {
        if (t + 1 < NT) load_tile(t + 1);
        const int buf = (NBUF == 2) ? (t & 1) : 0;
        if constexpr (VAR == 0) { mla_tile(buf); } else
#pragma unroll 2
        for (int sb = 0; sb < ((VAR == 2) ? A_TK / 64 : A_TK / 32); ++sb) {
            const int sub_off = (VAR == 2) ? 64 * sb + na_cb : 32 * sb;
            const int kb = kfirst + A_TK * t + sub_off;
            bool act = true;
            if (VAR == 1) act = (kb + 31 >= max(qw - 128, 0)) && (kb <= min(qw + 159, S - 1));
            if (VAR == 2) { const int kr = kb >> 6; act = (kr >= min(max(na_row0 - 4, 0), 120)) && (kr < min(max(na_row0 - 3, 0), 120) + 8); }
            if (VAR == 3) act = (kb + 31 >= max(qw - 64, 0)) && (kb <= min(qw + 95, L - 1));
            if (!act) continue;
            LAS const unsigned char* Kb = lds + A_KB + buf * A_TK * A_KP + sub_off * A_KP;
            LAS const unsigned char* Vb = lds + A_VB + buf * A_TK * A_VP + sub_off * A_VP;
            f32x16 s[QB];
#pragma unroll
            for (int qb = 0; qb < QB; ++qb)
#pragma unroll
                for (int i = 0; i < 16; ++i) s[qb][i] = (VAR == 0) ? -m_run[qb] : 0.f;
#pragma unroll
            for (int ks = 0; ks < NKS; ++ks) {
                const bf16x8 kf = *(LAS const bf16x8*)(Kb + r32 * A_KP + (16 * ks + 8 * hi) * 2);
#pragma unroll
                for (int qb = 0; qb < QB; ++qb) s[qb] = __builtin_amdgcn_mfma_f32_32x32x16_bf16(kf, qf[qb][ks], s[qb], 0, 0, 0);
            }
            bf16x8 pf[QB][2];
#pragma unroll
            for (int qb = 0; qb < QB; ++qb) {
                if (VAR == 1 || VAR == 3) {
                    const int HALFW = (VAR == 1) ? 128 : 64, LL = (VAR == 1) ? S : L;
                    const int qpos = qw + r32;
#pragma unroll
                    for (int i = 0; i < 16; ++i) {
                        const int kp = kb + crow(i, hi), rel = kp - qpos;
                        const bool ok = (rel >= -HALFW) && (rel <= HALFW) && (kp >= 0) && (kp < LL);
                        const int idx = min(max(rel + HALFW, 0), 2 * HALFW);
                        s[qb][i] = ok ? (s[qb][i] * c2 + LUT[idx]) : -INFINITY;
                    }
                }
                if (VAR == 2) {
                    const int kr_ = kb >> 6; const bool rowok = (kr_ >= r0) && (kr_ < r0 + 8); const int dr = min(max(kr_ - qrow + 7, 0), 14);
#pragma unroll
                    for (int i = 0; i < 16; ++i) {
                        const int ck = (kb & 63) + crow(i, hi), d = ck - qc;
                        const bool ok = rowok && (ck >= cs) && (ck < cs + 16);
                        const int idx = dr * 31 + min(max(d + 15, 0), 30);
                        s[qb][i] = ok ? (s[qb][i] * c2 + LUT[idx]) : -INFINITY;
                    }
                }
                float mx = s[qb][0];
#pragma unroll
                for (int i = 1; i < 16; ++i) mx = fmaxf(mx, s[qb][i]);
                if (VAR == 0) mxt[qb] = fmaxf(mxt[qb], mx);
                else {
                mx = xhalf_max(mx);
                const float mnew = fmaxf(m_run[qb], mx);
                if (__any(mnew != m_run[qb])) {
                    const float al = __builtin_amdgcn_exp2f(m_run[qb] - mnew);
                    l_run[qb] *= al; m_run[qb] = mnew;
                    if (hi == 0) WSF[32 * qb + r32] = al;
                    __builtin_amdgcn_fence(__ATOMIC_RELEASE, "wavefront"); __builtin_amdgcn_wave_barrier(); __builtin_amdgcn_fence(__ATOMIC_ACQUIRE, "wavefront");
#pragma unroll
                    for (int i = 0; i < 16; ++i) { const float al2 = WSF[32 * qb + crow(i, hi)]; o[qb][0][i] *= al2; o[qb][1][i] *= al2; }
                    __builtin_amdgcn_fence(__ATOMIC_RELEASE, "wavefront"); __builtin_amdgcn_wave_barrier(); __builtin_amdgcn_fence(__ATOMIC_ACQUIRE, "wavefront");
                }
                }
                float ps = 0.f;
#pragma unroll
                for (int i = 0; i < 16; ++i) { s[qb][i] = __builtin_amdgcn_exp2f((VAR == 0) ? s[qb][i] : s[qb][i] - m_run[qb]); ps += s[qb][i]; }
                l_run[qb] += ps;
                u32x4 pw0, pw1;
                pw0.x = cvt_pk(s[qb][0], s[qb][1]); pw0.y = cvt_pk(s[qb][2], s[qb][3]); pw0.z = cvt_pk(s[qb][4], s[qb][5]); pw0.w = cvt_pk(s[qb][6], s[qb][7]);
                pw1.x = cvt_pk(s[qb][8], s[qb][9]); pw1.y = cvt_pk(s[qb][10], s[qb][11]); pw1.z = cvt_pk(s[qb][12], s[qb][13]); pw1.w = cvt_pk(s[qb][14], s[qb][15]);
                pf[qb][0] = __builtin_bit_cast(bf16x8, pw0); pf[qb][1] = __builtin_bit_cast(bf16x8, pw1);
            }
#pragma unroll
            for (int d0 = 0; d0 < 2; ++d0) {
#pragma unroll
                for (int ss = 0; ss < 2; ++ss) {
                    LAS const unsigned char* vp = Vb + (16 * ss + 4 * hi + tq_q) * A_VP + (32 * d0 + 16 * blk + 4 * tq_p) * 2;
                    const s16x4 lo = __builtin_amdgcn_ds_read_tr16_b64_v4i16((LAS s16x4*)vp);
                    const s16x4 hh = __builtin_amdgcn_ds_read_tr16_b64_v4i16((LAS s16x4*)(vp + 8 * A_VP));
                    const bf16x8 vf = (bf16x8){lo[0], lo[1], lo[2], lo[3], hh[0], hh[1], hh[2], hh[3]};
#pragma unroll
                    for (int qb = 0; qb < QB; ++qb) o[qb][d0] = __builtin_amdgcn_mfma_f32_32x32x16_bf16(pf[qb][ss], vf, o[qb][d0], 0, 0, 0);
                }
            }
        }
        if (VAR == 0) {
#pragma unroll
            for (int qb = 0; qb < QB; ++qb) {
                if (__any(mxt[qb] > 64.0f)) {
                    const float dl = fmaxf(xhalf_max(mxt[qb]), 0.f), al = __builtin_amdgcn_exp2f(-dl);
                    l_run[qb] *= al; m_run[qb] += dl;
                    if (hi == 0) WSF[32 * qb + r32] = al;
                    __builtin_amdgcn_fence(__ATOMIC_RELEASE, "wavefront"); __builtin_amdgcn_wave_barrier(); __builtin_amdgcn_fence(__ATOMIC_ACQUIRE, "wavefront");
#pragma unroll
                    for (int i = 0; i < 16; ++i) { const float al2 = WSF[32 * qb + crow(i, hi)]; o[qb][0][i] *= al2; o[qb][1][i] *= al2; }
                    __builtin_amdgcn_fence(__ATOMIC_RELEASE, "wavefront"); __builtin_amdgcn_wave_barrier(); __builtin_amdgcn_fence(__ATOMIC_ACQUIRE, "wavefront");
                }
                mxt[qb] = -INFINITY;
            }
        }
        if (NBUF == 2) { if (t + 1 < NT) store_tile((t + 1) & 1); }
        else if (t + 1 < NT) { __syncthreads(); store_tile(0); }
        __syncthreads();
    }
#pragma unroll
    for (int qb = 0; qb < QB; ++qb) {
        const float lt = xhalf_sum(l_run[qb]);
        if (hi == 0) WSF[32 * qb + r32] = 1.0f / lt;
        if (VAR == 3) { if (hi == 0) P.LSE[(tb + res + (size_t)r * (qw + r32)) * 12 + g * 4 + h] = m_run[qb] + __builtin_amdgcn_logf(lt); }
    }
    __builtin_amdgcn_fence(__ATOMIC_RELEASE, "wavefront"); __builtin_amdgcn_wave_barrier(); __builtin_amdgcn_fence(__ATOMIC_ACQUIRE, "wavefront");
#pragma unroll
    for (int qb = 0; qb < QB; ++qb) {
#pragma unroll
        for (int i = 0; i < 16; ++i) {
            const int qi = (VAR == 2) ? NA_TOK(crow(i, hi)) : qw + 32 * qb + crow(i, hi); const float al = WSF[32 * qb + crow(i, hi)];
            bf16_t* op;
            if (VAR == 3) op = P.ZQw + (tb + res + (size_t)r * qi) * ZC + C_DQ + g * 256 + h * 64;
            else op = P.Y + (tb + qi) * DM + VAR * 256 + h * 64;
            const unsigned a0 = cvt_pk(o[qb][0][i] * al, 0.f), a1 = cvt_pk(o[qb][1][i] * al, 0.f);
            op[r32] = (bf16_t)(a0 & 0xffffu); op[32 + r32] = (bf16_t)(a1 & 0xffffu);
        }
    }
    __syncthreads();
}

DI int t5_bucket(int rel) {
    const int n = rel < 0 ? -rel : rel;
    const int v = n < 8 ? n : 8 + (n >= 15) + (n >= 27) + (n >= 50) + (n >= 91) + (n >= 166) + (n >= 305) + (n >= 559);
    return (rel > 0 ? 16 : 0) + v;
}
DI void transpose_item(const float* W, int ldw, int coff, const float* kscale, bf16_t* WT, int ldt, LAS float* scr, int kb, int nb, int lane) {
    const int k0 = 64 * kb, n0 = 32 * nb;
    const int rr = lane >> 3, c4 = 4 * (lane & 7);
    f32x4 v[8];
#pragma unroll
    for (int i = 0; i < 8; ++i) v[i] = *(const f32x4*)(W + (size_t)(k0 + 8 * i + rr) * ldw + coff + n0 + c4);
#pragma unroll
    for (int i = 0; i < 8; ++i) {
        const int kk = 8 * i + rr; f32x4 x = v[i];
        if (kscale) x = x * kscale[k0 + kk];
        LAS float* d = scr + kk * 33 + c4; d[0] = x.x; d[1] = x.y; d[2] = x.z; d[3] = x.w;
    }
    __builtin_amdgcn_fence(__ATOMIC_RELEASE, "wavefront"); __builtin_amdgcn_wave_barrier(); __builtin_amdgcn_fence(__ATOMIC_ACQUIRE, "wavefront");
    const int c = lane & 7;
#pragma unroll
    for (int j = 0; j < 4; ++j) { const int n = (lane >> 3) + 8 * j; const LAS float* s = scr + (8 * c) * 33 + n;
        u32x4 o; o.x = cvt_pk(s[0 * 33], s[1 * 33]); o.y = cvt_pk(s[2 * 33], s[3 * 33]); o.z = cvt_pk(s[4 * 33], s[5 * 33]); o.w = cvt_pk(s[6 * 33], s[7 * 33]);
        *(u32x4*)(WT + (size_t)(n0 + n) * ldt + k0 + 8 * c) = o; }
    __builtin_amdgcn_fence(__ATOMIC_RELEASE, "wavefront"); __builtin_amdgcn_wave_barrier(); __builtin_amdgcn_fence(__ATOMIC_ACQUIRE, "wavefront");
}
DI void transpose_mat(const float* W, int K, int N, int ldw, int coff, const float* kscale, bf16_t* WT, int ldt, LAS float* scr, int gw, int NGW, int lane) {
    const int nblk = N / 32, items = (K / 64) * nblk;
    for (int it = gw; it < items; it += NGW) transpose_item(W, ldw, coff, kscale, WT, ldt, scr, it / nblk, it % nblk, lane);
}
template <int RN> DI void ln_rows(const float* in, float* outf, bf16_t* outb, float* stat, const float* gam, const float* bet, int lane) {
    f32x4 v[RN][4]; float mean[RN], rstd[RN];
#pragma unroll
    for (int r = 0; r < RN; ++r)
#pragma unroll
        for (int j = 0; j < 4; ++j) v[r][j] = ((const f32x4*)(in + (size_t)r * DM))[lane + 64 * j];
#pragma unroll
    for (int r = 0; r < RN; ++r) { float s = 0.f;
#pragma unroll
        for (int j = 0; j < 4; ++j) s += (v[r][j].x + v[r][j].y) + (v[r][j].z + v[r][j].w);
        mean[r] = s; }
#pragma unroll
    for (int r = 0; r < RN; ++r) mean[r] = wave_sum(mean[r]);
#pragma unroll
    for (int r = 0; r < RN; ++r) { mean[r] *= (1.f / DM); float s2 = 0.f;
#pragma unroll
        for (int j = 0; j < 4; ++j) { v[r][j] = v[r][j] - mean[r]; s2 += (v[r][j].x * v[r][j].x + v[r][j].y * v[r][j].y) + (v[r][j].z * v[r][j].z + v[r][j].w * v[r][j].w); }
        rstd[r] = s2; }
#pragma unroll
    for (int r = 0; r < RN; ++r) rstd[r] = wave_sum(rstd[r]);
#pragma unroll
    for (int r = 0; r < RN; ++r) { rstd[r] = 1.0f / sqrtf(rstd[r] * (1.f / DM) + 1e-5f); if (stat && lane == 0) { stat[2 * r] = mean[r]; stat[2 * r + 1] = rstd[r]; } }
#pragma unroll
    for (int j = 0; j < 4; ++j) {
        const f32x4 gg = ((const f32x4*)gam)[lane + 64 * j], bb = ((const f32x4*)bet)[lane + 64 * j];
#pragma unroll
        for (int r = 0; r < RN; ++r) {
            const f32x4 y = v[r][j] * rstd[r] * gg + bb;
            if (outf) ((f32x4*)(outf + (size_t)r * DM))[lane + 64 * j] = y;
            if (outb) { u32x2 w2; w2.x = cvt_pk(y.x, y.y); w2.y = cvt_pk(y.z, y.w); ((u32x2*)(outb + (size_t)r * DM))[lane + 64 * j] = w2; }
        }
    }
}

#define XB_TMO      128
#define XB_XCNT(j)  (256  + 64 * (j))
#define XB_XSUB(j)  (1280 + 64 * (j))
#define XB_XGEN(j)  (2304 + 64 * (j))
#define XB_TOP      3328
#define XB_TOPGEN   3392
#define XCD_BAR_WORDS 3456
#define XB_SPIN_CAP (1u << 20)
DI unsigned xb_ld(unsigned* p)              { return __hip_atomic_load(p, __ATOMIC_RELAXED, __HIP_MEMORY_SCOPE_AGENT); }
DI unsigned xb_add(unsigned* p, unsigned v) { return __hip_atomic_fetch_add(p, v, __ATOMIC_RELAXED, __HIP_MEMORY_SCOPE_AGENT); }
DI unsigned xb_xcc_id() { return (unsigned)__builtin_amdgcn_s_getreg((3 << 11) | 20) & 0xFu; }
#define XB_SPIN(cond, bar) do { unsigned _sp = 0; while (cond) { __builtin_amdgcn_s_sleep(1); \
    if ((++_sp & 255u) == 0u) { if (xb_ld(&(bar)[XB_TMO])) break; if (_sp > XB_SPIN_CAP) { atomicAdd(&(bar)[XB_TMO], 1u); break; } } } } while (0)
DI void xcd_barrier_complete(unsigned* bar, unsigned x, unsigned& nloc, unsigned& nx) {
    const unsigned G = gridDim.x;
    unsigned sum, cnt, mine, sp = 0u;
    for (;;) {
        sum = 0u; cnt = 0u; mine = 0u;
#pragma unroll
        for (unsigned j = 0; j < 16; ++j) { const unsigned c = xb_ld(&bar[XB_XCNT(j)]); sum += c; cnt += (c > 0u) ? 1u : 0u; mine = (j == x) ? c : mine; }
        if (sum == G) break;
        __builtin_amdgcn_s_sleep(1);
        if ((++sp & 255u) == 0u) { if (xb_ld(&bar[XB_TMO])) break; if (sp > XB_SPIN_CAP) { atomicAdd(&bar[XB_TMO], 1u); break; } }
    }
    nloc = mine > 0u ? mine : 1u; nx = cnt > 0u ? cnt : 1u;
}
DI void xcd_barrier(unsigned* bar, volatile LAS unsigned* st, bool leader) {
    asm volatile("s_waitcnt vmcnt(0)" ::: "memory");
    __syncthreads();
    if (leader) {
        const unsigned x = xb_xcc_id();
        __builtin_amdgcn_s_waitcnt(0);
        unsigned nloc = st[0], nx = st[1];
        if (nloc == 0u) { xcd_barrier_complete(bar, x, nloc, nx); st[0] = nloc; st[1] = nx; }
        const unsigned old = xb_add(&bar[XB_XSUB(x)], 1u);
        const unsigned gen = old / nloc;
        if (old + 1u == (gen + 1u) * nloc) {
            __builtin_amdgcn_fence(__ATOMIC_RELEASE, "agent");
            asm volatile("s_waitcnt vmcnt(0)" ::: "memory");
            const unsigned og = xb_add(&bar[XB_TOP], 1u);
            const unsigned tg = og / nx;
            if (og + 1u == (tg + 1u) * nx) xb_add(&bar[XB_TOPGEN], 1u);
            else XB_SPIN(xb_ld(&bar[XB_TOPGEN]) == tg, bar);
            __builtin_amdgcn_fence(__ATOMIC_ACQUIRE, "agent");
            xb_add(&bar[XB_XGEN(x)], 1u);
            asm volatile("s_waitcnt vmcnt(0)" ::: "memory");
        } else {
            XB_SPIN(xb_ld(&bar[XB_XGEN(x)]) == gen, bar);
            __builtin_amdgcn_fence(__ATOMIC_ACQUIRE, "agent");
            asm volatile("s_waitcnt vmcnt(0)" ::: "memory");
        }
    }
    __syncthreads();
}

struct Args { const float* in[22]; float* out; unsigned char* ws; int ph_lo, ph_hi; };
constexpr int PH_PER_LAYER = 11, N_PHASES = 1 + NL * PH_PER_LAYER;
constexpr int TAB_OFF = 131072 + 2048;
typedef volatile LAS unsigned long long* tab_t;
DI unsigned long long tab_get(tab_t TAB, int i) {
    const unsigned long long v = TAB[i];
    const unsigned lo = __builtin_amdgcn_readfirstlane((unsigned)v), hi = __builtin_amdgcn_readfirstlane((unsigned)(v >> 32));
    return ((unsigned long long)hi << 32) | lo;
}
#define TABF(i) ((const float*)tab_get(TAB, (i)))
#define TABWS() ((unsigned char*)tab_get(TAB, 23))
#define TABOUT() ((float*)tab_get(TAB, 22))

DI int opaque_s(int v) { asm volatile("" : "+s"(v)); return v; }
DI void conv_layer(tab_t TAB, LAS unsigned char* lds, int l, int gw, int NGW, int gt, int NGT, int wave, int lane) {
    unsigned char* ws = TABWS();
    bf16_t* Wqkv_t = (bf16_t*)(ws + W_QKV); bf16_t* Wuq_t = (bf16_t*)(ws + W_UQ); bf16_t* Wukv_t = (bf16_t*)(ws + W_UKV);
    LAS float* scr = (LAS float*)(lds + wave * 8704);
    { const float* win = TABF(5) + (size_t)l * DM * INC;
      transpose_mat(win, DM, 4000, INC, 0, nullptr, Wqkv_t, DM, scr, gw, NGW, lane);
      transpose_mat(win, DM, 4096, INC, C_G, nullptr, (bf16_t*)(ws + W_G), DM, scr, gw, NGW, lane); }
    transpose_mat(TABF(16) + (size_t)l * DM * FF, DM, FF, FF, 0, nullptr, (bf16_t*)(ws + W_FF1), DM, scr, gw, NGW, lane);
    transpose_mat(TABF(17) + (size_t)l * FF * DM, FF, DM, DM, 0, nullptr, (bf16_t*)(ws + W_FF2), FF, scr, gw, NGW, lane);
    for (int n = 0; n < 4; ++n) transpose_mat(TABF(12) + ((size_t)l * 4 + n) * 256 * DM, 256, DM, DM, 0, nullptr, (bf16_t*)(ws + W_B) + (size_t)n * DM * 256, 256, scr, gw, NGW, lane);
    transpose_mat(TABF(13) + (size_t)l * DM * DM, DM, DM, DM, 0, nullptr, (bf16_t*)(ws + W_OUT), DM, scr, gw, NGW, lane);
    transpose_mat(TABF(19) + (size_t)l * DM * DM, DM, DM, DM, 0, nullptr, (bf16_t*)(ws + W_PG), DM, scr, gw, NGW, lane);
    transpose_mat(TABF(18) + (size_t)l * 256 * DM, 256, DM, DM, 0, nullptr, (bf16_t*)(ws + W_PLE), 256, scr, gw, NGW, lane);
    transpose_mat(TABF(7) + (size_t)l * 256 * 384, 256, 384, 384, 0, TABF(6) + l * 256, Wuq_t, 256, scr, gw, NGW, lane);
    transpose_mat(TABF(9) + (size_t)l * 128 * 512, 128, 512, 512, 0, TABF(8) + l * 128, Wukv_t, 256, scr, gw, NGW, lane);
    for (int i = gt; i < 96 * DM / 2; i += NGT) ((unsigned*)(Wqkv_t + (size_t)4000 * DM))[i] = 0u;
    for (int i = gt; i < 128 * 256 / 2; i += NGT) ((unsigned*)(Wuq_t + (size_t)384 * 256))[i] = 0u;
    for (int i = gt; i < 512 * 64; i += NGT) { const int rr = i >> 6, cc = i & 63; ((unsigned*)(Wukv_t + (size_t)rr * 256 + 128))[cc] = 0u; }
    const float* pl = TABF(1) + (size_t)l * T * 256; bf16_t* PB = (bf16_t*)(ws + WS_PB);
    for (int i = gt; i < T * 256 / 8; i += NGT) {
        const f32x4 v0 = ((const f32x4*)pl)[2 * i], v1 = ((const f32x4*)pl)[2 * i + 1];
        u32x4 o; o.x = cvt_pk(v0.x, v0.y); o.y = cvt_pk(v0.z, v0.w); o.z = cvt_pk(v1.x, v1.y); o.w = cvt_pk(v1.z, v1.w);
        ((u32x4*)PB)[i] = o;
    }
}

__global__ void __launch_bounds__(512) fwd_kernel(Args a) {
    extern __shared__ __attribute__((aligned(16))) unsigned char lds_raw[];
    LAS unsigned char* lds = (LAS unsigned char*)lds_raw;
    cg::grid_group grid = cg::this_grid();
    tab_t TAB = (tab_t)(lds + TAB_OFF);
    if (threadIdx.x == 0) {
#pragma unroll
        for (int i = 0; i < 22; ++i) TAB[i] = (unsigned long long)a.in[i];
        TAB[22] = (unsigned long long)a.out; TAB[23] = (unsigned long long)a.ws;
    }
    volatile LAS unsigned* BST = (volatile LAS unsigned*)(lds + TAB_OFF + 256);
    if (threadIdx.x < 2) BST[threadIdx.x] = 0u;
    if (blockIdx.x == 0) { unsigned* bw = (unsigned*)a.ws; for (int i = threadIdx.x; i < XCD_BAR_WORDS; i += 512) bw[i] = 0u; }
    __syncthreads();
    const int ph_lo = a.ph_lo, ph_hi = a.ph_hi;
    const int wave_s = __builtin_amdgcn_readfirstlane((int)threadIdx.x >> 6);
#define TIDS int tid_ = wave_s * 64 + lane_id(); asm volatile("" : "+v"(tid_)); const int tid = tid_, lane = tid & 63, wave = __builtin_amdgcn_readfirstlane(tid >> 6); int G_ = gridDim.x, bid_ = blockIdx.x; asm volatile("" : "+s"(G_), "+s"(bid_)); const int G = G_, bid = bid_; \
             const int gw = bid * 8 + wave, NGW = G * 8; const int gt = bid * 512 + tid, NGT = G * 512; (void)lane; (void)gw; (void)NGW; (void)gt; (void)NGT; (void)wave;
#define GRIDX opaque_s((int)gridDim.x)
#define BIDX opaque_s((int)blockIdx.x)
#define PHASE(k) asm volatile("" ::: "memory"); if (ph_lo <= (k) && (k) < ph_hi)
#define SEAM0(k) do { if (ph_lo <= (k) && (k) + 1 < ph_hi) { grid.sync(); if (wave_s == 0 && lane_id() == 0) (void)xb_add(&((unsigned*)TABWS())[XB_XCNT(xb_xcc_id())], 1u); } } while (0)
#define SEAM(k) do { if (ph_lo <= (k) && (k) + 1 < ph_hi) xcd_barrier((unsigned*)TABWS(), BST, wave_s == 0 && lane_id() == 0); } while (0)

    PHASE(0) {
        TIDS
        conv_layer(TAB, lds, 0, gw, NGW, gt, NGT, wave, lane);
        unsigned char* ws = TABWS();
        float* COS = (float*)(ws + WS_ROPE); float* SIN = COS + S * 16;
        for (int i = gt; i < S * 16; i += NGT) {
            const int pos = i >> 4, f = i & 15;
            const double b4 = (f & 3) == 0 ? 1.0 : ((f & 3) == 1 ? 0.5623413251903491 : ((f & 3) == 2 ? 0.31622776601683794 : 0.1778279410038923));
            const double p10 = (f >> 2) == 0 ? 1.0 : ((f >> 2) == 1 ? 0.1 : ((f >> 2) == 2 ? 0.01 : 0.001));
            const float inv = (float)(b4 * p10);
            const float ang = (float)pos * inv;
            double rev = (double)ang * 0.15915494309189535; rev -= floor(rev);
            COS[i] = __builtin_amdgcn_cosf((float)rev); SIN[i] = __builtin_amdgcn_sinf((float)rev);
        }
        const float* rel_bias = TABF(4); float* LUTS = (float*)(ws + WS_LUTS); float* LUTD = (float*)(ws + WS_LUTD);
        for (int i = gt; i < 4 * 257; i += NGT) { const int hh = i / 257, rl = i % 257 - 128; LUTS[hh * 260 + rl + 128] = rel_bias[t5_bucket(rl) * 16 + hh] * LOG2E; }
        for (int i = gt; i < 12 * 129; i += NGT) { const int gh = i / 129, rl = i % 129 - 64, gg = gh >> 2; const int rr = gg == 0 ? 1 : (gg == 1 ? 4 : 16);
            LUTD[gh * 132 + rl + 64] = rel_bias[t5_bucket(rl * rr) * 16 + 4 + gh] * LOG2E; }
        const float* x = TABF(0); float* H = TABOUT(); bf16_t* HB = (bf16_t*)(ws + WS_HB); const float* eg = TABF(2); const float* eb = TABF(3);
        float* ST = (float*)(ws + WS_STATS); (void)H;
        for (int m = gw * 8; m < T; m += NGW * 8) ln_rows<8>(x + (size_t)m * DM, nullptr, HB + (size_t)m * DM, ST + (size_t)m * 2, eg, eb, lane);
    }
    SEAM0(0);

    for (int l = 0; l < NL; ++l) {
        const int P0 = 1 + l * PH_PER_LAYER;
        PHASE(P0 + 0) {
            unsigned char* ws = TABWS();
            pg8::Gemm g{(const bf16_t*)(ws + WS_HB), (const bf16_t*)(ws + W_QKV), DM, DM}; pg8::StaticOrder so; so.init(T, ZC, GRIDX, BIDX);
            pg8::EpiStore<0> E{(bf16_t*)(ws + WS_Z), ZC, ZC, nullptr, 0, 1.0f};
            pg8::gemm_phase(lds, g, so, E, wave_s);
        }
        SEAM(P0 + 0);
        PHASE(P0 + 1) {
            { TIDS
              unsigned char* ws = TABWS();
              const bf16_t* ZQ = (const bf16_t*)(ws + WS_Z); float* RSTD = (float*)(ws + WS_RSTD); bf16_t* KR = (bf16_t*)(ws + WS_KR);
              const float* COS = (const float*)(ws + WS_ROPE); const float* SIN = COS + S * 16;
              pg8::StaticOrder so; so.init(T, 512, G, bid); pg8::Unit uu;
              for (int i = 0; so.tile(i, uu); ++i) {
                  const int ch = lane & 7;
#pragma unroll 1
                  for (int it = 0; it < 4; ++it) {
                      const int m = uu.pm * 256 + wave * 32 + it * 8 + (lane >> 3);
                      const bf16_t* zr = ZQ + (size_t)m * ZC;
                      float sq = 0.f, sk = 0.f;
#pragma unroll
                      for (int j = 0; j < 4; ++j) { const u32x4 q = *(const u32x4*)(zr + C_AQ + ch * 32 + 8 * j);
                          sq += bf_lo(q.x) * bf_lo(q.x) + bf_hi(q.x) * bf_hi(q.x) + bf_lo(q.y) * bf_lo(q.y) + bf_hi(q.y) * bf_hi(q.y)
                              + bf_lo(q.z) * bf_lo(q.z) + bf_hi(q.z) * bf_hi(q.z) + bf_lo(q.w) * bf_lo(q.w) + bf_hi(q.w) * bf_hi(q.w); }
#pragma unroll
                      for (int j = 0; j < 2; ++j) { const u32x4 q = *(const u32x4*)(zr + C_AKV + ch * 16 + 8 * j);
                          sk += bf_lo(q.x) * bf_lo(q.x) + bf_hi(q.x) * bf_hi(q.x) + bf_lo(q.y) * bf_lo(q.y) + bf_hi(q.y) * bf_hi(q.y)
                              + bf_lo(q.z) * bf_lo(q.z) + bf_hi(q.z) * bf_hi(q.z) + bf_lo(q.w) * bf_lo(q.w) + bf_hi(q.w) * bf_hi(q.w); }
                      sq += shx<1>(sq); sk += shx<1>(sk); sq += shx<2>(sq); sk += shx<2>(sk); sq += shx<4>(sq); sk += shx<4>(sk);
                      if (ch == 0) { RSTD[(size_t)m * 2] = 1.0f / sqrtf(sq * (1.f / 256.f) + 1e-6f); RSTD[(size_t)m * 2 + 1] = 1.0f / sqrtf(sk * (1.f / 128.f) + 1e-6f); }
                      if (ch < 4 && uu.pn == 0) {
                          const int pos = m & (S - 1);
                          const u32x2 a1 = *(const u32x2*)(zr + C_AKR + 4 * ch), a2 = *(const u32x2*)(zr + C_AKR + 16 + 4 * ch);
                          const f32x4 c = *(const f32x4*)(COS + pos * 16 + 4 * ch), sn = *(const f32x4*)(SIN + pos * 16 + 4 * ch);
                          const float x10 = bf_lo(a1.x), x11 = bf_hi(a1.x), x12 = bf_lo(a1.y), x13 = bf_hi(a1.y), x20 = bf_lo(a2.x), x21 = bf_hi(a2.x), x22 = bf_lo(a2.y), x23 = bf_hi(a2.y);
                          u32x2 o1, o2;
                          o1.x = cvt_pk(x10 * c.x - x20 * sn.x, x11 * c.y - x21 * sn.y); o1.y = cvt_pk(x12 * c.z - x22 * sn.z, x13 * c.w - x23 * sn.w);
                          o2.x = cvt_pk(x10 * sn.x + x20 * c.x, x11 * sn.y + x21 * c.y); o2.y = cvt_pk(x12 * sn.z + x22 * c.z, x13 * sn.w + x23 * c.w);
                          *(u32x2*)(KR + (size_t)m * 32 + 4 * ch) = o1; *(u32x2*)(KR + (size_t)m * 32 + 16 + 4 * ch) = o2;
                      }
                  }
              }
              asm volatile("s_waitcnt vmcnt(0)" ::: "memory");
              __syncthreads();
            }
            asm volatile("" ::: "memory");
            { unsigned char* ws = TABWS();
              pg8::Gemm g{(const bf16_t*)(ws + WS_Z) + C_AQ, (const bf16_t*)(ws + W_UQ), ZC, 256}; pg8::StaticOrder so; so.init(T, 512, GRIDX, BIDX);
              pg8::EpiStore<0> E{(bf16_t*)(ws + WS_QM), 384, 384, (const float*)(ws + WS_RSTD), 2, 0.10206207261596575f * LOG2E};
              pg8::gemm_phase(lds, g, so, E, wave_s); }
            asm volatile("" ::: "memory");
            { unsigned char* ws = TABWS();
              pg8::Gemm g{(const bf16_t*)(ws + WS_Z) + C_AKV, (const bf16_t*)(ws + W_UKV), ZC, 256}; pg8::StaticOrder so; so.init(T, 512, GRIDX, BIDX);
              pg8::EpiStore<0> E{(bf16_t*)(ws + WS_KVM), 512, 512, (const float*)(ws + WS_RSTD) + 1, 2, 1.0f};
              pg8::gemm_phase(lds, g, so, E, wave_s); }
        }
        SEAM(P0 + 1);
        PHASE(P0 + 2) {
            unsigned char* ws = TABWS(); const int G = GRIDX, bid = BIDX;
            bf16_t* ZQ = (bf16_t*)(ws + WS_Z);
            AttnP AP{ZQ, (const bf16_t*)(ws + WS_QM), (const bf16_t*)(ws + WS_KVM), (const bf16_t*)(ws + WS_KR), (bf16_t*)(ws + WS_Y), ZQ, (float*)(ws + WS_LSE),
                     (const float*)(ws + WS_LUTS), (const float*)(ws + WS_LUTD), TABF(11) + (size_t)l * 4 * 465, TABF(10) + l * 4, (const float*)(ws + WS_ROPE)};
            const int xq = bid & 7, jq = bid >> 3, Gq = (G + 7 - xq) >> 3;
            for (int j = jq; j < 32; j += Gq) attn_unit<0>(lds, AP, xq * 32 + j, wave_s);
            for (int j = jq; j < 64; j += Gq) attn_unit<1>(lds, AP, xq * 64 + j, wave_s);
            for (int j = jq; j < 64; j += Gq) attn_unit<2>(lds, AP, xq * 64 + j, wave_s);
            for (int j = jq; j < 192; j += Gq) attn_unit<3>(lds, AP, xq * 192 + j, wave_s);
        }
        SEAM(P0 + 2);
        PHASE(P0 + 3) {
            TIDS
            unsigned char* ws = TABWS();
            const bf16_t* ZQ = (const bf16_t*)(ws + WS_Z); const float* LSE = (const float*)(ws + WS_LSE); bf16_t* Y = (bf16_t*)(ws + WS_Y);
            for (int i = gt; i < T * 32; i += NGT) {
                const int m = i >> 5, hh = (i >> 3) & 3, ch = i & 7;
                const float l0 = LSE[(size_t)m * 12 + hh], l1 = LSE[(size_t)m * 12 + 4 + hh], l2 = LSE[(size_t)m * 12 + 8 + hh];
                const float mx = fmaxf(l0, fmaxf(l1, l2));
                float w0 = __builtin_amdgcn_exp2f(l0 - mx), w1 = __builtin_amdgcn_exp2f(l1 - mx), w2 = __builtin_amdgcn_exp2f(l2 - mx);
                const float inv = 1.0f / (w0 + w1 + w2); w0 *= inv; w1 *= inv; w2 *= inv;
                const bf16_t* zp = ZQ + (size_t)m * ZC + C_DQ + hh * 64 + ch * 8;
                const u32x4 a0 = *(const u32x4*)zp, a1 = *(const u32x4*)(zp + 256), a2 = *(const u32x4*)(zp + 512);
                u32x4 o;
                o.x = cvt_pk(w0 * bf_lo(a0.x) + w1 * bf_lo(a1.x) + w2 * bf_lo(a2.x), w0 * bf_hi(a0.x) + w1 * bf_hi(a1.x) + w2 * bf_hi(a2.x));
                o.y = cvt_pk(w0 * bf_lo(a0.y) + w1 * bf_lo(a1.y) + w2 * bf_lo(a2.y), w0 * bf_hi(a0.y) + w1 * bf_hi(a1.y) + w2 * bf_hi(a2.y));
                o.z = cvt_pk(w0 * bf_lo(a0.z) + w1 * bf_lo(a1.z) + w2 * bf_lo(a2.z), w0 * bf_hi(a0.z) + w1 * bf_hi(a1.z) + w2 * bf_hi(a2.z));
                o.w = cvt_pk(w0 * bf_lo(a0.w) + w1 * bf_lo(a1.w) + w2 * bf_lo(a2.w), w0 * bf_hi(a0.w) + w1 * bf_hi(a1.w) + w2 * bf_hi(a2.w));
                *(u32x4*)(Y + (size_t)m * DM + 768 + hh * 64 + ch * 8) = o;
            }
        }
        SEAM(P0 + 3);
        PHASE(P0 + 4) {
            unsigned char* ws = TABWS();
            pg8::Gemm g{(const bf16_t*)(ws + WS_HB), (const bf16_t*)(ws + W_G), DM, DM}; pg8::StaticOrder so; so.init(T, ZC, GRIDX, BIDX);
            pg8::EpiStore<1> E{(bf16_t*)(ws + WS_Z), ZC, ZC, nullptr, 0, 1.0f};
            pg8::gemm_phase(lds, g, so, E, wave_s);
        }
        SEAM(P0 + 4);
        PHASE(P0 + 5) {
            unsigned char* ws = TABWS();
            pg8::Gemm g{(const bf16_t*)(ws + WS_Y), (const bf16_t*)(ws + W_B), DM, 256}; pg8::MergeOrder mo; mo.s.init(T, DM, GRIDX, BIDX);
            pg8::EpiMerge E{(bf16_t*)(ws + WS_MG), (const bf16_t*)(ws + WS_Z)};
            pg8::gemm_phase(lds, g, mo, E, wave_s);
        }
        SEAM(P0 + 5);
        PHASE(P0 + 6) {
            unsigned char* ws = TABWS();
            pg8::Gemm g{(const bf16_t*)(ws + WS_MG), (const bf16_t*)(ws + W_OUT), DM, DM}; pg8::StaticOrder so; so.init(T, DM, GRIDX, BIDX);
            float* Hout = TABOUT();
            pg8::EpiResid<false> E{l == 0 ? TABF(0) : (const float*)Hout, Hout, nullptr, (const float*)(ws + WS_STATS), l == 0 ? TABF(2) : TABF(20) + (l - 1) * DM, l == 0 ? TABF(3) : TABF(21) + (l - 1) * DM};
            pg8::gemm_phase(lds, g, so, E, wave_s);
        }
        SEAM(P0 + 6);
        PHASE(P0 + 7) {
            TIDS
            unsigned char* ws = TABWS(); float* H = TABOUT(); bf16_t* HB = (bf16_t*)(ws + WS_HB); const float* gg = TABF(14) + l * DM; const float* bb = TABF(15) + l * DM;
            float* ST = (float*)(ws + WS_STATS);
            for (int m = gw * 8; m < T; m += NGW * 8) ln_rows<8>(H + (size_t)m * DM, nullptr, HB + (size_t)m * DM, ST + (size_t)m * 2, gg, bb, lane);
        }
        SEAM(P0 + 7);
        PHASE(P0 + 8) {
            { unsigned char* ws = TABWS();
              pg8::Gemm g{(const bf16_t*)(ws + WS_HB), (const bf16_t*)(ws + W_FF1), DM, DM}; pg8::StaticOrder so; so.init(T, FF, GRIDX, BIDX);
              pg8::EpiStore<2> E{(bf16_t*)(ws + WS_Z), FF, FF, nullptr, 0, 1.0f};
              pg8::gemm_phase(lds, g, so, E, wave_s); }
            asm volatile("" ::: "memory");
            { unsigned char* ws = TABWS();
              pg8::Gemm g{(const bf16_t*)(ws + WS_HB), (const bf16_t*)(ws + W_PG), DM, DM}; pg8::StaticOrder so; so.init(T, DM, GRIDX, BIDX);
              pg8::EpiStore<1> E{(bf16_t*)(ws + WS_Y), DM, DM, nullptr, 0, 1.0f};
              pg8::gemm_phase(lds, g, so, E, wave_s); }
            asm volatile("" ::: "memory");
            { unsigned char* ws = TABWS();
              pg8::Gemm g{(const bf16_t*)(ws + WS_PB), (const bf16_t*)(ws + W_PLE), 256, 256}; pg8::StaticOrder so; so.init(T, DM, GRIDX, BIDX);
              pg8::EpiMulInto E{(bf16_t*)(ws + WS_Y)};
              pg8::gemm_phase(lds, g, so, E, wave_s); }
        }
        SEAM(P0 + 8);
        PHASE(P0 + 9) {
            unsigned char* ws = TABWS();
            pg8::Gemm g{(const bf16_t*)(ws + WS_Z), (const bf16_t*)(ws + W_FF2), FF, FF}; pg8::StaticOrder so; so.init(T, DM, GRIDX, BIDX);
            float* Hout = TABOUT();
            pg8::EpiResid<true> E{(const float*)Hout, Hout, (const bf16_t*)(ws + WS_Y), (const float*)(ws + WS_STATS), TABF(14) + l * DM, TABF(15) + l * DM};
            pg8::gemm_phase(lds, g, so, E, wave_s);
        }
        SEAM(P0 + 9);
        PHASE(P0 + 10) {
            TIDS
            unsigned char* ws = TABWS(); float* H = TABOUT(); bf16_t* HB = (bf16_t*)(ws + WS_HB); const float* gg = TABF(20) + l * DM; const float* bb = TABF(21) + l * DM;
            float* ST = (float*)(ws + WS_STATS);
            if (l + 1 < NL) { for (int m = gw * 8; m < T; m += NGW * 8) ln_rows<8>(H + (size_t)m * DM, nullptr, HB + (size_t)m * DM, ST + (size_t)m * 2, gg, bb, lane); }
            else { for (int m = gw * 8; m < T; m += NGW * 8) ln_rows<8>(H + (size_t)m * DM, H + (size_t)m * DM, nullptr, nullptr, gg, bb, lane); }
            if (l + 1 < NL) conv_layer(TAB, lds, l + 1, gw, NGW, gt, NGT, wave, lane);
        }
        if (l + 1 < NL) SEAM(P0 + 10);
    }
}

extern "C" void kernel_launch(void* const* d_in, const int* in_sizes, int n_in, void* d_out, int out_size, void* d_ws, size_t ws_size, hipStream_t stream) {
    static int grid = 0;
    if (grid == 0) {
        if (n_in != 22 || out_size != T * DM || ws_size < WS_END) { fprintf(stderr, "kernel_launch: unexpected shapes (n_in %d out %d ws %zu)\n", n_in, out_size, ws_size); grid = -1; return; }
        int dev = 0, cus = 0, per = 0;
        (void)hipGetDevice(&dev); (void)hipDeviceGetAttribute(&cus, hipDeviceAttributeMultiprocessorCount, dev);
        (void)hipFuncSetAttribute((const void*)fwd_kernel, hipFuncAttributeMaxDynamicSharedMemorySize, LDS_BYTES);
        (void)hipOccupancyMaxActiveBlocksPerMultiprocessor(&per, (const void*)fwd_kernel, 512, LDS_BYTES);
        if (per < 1) per = 1;
        grid = cus * per;
        fprintf(stderr, "kernel_launch: grid %d (cus %d x %d)\n", grid, cus, per);
    }
    if (grid < 0) return;
    Args a{};
    for (int i = 0; i < 22; ++i) a.in[i] = (const float*)d_in[i];
    a.out = (float*)d_out; a.ws = (unsigned char*)d_ws;
#if N_LAUNCH_MODE == 1
    a.ph_lo = 0; a.ph_hi = N_PHASES;
    void* args[] = {&a};
    hipError_t e = hipLaunchCooperativeKernel((void*)fwd_kernel, dim3(grid), dim3(512), args, LDS_BYTES, stream);
    if (e != hipSuccess) fprintf(stderr, "cooperative launch failed: %s (grid %d)\n", hipGetErrorString(e), grid);
#else
    for (int k = 0; k < N_PHASES; ++k) { a.ph_lo = k; a.ph_hi = k + 1; hipLaunchKernelGGL(fwd_kernel, dim3(grid), dim3(512), LDS_BYTES, stream, a); }
#endif
}
```

```cpp
#include <hip/hip_runtime.h>
#include <hip/hip_cooperative_groups.h>
#include <cstdio>
#include <cstdint>
namespace cg = cooperative_groups;

#define LAS __attribute__((address_space(3)))
#define DI __device__ __forceinline__
typedef unsigned short bf16_t;
typedef short bf16x8 __attribute__((ext_vector_type(8)));
typedef short s16x4 __attribute__((ext_vector_type(4)));
typedef float f32x4 __attribute__((ext_vector_type(4)));
typedef float f32x2 __attribute__((ext_vector_type(2)));
typedef float f32x16 __attribute__((ext_vector_type(16)));
typedef unsigned u32x4 __attribute__((ext_vector_type(4)));
typedef unsigned u32x2 __attribute__((ext_vector_type(2)));
typedef __bf16 bf16x2_t __attribute__((ext_vector_type(2)));

#ifndef N_LAUNCH_MODE
#define N_LAUNCH_MODE 1
#endif

constexpr int T = 32768, S = 8192, DM = 1024, FF = 4096, INC = 8096, ZC = 4096, NL = 2;
constexpr int C_AQ = 0, C_AKV = 256, C_AKR = 384, C_BQ = 416, C_BK = 672, C_BV = 800, C_CQ = 928, C_CK = 1184, C_CV = 1440,
              C_DQ = 1696, C_DK = 2464, C_DV = 3232, C_G = 4000;
constexpr float LOG2E = 1.4426950408889634f;
constexpr float ALPHA = 1.4142135623730951f;

constexpr size_t MiB = 1u << 20;
constexpr size_t WS_RSTD = 64 * 1024, WS_LUTS = 320 * 1024, WS_LUTD = 328 * 1024, WS_LSE = 512 * 1024;
constexpr size_t WS_W = 2 * MiB;
constexpr size_t W_QKV = WS_W, W_G = WS_W + 8 * MiB, W_FF1 = WS_W + 16 * MiB, W_FF2 = WS_W + 24 * MiB, W_B = WS_W + 32 * MiB, W_OUT = WS_W + 34 * MiB,
                 W_PG = WS_W + 36 * MiB, W_PLE = WS_W + 38 * MiB, W_UQ = WS_W + 38 * MiB + 512 * 1024, W_UKV = WS_W + 38 * MiB + 768 * 1024;
constexpr size_t WS_ROPE = 41 * MiB, WS_PB = 42 * MiB, WS_HB = 58 * MiB, WS_Z = 122 * MiB, WS_Y = 378 * MiB, WS_M = 442 * MiB;
constexpr size_t WS_QM = WS_M, WS_KVM = WS_M + 24 * MiB, WS_KR = WS_M + 56 * MiB, WS_MG = WS_M;
constexpr size_t WS_STATS = 506 * MiB;
constexpr size_t WS_END = 512 * MiB;

constexpr int LDS_BYTES = 135168;

DI unsigned cvt_pk(float lo, float hi) { f32x2 v = {lo, hi}; bf16x2_t b = __builtin_convertvector(v, bf16x2_t); return __builtin_bit_cast(unsigned, b); }
DI float bf_lo(unsigned u) { return __uint_as_float(u << 16); }
DI float bf_hi(unsigned u) { return __uint_as_float(u & 0xffff0000u); }
DI float xhalf_max(float m) { auto rr = __builtin_amdgcn_permlane32_swap(__float_as_uint(m), __float_as_uint(m), false, false); return fmaxf(__uint_as_float(rr[0]), __uint_as_float(rr[1])); }
DI float xhalf_sum(float m) { auto rr = __builtin_amdgcn_permlane32_swap(__float_as_uint(m), __float_as_uint(m), false, false); return __uint_as_float(rr[0]) + __uint_as_float(rr[1]); }
template <int O> DI float shx(float v) { return __int_as_float(__builtin_amdgcn_ds_swizzle(__float_as_int(v), (O << 10) | 0x1f)); }
DI float wave_sum(float v) {
    v += shx<1>(v); v += shx<2>(v); v += shx<4>(v); v += shx<8>(v); v += shx<16>(v); v = xhalf_sum(v);
    return v;
}
DI float sigmoid_f(float x) { return __builtin_amdgcn_rcpf(1.0f + __builtin_amdgcn_exp2f(-x * LOG2E)); }
DI int lane_id() { int l; asm volatile("v_mbcnt_lo_u32_b32 %0, -1, 0\n\tv_mbcnt_hi_u32_b32 %0, -1, %0" : "=v"(l)); return l; }
DI int crow(int r, int hi) { return (r & 3) + 8 * (r >> 2) + 4 * hi; }

namespace pg8 {
constexpr int BM = 256, BK = 64, HALF = 128, HTB = HALF * BK * 2, STAGE_BYTES = 8 * HTB, NXCD = 8, WGM = 8;
DI int lds_byte(int r, int c) { const int st = (r >> 4) * 2 + (c >> 5), rr = r & 15, cc = c & 31, ob = rr * 64 + cc * 2; return st * 1024 + (ob ^ (((ob >> 9) & 1) << 5)); }
DI void stage_rc(int b, int& R, int& C) { const int st = b / 1024, sb = b % 1024, swz = sb ^ (((sb >> 9) & 1) << 5); R = (st >> 1) * 16 + swz / 64; C = (st & 1) * 32 + (swz % 64) / 2; }
DI int perm32(int rho) { const int n = rho >> 4, i = rho & 15; return 8 * (i >> 2) + 4 * n + (i & 3); }

struct Unit { int pm, pn, z; };
struct Gemm { const bf16_t* A; const bf16_t* Bt; int lda; int K; };

struct StaticOrder {
    int nM, nN, nwg, G, c;
    DI void init(int M, int N, int G_, int c_) { nM = M / BM; nN = N / BM; nwg = nM * nN; G = G_; c = c_; }
    DI bool tile(int i, Unit& u) const {
        const long L = (long)i * G + c; if (L >= nwg) return false;
        int wgid = (int)L; { const int q = nwg / NXCD, r = nwg % NXCD, xcd = wgid % NXCD, off = wgid / NXCD; wgid = (xcd < r ? xcd * (q + 1) : r * (q + 1) + (xcd - r) * q) + off; }
        const int nig = WGM * nN, gid = wgid / nig, fm = gid * WGM, gsz = (nM - fm) < WGM ? (nM - fm) : WGM;
        u.pm = fm + ((wgid % nig) % gsz); u.pn = (wgid % nig) / gsz; u.z = 0; return true;
    }
    DI bool next(int i, Unit& u) const { return tile(i, u); }
    DI size_t aoff(const Unit& u, const Gemm& g) const { return (size_t)u.pm * BM * g.lda * 2; }
    DI size_t boff(const Unit& u, const Gemm& g) const { return (size_t)u.pn * BM * g.K * 2; }
};
struct MergeOrder {
    StaticOrder s;
    DI bool next(int i, Unit& u) const { if (!s.tile(i >> 2, u)) return false; u.z = i & 3; return true; }
    DI size_t aoff(const Unit& u, const Gemm& g) const { return (size_t)u.pm * BM * g.lda * 2 + (size_t)u.z * 256 * 2; }
    DI size_t boff(const Unit& u, const Gemm& g) const { return (size_t)(u.z * 4 + u.pn) * BM * g.K * 2; }
};

#define EPI_ROWS_BEGIN \
    _Pragma("unroll") for (int ai = 0; ai < 2; ++ai) _Pragma("unroll") for (int m = 0; m < 4; ++m) { const int row = u.pm * BM + ai * HALF + wr * 64 + m * 16 + fr;
#define EPI_COLS_BEGIN \
    _Pragma("unroll") for (int bj = 0; bj < 2; ++bj) { const int col = u.pn * BM + bj * HALF + wc * 32 + 8 * fq; f32x4 v0 = acc[ai][bj][m][0], v1 = acc[ai][bj][m][1];
#define EPI_END } asm volatile("" ::: "memory"); }

template <int ACT  > struct EpiStore {
    bf16_t* O; int ldc; int ncv; const float* rs; int rss; float cmul;
    DI void operator()(const f32x4 (&acc)[2][2][4][2], const Unit& u, int wr, int wc, int fr, int fq) const {
        float scv[2][4];
#pragma unroll
        for (int ai = 0; ai < 2; ++ai)
#pragma unroll
            for (int m = 0; m < 4; ++m) scv[ai][m] = rs ? rs[(size_t)(u.pm * BM + ai * HALF + wr * 64 + m * 16 + fr) * rss] * cmul : 1.0f;
        EPI_ROWS_BEGIN
            const float sc = scv[ai][m]; bf16_t* rowp = O + (size_t)row * ldc;
            EPI_COLS_BEGIN
                if (col < ncv) {
                    v0 = v0 * sc; v1 = v1 * sc;
                    if (ACT == 1) {
#pragma unroll
                        for (int j = 0; j < 4; ++j) { v0[j] = sigmoid_f(v0[j]); v1[j] = sigmoid_f(v1[j]); }
                    }
                    if (ACT == 2) {
#pragma unroll
                        for (int j = 0; j < 4; ++j) { const float a = fmaxf(v0[j], 0.f), b = fmaxf(v1[j], 0.f); v0[j] = a * a; v1[j] = b * b; }
                    }
                    u32x4 w; w.x = cvt_pk(v0[0], v0[1]); w.y = cvt_pk(v0[2], v0[3]); w.z = cvt_pk(v1[0], v1[1]); w.w = cvt_pk(v1[2], v1[3]);
                    *(u32x4*)(rowp + col) = w;
                }
            }
            asm volatile("" ::: "memory");
        }
    }
};
#define EPI_ROW(ai, m) (u.pm * BM + (ai) * HALF + wr * 64 + (m) * 16 + fr)
#define EPI_COL(bj) (u.pn * BM + (bj) * HALF + wc * 32 + 8 * fq)
DI void mul_bf8(f32x4& v0, f32x4& v1, const u32x4 g) {
    v0[0] *= bf_lo(g.x); v0[1] *= bf_hi(g.x); v0[2] *= bf_lo(g.y); v0[3] *= bf_hi(g.y); v1[0] *= bf_lo(g.z); v1[1] *= bf_hi(g.z); v1[2] *= bf_lo(g.w); v1[3] *= bf_hi(g.w); }
DI void add_bf8(f32x4& v0, f32x4& v1, const u32x4 g) {
    v0[0] += bf_lo(g.x); v0[1] += bf_hi(g.x); v0[2] += bf_lo(g.y); v0[3] += bf_hi(g.y); v1[0] += bf_lo(g.z); v1[1] += bf_hi(g.z); v1[2] += bf_lo(g.w); v1[3] += bf_hi(g.w); }
DI u32x4 pack_bf8(const f32x4 v0, const f32x4 v1) { u32x4 w; w.x = cvt_pk(v0[0], v0[1]); w.y = cvt_pk(v0[2], v0[3]); w.z = cvt_pk(v1[0], v1[1]); w.w = cvt_pk(v1[2], v1[3]); return w; }
struct EpiMerge {
    bf16_t* MG; const bf16_t* GT;
    DI void operator()(const f32x4 (&acc)[2][2][4][2], const Unit& u, int wr, int wc, int fr, int fq) const {
#pragma unroll
        for (int ai = 0; ai < 2; ++ai)
#pragma unroll
            for (int mh = 0; mh < 2; ++mh) {
                u32x4 gv[2][2], ov[2][2];
#pragma unroll
                for (int mm = 0; mm < 2; ++mm)
#pragma unroll
                    for (int bj = 0; bj < 2; ++bj) {
                        const size_t row = EPI_ROW(ai, 2 * mh + mm); const int col = EPI_COL(bj);
                        gv[mm][bj] = *(const u32x4*)(GT + row * ZC + u.z * DM + col);
                        if (u.z != 0) ov[mm][bj] = *(const u32x4*)(MG + row * DM + col);
                    }
#pragma unroll
                for (int mm = 0; mm < 2; ++mm)
#pragma unroll
                    for (int bj = 0; bj < 2; ++bj) {
                        const size_t row = EPI_ROW(ai, 2 * mh + mm); const int col = EPI_COL(bj);
                        f32x4 v0 = acc[ai][bj][2 * mh + mm][0], v1 = acc[ai][bj][2 * mh + mm][1];
                        mul_bf8(v0, v1, gv[mm][bj]);
                        if (u.z != 0) add_bf8(v0, v1, ov[mm][bj]);
                        *(u32x4*)(MG + row * DM + col) = pack_bf8(v0, v1);
                    }
                asm volatile("" ::: "memory");
            }
    }
};
template <bool EXTRA> struct EpiResid {
    const float* Xin; float* Xout; const bf16_t* E; const float* stats; const float* gam; const float* bet;
    DI void operator()(const f32x4 (&acc)[2][2][4][2], const Unit& u, int wr, int wc, int fr, int fq) const {
        f32x4 g0[2], g1[2], b0[2], b1[2];
#pragma unroll
        for (int bj = 0; bj < 2; ++bj) { const int col = EPI_COL(bj);
            g0[bj] = *(const f32x4*)(gam + col) * ALPHA; g1[bj] = *(const f32x4*)(gam + col + 4) * ALPHA;
            b0[bj] = *(const f32x4*)(bet + col) * ALPHA; b1[bj] = *(const f32x4*)(bet + col + 4) * ALPHA; }
#pragma unroll
        for (int ai = 0; ai < 2; ++ai)
#pragma unroll
            for (int mh = 0; mh < 2; ++mh) {
                f32x4 x0[2][2], x1[2][2]; u32x4 ev[2][2]; f32x2 st[2];
#pragma unroll
                for (int mm = 0; mm < 2; ++mm) {
                    const size_t row = EPI_ROW(ai, 2 * mh + mm);
                    st[mm] = *(const f32x2*)(stats + row * 2);
#pragma unroll
                    for (int bj = 0; bj < 2; ++bj) {
                        const int col = EPI_COL(bj);
                        x0[mm][bj] = *(const f32x4*)(Xin + row * DM + col); x1[mm][bj] = *(const f32x4*)(Xin + row * DM + col + 4);
                        if (EXTRA) ev[mm][bj] = *(const u32x4*)(E + row * DM + col);
                    }
                }
#pragma unroll
                for (int mm = 0; mm < 2; ++mm)
#pragma unroll
                    for (int bj = 0; bj < 2; ++bj) {
                        const size_t row = EPI_ROW(ai, 2 * mh + mm); const int col = EPI_COL(bj);
                        const float mean = st[mm].x, rstd = st[mm].y;
                        f32x4 v0 = acc[ai][bj][2 * mh + mm][0] + ((x0[mm][bj] - mean) * rstd) * g0[bj] + b0[bj];
                        f32x4 v1 = acc[ai][bj][2 * mh + mm][1] + ((x1[mm][bj] - mean) * rstd) * g1[bj] + b1[bj];
                        if (EXTRA) add_bf8(v0, v1, ev[mm][bj]);
                        *(f32x4*)(Xout + row * DM + col) = v0; *(f32x4*)(Xout + row * DM + col + 4) = v1;
                    }
                asm volatile("" ::: "memory");
            }
    }
};
struct EpiMulInto {
    bf16_t* P;
    DI void operator()(const f32x4 (&acc)[2][2][4][2], const Unit& u, int wr, int wc, int fr, int fq) const {
#pragma unroll
        for (int ai = 0; ai < 2; ++ai) {
            u32x4 gv[4][2];
#pragma unroll
            for (int m = 0; m < 4; ++m)
#pragma unroll
                for (int bj = 0; bj < 2; ++bj) gv[m][bj] = *(const u32x4*)(P + (size_t)EPI_ROW(ai, m) * DM + EPI_COL(bj));
#pragma unroll
            for (int m = 0; m < 4; ++m)
#pragma unroll
                for (int bj = 0; bj < 2; ++bj) {
                    f32x4 v0 = acc[ai][bj][m][0], v1 = acc[ai][bj][m][1];
                    mul_bf8(v0, v1, gv[m][bj]);
                    *(u32x4*)(P + (size_t)EPI_ROW(ai, m) * DM + EPI_COL(bj)) = pack_bf8(v0, v1);
                }
            asm volatile("" ::: "memory");
        }
    }
};

template <class Epi, class Sched>
DI void gemm_phase(LAS unsigned char* lds, const Gemm g, const Sched& S_, const Epi& E, const int wave_s) {
    int tid_ = wave_s * 64 + lane_id(); asm volatile("" : "+v"(tid_));
    const int tid = tid_, wid = __builtin_amdgcn_readfirstlane(tid >> 6), lane = tid & 63, wr = wid >> 2, wc = wid & 3, fr = lane & 15, fq = lane >> 4;
    const int K = g.K, nt = K / BK;
    unsigned voffA[2], voffB[2];
#pragma unroll
    for (int i = 0; i < 2; ++i) { int R, C; stage_rc(tid * 16 + i * 8192, R, C); const int Rb = (R & ~31) + perm32(R & 31);
        voffA[i] = (unsigned)(R * g.lda + C) * 2u; voffB[i] = (unsigned)(Rb * K + C) * 2u; }
    const size_t kstep = (size_t)(BK * 2);
    const size_t hstepA = (size_t)HALF * g.lda * 2, hstepB = (size_t)HALF * K * 2;
    const unsigned ldsw = (unsigned)wid * 1024u;
    const int aoff = lds_byte(wr * 64 + fr, fq * 8), boff = lds_byte(wc * 32 + fr, fq * 8);
#define PG8_SA(b, h) (((b) * 2 + (h)) * HTB)
#define PG8_SB(b, h) ((4 + (b) * 2 + (h)) * HTB)
#define PG8_STAGE(bufoff, gbase, voff) do { _Pragma("unroll") for (int _i = 0; _i < 2; ++_i) \
        __builtin_amdgcn_global_load_lds((const unsigned*)((const char*)(gbase) + (voff)[_i]), (LAS unsigned*)(lds + (bufoff) + ldsw + _i * 8192), 16, 0, 0); } while (0)
#define PG8_LDA(dst, b, h) do { _Pragma("unroll") for (int m = 0; m < 4; ++m) _Pragma("unroll") for (int k = 0; k < 2; ++k) dst[m][k] = *(const LAS bf16x8*)(lds + PG8_SA(b, h) + aoff + m * 2048 + k * 1024); } while (0)
#define PG8_LDB(dst, b, h) do { _Pragma("unroll") for (int n = 0; n < 2; ++n) _Pragma("unroll") for (int k = 0; k < 2; ++k) dst[n][k] = *(const LAS bf16x8*)(lds + PG8_SB(b, h) + boff + n * 2048 + k * 1024); } while (0)
#define PG8_MMA(ai, bj, At, Bt) do { __builtin_amdgcn_s_setprio(1); _Pragma("unroll") for (int m = 0; m < 4; ++m) _Pragma("unroll") for (int n = 0; n < 2; ++n) _Pragma("unroll") for (int k = 0; k < 2; ++k) \
        acc[ai][bj][m][n] = __builtin_amdgcn_mfma_f32_16x16x32_bf16(Bt[n][k], At[m][k], acc[ai][bj][m][n], 0, 0, 0); __builtin_amdgcn_s_setprio(0); } while (0)
#define PG8_WAIT_V(n) asm volatile("s_waitcnt vmcnt(" #n ")" ::: "memory")
#define PG8_WAIT_L(n) asm volatile("s_waitcnt lgkmcnt(" #n ")" ::: "memory")
#define PG8_BAR __builtin_amdgcn_s_barrier()
#define PG8_SCHED __builtin_amdgcn_sched_barrier(0)
    Unit cur, nxt; int ui = 0;
    if (!S_.next(0, cur)) return;
    f32x4 acc[2][2][4][2];
#pragma unroll
    for (int a = 0; a < 2; ++a)
#pragma unroll
        for (int b = 0; b < 2; ++b)
#pragma unroll
            for (int m = 0; m < 4; ++m)
#pragma unroll
                for (int n = 0; n < 2; ++n) acc[a][b][m][n] = (f32x4){0.f, 0.f, 0.f, 0.f};
    bf16x8 At[4][2], B0[2][2], B1[2][2];
    const char* cA = (const char*)g.A + S_.aoff(cur, g); const char* cB = (const char*)g.Bt + S_.boff(cur, g);
    PG8_STAGE(PG8_SB(0, 0), cB, voffB); PG8_STAGE(PG8_SB(0, 1), cB + hstepB, voffB); PG8_STAGE(PG8_SA(0, 0), cA, voffA); PG8_STAGE(PG8_SA(0, 1), cA + hstepA, voffA);
    if (wr == 1) PG8_BAR;
    PG8_WAIT_V(2); PG8_BAR;
    PG8_STAGE(PG8_SB(1, 0), cB + kstep, voffB); PG8_STAGE(PG8_SA(1, 0), cA + kstep, voffA); PG8_STAGE(PG8_SB(1, 1), cB + hstepB + kstep, voffB);
    PG8_WAIT_V(6); PG8_BAR;
    for (;;) {
        const bool has_next = S_.next(ui + 1, nxt);
        const char* nA = has_next ? (const char*)g.A + S_.aoff(nxt, g) : cA; const char* nB = has_next ? (const char*)g.Bt + S_.boff(nxt, g) : cB;
        for (int t = 0; t < nt; t += 2) {
            const bool last = (t == nt - 2);
            const char* a1 = cA + (size_t)(t + 1) * kstep;
            const char* a2 = last ? nA : cA + (size_t)(t + 2) * kstep; const char* b2 = last ? nB : cB + (size_t)(t + 2) * kstep;
            const char* a3 = a2 + kstep; const char* b3 = b2 + kstep;
            PG8_LDB(B0, 0, 0); PG8_LDB(B1, 0, 1); PG8_SCHED; PG8_LDA(At, 0, 0); PG8_STAGE(PG8_SA(1, 1), a1 + hstepA, voffA);
            PG8_WAIT_V(8); PG8_WAIT_L(0); PG8_BAR; PG8_MMA(0, 0, At, B0); PG8_MMA(0, 1, At, B1); PG8_BAR; PG8_SCHED;
            PG8_LDA(At, 0, 1); PG8_STAGE(PG8_SB(0, 0), b2, voffB); PG8_STAGE(PG8_SB(0, 1), b2 + hstepB, voffB); PG8_STAGE(PG8_SA(0, 0), a2, voffA);
            PG8_WAIT_V(8); PG8_WAIT_L(0); PG8_BAR; PG8_MMA(1, 0, At, B0); PG8_MMA(1, 1, At, B1); PG8_BAR; PG8_SCHED;
            PG8_LDB(B0, 1, 0); PG8_LDB(B1, 1, 1); PG8_SCHED; PG8_LDA(At, 1, 0); PG8_STAGE(PG8_SA(0, 1), a2 + hstepA, voffA);
            PG8_WAIT_V(8); PG8_WAIT_L(0); PG8_BAR; PG8_MMA(0, 0, At, B0); PG8_MMA(0, 1, At, B1); PG8_BAR; PG8_SCHED;
            PG8_LDA(At, 1, 1); PG8_STAGE(PG8_SB(1, 0), b3, voffB); PG8_STAGE(PG8_SB(1, 1), b3 + hstepB, voffB); PG8_STAGE(PG8_SA(1, 0), a3, voffA);
            PG8_WAIT_V(8); PG8_WAIT_L(0); PG8_BAR; PG8_MMA(1, 0, At, B0); PG8_MMA(1, 1, At, B1); PG8_BAR; PG8_SCHED;
        }
        if (wr == 0) PG8_BAR;
        { const int l2 = lane_id(); E(acc, cur, wr, wc, l2 & 15, l2 >> 4); }
        if (!has_next) break;
#pragma unroll
        for (int a = 0; a < 2; ++a)
#pragma unroll
            for (int b = 0; b < 2; ++b)
#pragma unroll
                for (int m = 0; m < 4; ++m)
#pragma unroll
                    for (int n = 0; n < 2; ++n) acc[a][b][m][n] = (f32x4){0.f, 0.f, 0.f, 0.f};
        cur = nxt; cA = nA; cB = nB; ++ui;
        if (wr == 1) PG8_BAR;
    }
    PG8_WAIT_V(0);
    PG8_BAR;
#undef PG8_SA
#undef PG8_SB
#undef PG8_STAGE
#undef PG8_LDA
#undef PG8_LDB
#undef PG8_MMA
#undef PG8_WAIT_V
#undef PG8_WAIT_L
#undef PG8_BAR
#undef PG8_SCHED
}
}

struct AttnP {
    const bf16_t* ZQ; const bf16_t* QM; const bf16_t* KVM; const bf16_t* KR; bf16_t* Y; bf16_t* ZQw; float* LSE;
    const float* LUTS; const float* LUTD; const float* rpb; const float* sink; const float* COS;
};
constexpr int A_VP = 144, A_LUT = 114688, A_WSF = A_LUT + 2048, A_END = A_WSF + 2048;

DI void glds16(const void* gsrc, unsigned lds_dst) { unsigned keep;
    asm volatile("s_mov_b32 %0, m0\n\ts_mov_b32 m0, %2\n\ts_nop 0\n\tglobal_load_lds_dwordx4 %1, off\n\ts_mov_b32 m0, %0" : "=&s"(keep) : "v"(gsrc), "s"(lds_dst) : "memory"); }
DI void glds16s(unsigned voff, const void* sbase, unsigned lds_dst) { unsigned keep;
    const unsigned long long sb = (unsigned long long)sbase;
    const unsigned blo = __builtin_amdgcn_readfirstlane((unsigned)sb), bhi = __builtin_amdgcn_readfirstlane((unsigned)(sb >> 32));
    const unsigned long long sbu = ((unsigned long long)bhi << 32) | blo;
    asm volatile("s_mov_b32 %0, m0\n\ts_mov_b32 m0, %3\n\ts_nop 0\n\tglobal_load_lds_dwordx4 %1, %2\n\ts_mov_b32 m0, %0" : "=&s"(keep) : "v"(voff), "s"(sbu), "s"(lds_dst) : "memory"); }
template <int VAR> DI void attn_unit(LAS unsigned char* lds, const AttnP& P, const int u, const int wave_s) {
    constexpr int NKS = (VAR == 0) ? 6 : 4, QB = (VAR == 0) ? 2 : 1, QPW = 32 * QB;
    constexpr int A_TK = (VAR == 0) ? 128 : (VAR == 1 ? 256 : 384), NBUF = (VAR == 0) ? 2 : 1, A_KP = (VAR == 0) ? 208 : 144, NLD = A_TK / 64;
    constexpr int A_KB = 0, A_VB = (VAR == 0) ? 2 * 24576 : NBUF * A_TK * A_KP;
    static_assert(A_VB + ((VAR == 0) ? 2 * 16384 : NBUF * A_TK * A_VP) <= A_LUT, "attention tiles vs LDS map");
    int tid_ = wave_s * 64 + lane_id(); asm volatile("" : "+v"(tid_));
    const int tid = tid_, lane = tid & 63, r32 = lane & 31, hi = lane >> 5, w = __builtin_amdgcn_readfirstlane(tid >> 6);
    LAS float* LUT = (LAS float*)(lds + A_LUT);
    LAS float* WSF = (LAS float*)(lds + A_WSF) + w * 64;
    int b, h, qt, g = 0, r = 1, res = 0, L = S, j0 = 0;
    if (VAR == 0) { qt = u & 15; h = (u >> 4) & 3; b = u >> 6; j0 = 512 * qt; }
    else if (VAR == 3) { qt = u & 31; h = (u >> 5) & 3; b = u / 384; g = (u >> 7) % 3; r = (g == 0) ? 1 : (g == 1 ? 4 : 16); L = S / r; const int tpr = 32 / r; res = qt / tpr; j0 = 256 * (qt % tpr); }
    else { qt = u & 31; h = (u >> 5) & 3; b = u >> 7; j0 = 256 * qt; }
    const size_t tb = (size_t)b * S;
    const int qw = j0 + QPW * w;
    const int na_row0 = 4 * qt + 2 * (w >> 2), na_col0 = 16 * (w & 3), na_cb = min(max(na_col0 - 8, 0), 32);
#define NA_TOK(qidx) ((na_row0 + ((qidx) >> 4)) * 64 + na_col0 + ((qidx) & 15))
    if (VAR == 1) { for (int i = tid; i < 257; i += 512) LUT[i] = P.LUTS[h * 260 + i]; }
    if (VAR == 2) { for (int i = tid; i < 465; i += 512) LUT[i] = P.rpb[h * 465 + i] * LOG2E; }
    if (VAR == 3) { for (int i = tid; i < 129; i += 512) LUT[i] = P.LUTD[(g * 4 + h) * 132 + i]; }
    bf16x8 qf[QB][NKS];
#pragma unroll
    for (int qb = 0; qb < QB; ++qb) {
        const int qi = (VAR == 2) ? NA_TOK(r32) : qw + 32 * qb + r32;
        const bf16_t* qp;
        if (VAR == 0) qp = P.QM + (tb + qi) * 384 + h * 96;
        else if (VAR == 1) qp = P.ZQ + (tb + qi) * ZC + C_BQ + h * 64;
        else if (VAR == 2) qp = P.ZQ + (tb + qi) * ZC + C_CQ + h * 64;
        else qp = P.ZQ + (tb + res + (size_t)r * qi) * ZC + C_DQ + g * 256 + h * 64;
#pragma unroll
        for (int ks = 0; ks < NKS; ++ks) qf[qb][ks] = *(const bf16x8*)(qp + 16 * ks + 8 * hi);
        if (VAR == 0) {
            const float* cp = P.COS + qi * 16 + 8 * hi; const float* sp = cp + S * 16;
            const f32x4 c0 = *(const f32x4*)cp, c1 = *(const f32x4*)(cp + 4), s0 = *(const f32x4*)sp, s1 = *(const f32x4*)(sp + 4);
            const u32x4 a4 = __builtin_bit_cast(u32x4, qf[qb][4]), a5 = __builtin_bit_cast(u32x4, qf[qb][5]);
            u32x4 o4, o5;
#define ROPE2(k, ca, cb, sa, sb) { const float x1l = bf_lo(a4[k]), x1h = bf_hi(a4[k]), x2l = bf_lo(a5[k]), x2h = bf_hi(a5[k]); \
                o4[k] = cvt_pk(x1l * ca - x2l * sa, x1h * cb - x2h * sb); o5[k] = cvt_pk(x1l * sa + x2l * ca, x1h * sb + x2h * cb); }
            ROPE2(0, c0[0], c0[1], s0[0], s0[1]) ROPE2(1, c0[2], c0[3], s0[2], s0[3]) ROPE2(2, c1[0], c1[1], s1[0], s1[1]) ROPE2(3, c1[2], c1[3], s1[2], s1[3])
#undef ROPE2
            qf[qb][4] = __builtin_bit_cast(bf16x8, o4); qf[qb][5] = __builtin_bit_cast(bf16x8, o5);
        }
    }
    int NT, kfirst;
    if (VAR == 0) { NT = S / A_TK; kfirst = 0; }
    else if (VAR == 1) { NT = 2; kfirst = j0 - 128; }
    else if (VAR == 2) { const int f = min(max(4 * qt - 4, 0), 120); NT = 2; kfirst = 64 * f; }
    else { NT = 1; kfirst = j0 - 64; }
    float m_run[QB], l_run[QB];
    f32x16 o[QB][2];
#pragma unroll
    for (int qb = 0; qb < QB; ++qb) {
        m_run[qb] = (VAR == 0) ? 0.f : -1e30f; l_run[qb] = 0.f;
        if (VAR == 1) { m_run[qb] = P.sink[h] * LOG2E; l_run[qb] = (hi == 0) ? 1.0f : 0.0f; }
#pragma unroll
        for (int i = 0; i < 16; ++i) { o[qb][0][i] = 0.f; o[qb][1][i] = 0.f; }
    }
    const float c2 = 0.125f * LOG2E;
    const int qrow = na_row0 + (r32 >> 4), qc = na_col0 + (r32 & 15);
    const int r0 = min(max(qrow - 4, 0), 120), cs = min(max(qc - 8, 0), 48);
    const int srow = tid >> 3, sch = tid & 7, srow2 = tid >> 2, sch2 = tid & 3;
    u32x4 kreg[NLD], vreg[NLD], rreg;
    auto load_tile = [&](int t) {
#pragma unroll
        for (int i = 0; i < NLD; ++i) {
            const int kidx = kfirst + A_TK * t + srow + 64 * i;
            if (VAR == 0) {
                const bf16_t* kp = P.KVM + (tb + kidx) * 512 + h * 128 + sch * 8;
                kreg[i] = *(const u32x4*)kp; vreg[i] = *(const u32x4*)(kp + 64);
            } else if (VAR == 1) {
                const int kc = min(max(kidx, 0), S - 1); const bf16_t* base = P.ZQ + (tb + kc) * ZC + (h >> 1) * 64 + sch * 8;
                kreg[i] = *(const u32x4*)(base + C_BK); vreg[i] = *(const u32x4*)(base + C_BV);
            } else if (VAR == 2) {
                const int kc = min(kidx, S - 1); const bf16_t* base = P.ZQ + (tb + kc) * ZC + h * 64 + sch * 8;
                kreg[i] = *(const u32x4*)(base + C_CK); vreg[i] = *(const u32x4*)(base + C_CV);
            } else {
                const int kc = min(max(kidx, 0), L - 1); const bf16_t* base = P.ZQ + (tb + res + (size_t)r * kc) * ZC + g * 256 + h * 64 + sch * 8;
                kreg[i] = *(const u32x4*)(base + C_DK); vreg[i] = *(const u32x4*)(base + C_DV);
            }
        }
        if (VAR == 0) rreg = *(const u32x4*)(P.KR + (tb + kfirst + A_TK * t + srow2) * 32 + sch2 * 8);
    };
    auto store_tile = [&](int buf) {
#pragma unroll
        for (int i = 0; i < NLD; ++i) {
            *(LAS u32x4*)(lds + A_KB + buf * A_TK * A_KP + (srow + 64 * i) * A_KP + sch * 16) = kreg[i];
            *(LAS u32x4*)(lds + A_VB + buf * A_TK * A_VP + (srow + 64 * i) * A_VP + sch * 16) = vreg[i];
        }
        if (VAR == 0) *(LAS u32x4*)(lds + A_KB + buf * A_TK * A_KP + srow2 * A_KP + 128 + sch2 * 16) = rreg;
    };
    const unsigned lds_base = (unsigned)(size_t)lds;
    const unsigned dl_k = (unsigned)((lane & 31) * 1024 + (lane >> 5) * 16), dl_r = (unsigned)((lane & 31) * 64 + (lane >> 5) * 16),
                   dl_v = (unsigned)((lane >> 3) * 1024 + (((lane & 7) ^ ((lane >> 3) & 7)) << 4));
    auto dma_tile = [&](int t, int buf) {
        const size_t krow0 = tb + kfirst + A_TK * t;
#pragma unroll
        for (int q = 0; q < 3; ++q) {
            const int i = w + 8 * q, sbk = i / 6, cp = i % 6;
            const unsigned dst = (unsigned)__builtin_amdgcn_readfirstlane((int)(lds_base + A_KB + buf * 24576 + (sbk * 12 + 2 * cp) * 512));
            if (cp < 4) glds16s(dl_k, P.KVM + (krow0 + 32 * sbk) * 512 + h * 128 + 16 * cp, dst);
            else        glds16s(dl_r, P.KR + (krow0 + 32 * sbk) * 32 + 16 * (cp - 4), dst);
        }
#pragma unroll
        for (int q = 0; q < 2; ++q) {
            const int j = w + 8 * q;
            glds16s(dl_v, P.KVM + (krow0 + 8 * j) * 512 + h * 128 + 64, (unsigned)__builtin_amdgcn_readfirstlane((int)(lds_base + A_VB + buf * 16384 + j * 1024)));
        }
    };
    if constexpr (VAR == 0) { dma_tile(0, 0); asm volatile("s_waitcnt vmcnt(0)" ::: "memory"); } else { load_tile(0); store_tile(0); }
    __syncthreads();
    const int tq = lane & 15, tq_q = tq >> 2, tq_p = tq & 3, blk = (lane >> 4) & 1;
    float mxt[QB];
    if (VAR == 0) {
#pragma unroll
        for (int qb = 0; qb < QB; ++qb) {
            f32x16 s0;
#pragma unroll
            for (int i = 0; i < 16; ++i) s0[i] = 0.f;
#pragma unroll
            for (int ks = 0; ks < NKS; ++ks) {
                const bf16x8 kf = *(LAS const bf16x8*)(lds + A_KB + ((2 * ks + hi) * 32 + r32) * 16);
                s0 = __builtin_amdgcn_mfma_f32_32x32x16_bf16(kf, qf[qb][ks], s0, 0, 0, 0);
            }
            float mx = s0[0];
#pragma unroll
            for (int i = 1; i < 16; ++i) mx = fmaxf(mx, s0[i]);
            m_run[qb] = xhalf_max(mx); mxt[qb] = -INFINITY;
        }
    }
    f32x16 negm;
#pragma unroll
    for (int i = 0; i < 16; ++i) negm[i] = -fmaxf(m_run[0], m_run[QB - 1]);
    auto mla_tile = [&](const int buf) {
#define SBAR0() __builtin_amdgcn_sched_barrier(0)
#define PINV(x) asm volatile("" : "+v"(x))
#define EX(v, i) v[i] = __builtin_amdgcn_exp2f(v[i])
            LAS const unsigned char* Kt = lds + A_KB + buf * 24576 + (hi * 32 + r32) * 16;
            LAS const unsigned char* Vt = lds + A_VB + buf * 16384 + (4 * hi + tq_q) * 128 + 8 * (tq_p & 1);
            const int vsw = (4 * hi + tq_q) & 7, vch = 2 * blk + (tq_p >> 1);
            f32x16 sc0 = negm, sc1 = negm, sn0, sn1;
#pragma unroll
            for (int ks = 0; ks < NKS; ++ks) {
                const bf16x8 kfx = *(LAS const bf16x8*)(Kt + 1024 * ks);
                sc0 = __builtin_amdgcn_mfma_f32_32x32x16_bf16(kfx, qf[0][ks], sc0, 0, 0, 0);
                sc1 = __builtin_amdgcn_mfma_f32_32x32x16_bf16(kfx, qf[1][ks], sc1, 0, 0, 0);
            }
            SBAR0();
#pragma unroll
            for (int sb = 0; sb < A_TK / 32; ++sb) {
                bf16x8 vf[2][2];
#pragma unroll
                for (int d0 = 0; d0 < 1; ++d0)
#pragma unroll
                    for (int ss = 0; ss < 2; ++ss) {
                        LAS const unsigned char* vp = Vt + (32 * sb + 16 * ss) * 128 + (((4 * d0 + vch) ^ vsw) << 4);
                        const s16x4 lo = __builtin_amdgcn_ds_read_tr16_b64_v4i16((LAS s16x4*)vp);
                        const s16x4 hh = __builtin_amdgcn_ds_read_tr16_b64_v4i16((LAS s16x4*)(vp + 8 * 128));
                        vf[d0][ss] = (bf16x8){lo[0], lo[1], lo[2], lo[3], hh[0], hh[1], hh[2], hh[3]};
                    }
                if (sb + 1 < A_TK / 32) {
                    LAS const unsigned char* Kn = Kt + (sb + 1) * 6144;
                    bf16x8 k0 = *(LAS const bf16x8*)(Kn), k1 = *(LAS const bf16x8*)(Kn + 1024), k2 = *(LAS const bf16x8*)(Kn + 2048);
                    SBAR0();
                    sn0 = __builtin_amdgcn_mfma_f32_32x32x16_bf16(k0, qf[0][0], negm, 0, 0, 0); EX(sc0, 0); EX(sc0, 1); EX(sc0, 2); PINV(sc0); SBAR0();
                    sn1 = __builtin_amdgcn_mfma_f32_32x32x16_bf16(k0, qf[1][0], negm, 0, 0, 0); EX(sc1, 0); EX(sc1, 1); EX(sc1, 2); PINV(sc1); SBAR0();
                    k0 = *(LAS const bf16x8*)(Kn + 3072);
                    sn0 = __builtin_amdgcn_mfma_f32_32x32x16_bf16(k1, qf[0][1], sn0, 0, 0, 0);  EX(sc0, 3); EX(sc0, 4); EX(sc0, 5); PINV(sc0); SBAR0();
                    sn1 = __builtin_amdgcn_mfma_f32_32x32x16_bf16(k1, qf[1][1], sn1, 0, 0, 0);  EX(sc1, 3); EX(sc1, 4); EX(sc1, 5); PINV(sc1); SBAR0();
                    k1 = *(LAS const bf16x8*)(Kn + 4096);
                    sn0 = __builtin_amdgcn_mfma_f32_32x32x16_bf16(k2, qf[0][2], sn0, 0, 0, 0);  EX(sc0, 6); EX(sc0, 7); EX(sc0, 8); PINV(sc0); SBAR0();
                    sn1 = __builtin_amdgcn_mfma_f32_32x32x16_bf16(k2, qf[1][2], sn1, 0, 0, 0);  EX(sc1, 6); EX(sc1, 7); EX(sc1, 8); PINV(sc1); SBAR0();
                    k2 = *(LAS const bf16x8*)(Kn + 5120);
                    sn0 = __builtin_amdgcn_mfma_f32_32x32x16_bf16(k0, qf[0][3], sn0, 0, 0, 0);  EX(sc0, 9); EX(sc0, 10); EX(sc0, 11); PINV(sc0); SBAR0();
                    sn1 = __builtin_amdgcn_mfma_f32_32x32x16_bf16(k0, qf[1][3], sn1, 0, 0, 0);  EX(sc1, 9); EX(sc1, 10); EX(sc1, 11); PINV(sc1); SBAR0();
                    sn0 = __builtin_amdgcn_mfma_f32_32x32x16_bf16(k1, qf[0][4], sn0, 0, 0, 0);  EX(sc0, 12); EX(sc0, 13); PINV(sc0); SBAR0();
                    sn1 = __builtin_amdgcn_mfma_f32_32x32x16_bf16(k1, qf[1][4], sn1, 0, 0, 0);  EX(sc1, 12); EX(sc1, 13); PINV(sc1); SBAR0();
                    sn0 = __builtin_amdgcn_mfma_f32_32x32x16_bf16(k2, qf[0][5], sn0, 0, 0, 0);  EX(sc0, 14); EX(sc0, 15); PINV(sc0); SBAR0();
                    sn1 = __builtin_amdgcn_mfma_f32_32x32x16_bf16(k2, qf[1][5], sn1, 0, 0, 0);  EX(sc1, 14); EX(sc1, 15); PINV(sc1); SBAR0();
                } else {
#pragma unroll
                    for (int i = 0; i < 16; ++i) { EX(sc0, i); EX(sc1, i); }
                    SBAR0();
                }
                u32x4 pa0, pa1, pb0, pb1;
                pa0.x = cvt_pk(sc0[0], sc0[1]); pa0.y = cvt_pk(sc0[2], sc0[3]); pa0.z = cvt_pk(sc0[4], sc0[5]); pa0.w = cvt_pk(sc0[6], sc0[7]);
                pa1.x = cvt_pk(sc0[8], sc0[9]); pa1.y = cvt_pk(sc0[10], sc0[11]); pa1.z = cvt_pk(sc0[12], sc0[13]); pa1.w = cvt_pk(sc0[14], sc0[15]);
                pb0.x = cvt_pk(sc1[0], sc1[1]); pb0.y = cvt_pk(sc1[2], sc1[3]); pb0.z = cvt_pk(sc1[4], sc1[5]); pb0.w = cvt_pk(sc1[6], sc1[7]);
                pb1.x = cvt_pk(sc1[8], sc1[9]); pb1.y = cvt_pk(sc1[10], sc1[11]); pb1.z = cvt_pk(sc1[12], sc1[13]); pb1.w = cvt_pk(sc1[14], sc1[15]);
                const bf16x8 pf00 = __builtin_bit_cast(bf16x8, pa0), pf01 = __builtin_bit_cast(bf16x8, pa1), pf10 = __builtin_bit_cast(bf16x8, pb0), pf11 = __builtin_bit_cast(bf16x8, pb1);
                float ps0 = l_run[0], ps1 = l_run[1];
#pragma unroll
                for (int d0 = 0; d0 < 2; ++d0)
#pragma unroll
                    for (int ss = 0; ss < 2; ++ss) {
                        bf16x8 vfx;
                        if (d0 == 0) vfx = vf[0][ss];
                        else { LAS const unsigned char* vp = Vt + (32 * sb + 16 * ss) * 128 + (((4 + vch) ^ vsw) << 4);
                               const s16x4 lo = __builtin_amdgcn_ds_read_tr16_b64_v4i16((LAS s16x4*)vp);
                               const s16x4 hh = __builtin_amdgcn_ds_read_tr16_b64_v4i16((LAS s16x4*)(vp + 8 * 128));
                               vfx = (bf16x8){lo[0], lo[1], lo[2], lo[3], hh[0], hh[1], hh[2], hh[3]}; }
                        o[0][d0] = __builtin_amdgcn_mfma_f32_32x32x16_bf16(ss == 0 ? pf00 : pf01, vfx, o[0][d0], 0, 0, 0);
                        o[1][d0] = __builtin_amdgcn_mfma_f32_32x32x16_bf16(ss == 0 ? pf10 : pf11, vfx, o[1][d0], 0, 0, 0);
                        const int q4 = 4 * (2 * d0 + ss);
                        ps0 += sc0[q4]; ps0 += sc0[q4 + 1]; ps0 += sc0[q4 + 2]; ps0 += sc0[q4 + 3];
                        ps1 += sc1[q4]; ps1 += sc1[q4 + 1]; ps1 += sc1[q4 + 2]; ps1 += sc1[q4 + 3];
                    }
                l_run[0] = ps0; l_run[1] = ps1;
                if (sb + 1 < A_TK / 32) { sc0 = sn0; sc1 = sn1; }
                SBAR0();
            }
#undef SBAR0
#undef PINV
#undef EX
            if (__any(fmaxf(l_run[0], l_run[1]) > 1.8446744e19f)) {
                const float dn = 5.421010862427522e-20f;
                l_run[0] *= dn; l_run[1] *= dn;
#pragma unroll
                for (int i = 0; i < 16; ++i) { o[0][0][i] *= dn; o[0][1][i] *= dn; o[1][0][i] *= dn; o[1][1][i] *= dn; negm[i] -= 64.0f; }
            }
    };
#define LDS_BAR() asm volatile("s_waitcnt lgkmcnt(0)\n\ts_barrier" ::: "memory")
    if constexpr (VAR == 0) {
        for (int t = 0; t < NT; ++t) {
            if (t + 1 < NT) dma_tile(t + 1, (t + 1) & 1);
            mla_tile(t & 1);
            asm volatile("s_waitcnt vmcnt(0)" ::: "memory");
            LDS_BAR();
        }
    } else
    for (int t = 0; t < NT; ++t) {
        if (t + 1 < NT) load_tile(t + 1);
        const int buf = (NBUF == 2) ? (t & 1) : 0;
        if constexpr (VAR == 0) { mla_tile(buf); } else
#pragma unroll 2
        for (int sb = 0; sb < ((VAR == 2) ? A_TK / 64 : A_TK / 32); ++sb) {
            const int sub_off = (VAR == 2) ? 64 * sb + na_cb : 32 * sb;
            const int kb = kfirst + A_TK * t + sub_off;
            bool act = true;
            if (VAR == 1) act = (kb + 31 >= max(qw - 128, 0)) && (kb <= min(qw + 159, S - 1));
            if (VAR == 2) { const int kr = kb >> 6; act = (kr >= min(max(na_row0 - 4, 0), 120)) && (kr < min(max(na_row0 - 3, 0), 120) + 8); }
            if (VAR == 3) act = (kb + 31 >= max(qw - 64, 0)) && (kb <= min(qw + 95, L - 1));
            if (!act) continue;
            LAS const unsigned char* Kb = lds + A_KB + buf * A_TK * A_KP + sub_off * A_KP;
            LAS const unsigned char* Vb = lds + A_VB + buf * A_TK * A_VP + sub_off * A_VP;
            f32x16 s[QB];
#pragma unroll
            for (int qb = 0; qb < QB; ++qb)
#pragma unroll
                for (int i = 0; i < 16; ++i) s[qb][i] = (VAR == 0) ? -m_run[qb] : 0.f;
#pragma unroll
            for (int ks = 0; ks < NKS; ++ks) {
                const bf16x8 kf = *(LAS const bf16x8*)(Kb + r32 * A_KP + (16 * ks + 8 * hi) * 2);
#pragma unroll
                for (int qb = 0; qb < QB; ++qb) s[qb] = __builtin_amdgcn_mfma_f32_32x32x16_bf16(kf, qf[qb][ks], s[qb], 0, 0, 0);
            }
            bf16x8 pf[QB][2];
#pragma unroll
            for (int qb = 0; qb < QB; ++qb) {
                if (VAR == 1 || VAR == 3) {
                    const int HALFW = (VAR == 1) ? 128 : 64, LL = (VAR == 1) ? S : L;
                    const int qpos = qw + r32;
                    const bool full = (kb - qw - 31 >= -HALFW) && (kb - qw + 31 <= HALFW) && (kb >= 0) && (kb + 31 < LL);
                    if (full) {
                        LAS const float* lp = LUT + (kb - qpos + HALFW) + 4 * hi;
#pragma unroll
                        for (int i = 0; i < 16; ++i) s[qb][i] = s[qb][i] * c2 + lp[(i & 3) + 8 * (i >> 2)];
                    } else {
#pragma unroll
                    for (int i = 0; i < 16; ++i) {
                        const int kp = kb + crow(i, hi), rel = kp - qpos;
                        const bool ok = (rel >= -HALFW) && (rel <= HALFW) && (kp >= 0) && (kp < LL);
                        const int idx = min(max(rel + HALFW, 0), 2 * HALFW);
                        s[qb][i] = ok ? (s[qb][i] * c2 + LUT[idx]) : -INFINITY;
                    }
                    }
                }
                if (VAR == 2) {
                    const int kr_ = kb >> 6; const bool rowok = (kr_ >= r0) && (kr_ < r0 + 8); const int dr = min(max(kr_ - qrow + 7, 0), 14);
#pragma unroll
                    for (int i = 0; i < 16; ++i) {
                        const int ck = (kb & 63) + crow(i, hi), d = ck - qc;
                        const bool ok = rowok && (ck >= cs) && (ck < cs + 16);
                        const int idx = dr * 31 + min(max(d + 15, 0), 30);
                        s[qb][i] = ok ? (s[qb][i] * c2 + LUT[idx]) : -INFINITY;
                    }
                }
                float mx = s[qb][0];
#pragma unroll
                for (int i = 1; i < 16; ++i) mx = fmaxf(mx, s[qb][i]);
                if (VAR == 0) mxt[qb] = fmaxf(mxt[qb], mx);
                else {
                mx = xhalf_max(mx);
                const float mnew = fmaxf(m_run[qb], mx);
                if (__any(mnew != m_run[qb])) {
                    const float al = __builtin_amdgcn_exp2f(m_run[qb] - mnew);
                    l_run[qb] *= al; m_run[qb] = mnew;
                    if (hi == 0) WSF[32 * qb + r32] = al;
                    __builtin_amdgcn_fence(__ATOMIC_RELEASE, "wavefront"); __builtin_amdgcn_wave_barrier(); __builtin_amdgcn_fence(__ATOMIC_ACQUIRE, "wavefront");
#pragma unroll
                    for (int i = 0; i < 16; ++i) { const float al2 = WSF[32 * qb + crow(i, hi)]; o[qb][0][i] *= al2; o[qb][1][i] *= al2; }
                    __builtin_amdgcn_fence(__ATOMIC_RELEASE, "wavefront"); __builtin_amdgcn_wave_barrier(); __builtin_amdgcn_fence(__ATOMIC_ACQUIRE, "wavefront");
                }
                }
                float ps = 0.f;
#pragma unroll
                for (int i = 0; i < 16; ++i) { s[qb][i] = __builtin_amdgcn_exp2f((VAR == 0) ? s[qb][i] : s[qb][i] - m_run[qb]); ps += s[qb][i]; }
                l_run[qb] += ps;
                u32x4 pw0, pw1;
                pw0.x = cvt_pk(s[qb][0], s[qb][1]); pw0.y = cvt_pk(s[qb][2], s[qb][3]); pw0.z = cvt_pk(s[qb][4], s[qb][5]); pw0.w = cvt_pk(s[qb][6], s[qb][7]);
                pw1.x = cvt_pk(s[qb][8], s[qb][9]); pw1.y = cvt_pk(s[qb][10], s[qb][11]); pw1.z = cvt_pk(s[qb][12], s[qb][13]); pw1.w = cvt_pk(s[qb][14], s[qb][15]);
                pf[qb][0] = __builtin_bit_cast(bf16x8, pw0); pf[qb][1] = __builtin_bit_cast(bf16x8, pw1);
            }
#pragma unroll
            for (int d0 = 0; d0 < 2; ++d0) {
#pragma unroll
                for (int ss = 0; ss < 2; ++ss) {
                    LAS const unsigned char* vp = Vb + (16 * ss + 4 * hi + tq_q) * A_VP + (32 * d0 + 16 * blk + 4 * tq_p) * 2;
                    const s16x4 lo = __builtin_amdgcn_ds_read_tr16_b64_v4i16((LAS s16x4*)vp);
                    const s16x4 hh = __builtin_amdgcn_ds_read_tr16_b64_v4i16((LAS s16x4*)(vp + 8 * A_VP));
                    const bf16x8 vf = (bf16x8){lo[0], lo[1], lo[2], lo[3], hh[0], hh[1], hh[2], hh[3]};
#pragma unroll
                    for (int qb = 0; qb < QB; ++qb) o[qb][d0] = __builtin_amdgcn_mfma_f32_32x32x16_bf16(pf[qb][ss], vf, o[qb][d0], 0, 0, 0);
                }
            }
        }
        if (VAR == 0) {
#pragma unroll
            for (int qb = 0; qb < QB; ++qb) {
                if (__any(mxt[qb] > 64.0f)) {
                    const float dl = fmaxf(xhalf_max(mxt[qb]), 0.f), al = __builtin_amdgcn_exp2f(-dl);
                    l_run[qb] *= al; m_run[qb] += dl;
                    if (hi == 0) WSF[32 * qb + r32] = al;
                    __builtin_amdgcn_fence(__ATOMIC_RELEASE, "wavefront"); __builtin_amdgcn_wave_barrier(); __builtin_amdgcn_fence(__ATOMIC_ACQUIRE, "wavefront");
#pragma unroll
                    for (int i = 0; i < 16; ++i) { const float al2 = WSF[32 * qb + crow(i, hi)]; o[qb][0][i] *= al2; o[qb][1][i] *= al2; }
                    __builtin_amdgcn_fence(__ATOMIC_RELEASE, "wavefront"); __builtin_amdgcn_wave_barrier(); __builtin_amdgcn_fence(__ATOMIC_ACQUIRE, "wavefront");
                }
                mxt[qb] = -INFINITY;
            }
        }
        if (NBUF == 2) { if (t + 1 < NT) store_tile((t + 1) & 1); }
        else if (t + 1 < NT) { __syncthreads(); store_tile(0); }
        __syncthreads();
    }
#pragma unroll
    for (int qb = 0; qb < QB; ++qb) {
        const float lt = xhalf_sum(l_run[qb]);
        if (hi == 0) WSF[32 * qb + r32] = 1.0f / lt;
        if (VAR == 3) { if (hi == 0) P.LSE[(tb + res + (size_t)r * (qw + r32)) * 12 + g * 4 + h] = m_run[qb] + __builtin_amdgcn_logf(lt); }
    }
    __builtin_amdgcn_fence(__ATOMIC_RELEASE, "wavefront"); __builtin_amdgcn_wave_barrier(); __builtin_amdgcn_fence(__ATOMIC_ACQUIRE, "wavefront");
#pragma unroll
    for (int qb = 0; qb < QB; ++qb) {
#pragma unroll
        for (int i = 0; i < 16; ++i) {
            const int qi = (VAR == 2) ? NA_TOK(crow(i, hi)) : qw + 32 * qb + crow(i, hi); const float al = WSF[32 * qb + crow(i, hi)];
            bf16_t* op;
            if (VAR == 3) op = P.ZQw + (tb + res + (size_t)r * qi) * ZC + C_DQ + g * 256 + h * 64;
            else op = P.Y + (tb + qi) * DM + VAR * 256 + h * 64;
            const unsigned a0 = cvt_pk(o[qb][0][i] * al, 0.f), a1 = cvt_pk(o[qb][1][i] * al, 0.f);
            op[r32] = (bf16_t)(a0 & 0xffffu); op[32 + r32] = (bf16_t)(a1 & 0xffffu);
        }
    }
    __syncthreads();
}

DI int t5_bucket(int rel) {
    const int n = rel < 0 ? -rel : rel;
    const int v = n < 8 ? n : 8 + (n >= 15) + (n >= 27) + (n >= 50) + (n >= 91) + (n >= 166) + (n >= 305) + (n >= 559);
    return (rel > 0 ? 16 : 0) + v;
}
DI void transpose_item(const float* W, int ldw, int coff, const float* kscale, bf16_t* WT, int ldt, LAS float* scr, int kb, int nb, int lane) {
    const int k0 = 64 * kb, n0 = 32 * nb;
    const int rr = lane >> 3, c4 = 4 * (lane & 7);
    f32x4 v[8];
#pragma unroll
    for (int i = 0; i < 8; ++i) v[i] = *(const f32x4*)(W + (size_t)(k0 + 8 * i + rr) * ldw + coff + n0 + c4);
#pragma unroll
    for (int i = 0; i < 8; ++i) {
        const int kk = 8 * i + rr; f32x4 x = v[i];
        if (kscale) x = x * kscale[k0 + kk];
        LAS float* d = scr + kk * 33 + c4; d[0] = x.x; d[1] = x.y; d[2] = x.z; d[3] = x.w;
    }
    __builtin_amdgcn_fence(__ATOMIC_RELEASE, "wavefront"); __builtin_amdgcn_wave_barrier(); __builtin_amdgcn_fence(__ATOMIC_ACQUIRE, "wavefront");
    const int c = lane & 7;
#pragma unroll
    for (int j = 0; j < 4; ++j) { const int n = (lane >> 3) + 8 * j; const LAS float* s = scr + (8 * c) * 33 + n;
        u32x4 o; o.x = cvt_pk(s[0 * 33], s[1 * 33]); o.y = cvt_pk(s[2 * 33], s[3 * 33]); o.z = cvt_pk(s[4 * 33], s[5 * 33]); o.w = cvt_pk(s[6 * 33], s[7 * 33]);
        *(u32x4*)(WT + (size_t)(n0 + n) * ldt + k0 + 8 * c) = o; }
    __builtin_amdgcn_fence(__ATOMIC_RELEASE, "wavefront"); __builtin_amdgcn_wave_barrier(); __builtin_amdgcn_fence(__ATOMIC_ACQUIRE, "wavefront");
}
DI void transpose_mat(const float* W, int K, int N, int ldw, int coff, const float* kscale, bf16_t* WT, int ldt, LAS float* scr, int gw, int NGW, int lane) {
    const int nblk = N / 32, items = (K / 64) * nblk;
    for (int it = gw; it < items; it += NGW) transpose_item(W, ldw, coff, kscale, WT, ldt, scr, it / nblk, it % nblk, lane);
}
template <int RN> DI void ln_rows(const float* in, float* outf, bf16_t* outb, float* stat, const float* gam, const float* bet, int lane) {
    f32x4 v[RN][4]; float mean[RN], rstd[RN];
#pragma unroll
    for (int r = 0; r < RN; ++r)
#pragma unroll
        for (int j = 0; j < 4; ++j) v[r][j] = ((const f32x4*)(in + (size_t)r * DM))[lane + 64 * j];
#pragma unroll
    for (int r = 0; r < RN; ++r) { float s = 0.f;
#pragma unroll
        for (int j = 0; j < 4; ++j) s += (v[r][j].x + v[r][j].y) + (v[r][j].z + v[r][j].w);
        mean[r] = s; }
#pragma unroll
    for (int r = 0; r < RN; ++r) mean[r] = wave_sum(mean[r]);
#pragma unroll
    for (int r = 0; r < RN; ++r) { mean[r] *= (1.f / DM); float s2 = 0.f;
#pragma unroll
        for (int j = 0; j < 4; ++j) { v[r][j] = v[r][j] - mean[r]; s2 += (v[r][j].x * v[r][j].x + v[r][j].y * v[r][j].y) + (v[r][j].z * v[r][j].z + v[r][j].w * v[r][j].w); }
        rstd[r] = s2; }
#pragma unroll
    for (int r = 0; r < RN; ++r) rstd[r] = wave_sum(rstd[r]);
#pragma unroll
    for (int r = 0; r < RN; ++r) { rstd[r] = 1.0f / sqrtf(rstd[r] * (1.f / DM) + 1e-5f); if (stat && lane == 0) { stat[2 * r] = mean[r]; stat[2 * r + 1] = rstd[r]; } }
#pragma unroll
    for (int j = 0; j < 4; ++j) {
        const f32x4 gg = ((const f32x4*)gam)[lane + 64 * j], bb = ((const f32x4*)bet)[lane + 64 * j];
#pragma unroll
        for (int r = 0; r < RN; ++r) {
            const f32x4 y = v[r][j] * rstd[r] * gg + bb;
            if (outf) ((f32x4*)(outf + (size_t)r * DM))[lane + 64 * j] = y;
            if (outb) { u32x2 w2; w2.x = cvt_pk(y.x, y.y); w2.y = cvt_pk(y.z, y.w); ((u32x2*)(outb + (size_t)r * DM))[lane + 64 * j] = w2; }
        }
    }
}

#define XB_TMO      128
#define XB_XCNT(j)  (256  + 64 * (j))
#define XB_XSUB(j)  (1280 + 64 * (j))
#define XB_XGEN(j)  (2304 + 64 * (j))
#define XB_TOP      3328
#define XB_TOPGEN   3392
#define XCD_BAR_WORDS 3456
#define XB_SPIN_CAP (1u << 20)
DI unsigned xb_ld(unsigned* p)              { return __hip_atomic_load(p, __ATOMIC_RELAXED, __HIP_MEMORY_SCOPE_AGENT); }
DI unsigned xb_add(unsigned* p, unsigned v) { return __hip_atomic_fetch_add(p, v, __ATOMIC_RELAXED, __HIP_MEMORY_SCOPE_AGENT); }
DI unsigned xb_xcc_id() { return (unsigned)__builtin_amdgcn_s_getreg((3 << 11) | 20) & 0xFu; }
#define XB_SPIN(cond, bar) do { unsigned _sp = 0; while (cond) { __builtin_amdgcn_s_sleep(1); \
    if ((++_sp & 255u) == 0u) { if (xb_ld(&(bar)[XB_TMO])) break; if (_sp > XB_SPIN_CAP) { atomicAdd(&(bar)[XB_TMO], 1u); break; } } } } while (0)
DI void xcd_barrier_complete(unsigned* bar, unsigned x, unsigned& nloc, unsigned& nx) {
    const unsigned G = gridDim.x;
    unsigned sum, cnt, mine, sp = 0u;
    for (;;) {
        sum = 0u; cnt = 0u; mine = 0u;
#pragma unroll
        for (unsigned j = 0; j < 16; ++j) { const unsigned c = xb_ld(&bar[XB_XCNT(j)]); sum += c; cnt += (c > 0u) ? 1u : 0u; mine = (j == x) ? c : mine; }
        if (sum == G) break;
        __builtin_amdgcn_s_sleep(1);
        if ((++sp & 255u) == 0u) { if (xb_ld(&bar[XB_TMO])) break; if (sp > XB_SPIN_CAP) { atomicAdd(&bar[XB_TMO], 1u); break; } }
    }
    nloc = mine > 0u ? mine : 1u; nx = cnt > 0u ? cnt : 1u;
}
DI void xcd_barrier(unsigned* bar, volatile LAS unsigned* st, bool leader) {
    asm volatile("s_waitcnt vmcnt(0)" ::: "memory");
    __syncthreads();
    if (leader) {
        const unsigned x = xb_xcc_id();
        __builtin_amdgcn_s_waitcnt(0);
        unsigned nloc = st[0], nx = st[1];
        if (nloc == 0u) { xcd_barrier_complete(bar, x, nloc, nx); st[0] = nloc; st[1] = nx; }
        const unsigned old = xb_add(&bar[XB_XSUB(x)], 1u);
        const unsigned gen = old / nloc;
        if (old + 1u == (gen + 1u) * nloc) {
            __builtin_amdgcn_fence(__ATOMIC_RELEASE, "agent");
            asm volatile("s_waitcnt vmcnt(0)" ::: "memory");
            const unsigned og = xb_add(&bar[XB_TOP], 1u);
            const unsigned tg = og / nx;
            if (og + 1u == (tg + 1u) * nx) xb_add(&bar[XB_TOPGEN], 1u);
            else XB_SPIN(xb_ld(&bar[XB_TOPGEN]) == tg, bar);
            __builtin_amdgcn_fence(__ATOMIC_ACQUIRE, "agent");
            xb_add(&bar[XB_XGEN(x)], 1u);
            asm volatile("s_waitcnt vmcnt(0)" ::: "memory");
        } else {
            XB_SPIN(xb_ld(&bar[XB_XGEN(x)]) == gen, bar);
            __builtin_amdgcn_fence(__ATOMIC_ACQUIRE, "agent");
            asm volatile("s_waitcnt vmcnt(0)" ::: "memory");
        }
    }
    __syncthreads();
}

struct Args { const float* in[22]; float* out; unsigned char* ws; int ph_lo, ph_hi; };
constexpr int PH_PER_LAYER = 11, N_PHASES = 1 + NL * PH_PER_LAYER;
constexpr int TAB_OFF = 131072 + 2048;
typedef volatile LAS unsigned long long* tab_t;
DI unsigned long long tab_get(tab_t TAB, int i) {
    const unsigned long long v = TAB[i];
    const unsigned lo = __builtin_amdgcn_readfirstlane((unsigned)v), hi = __builtin_amdgcn_readfirstlane((unsigned)(v >> 32));
    return ((unsigned long long)hi << 32) | lo;
}
#define TABF(i) ((const float*)tab_get(TAB, (i)))
#define TABWS() ((unsigned char*)tab_get(TAB, 23))
#define TABOUT() ((float*)tab_get(TAB, 22))

DI int opaque_s(int v) { asm volatile("" : "+s"(v)); return v; }
DI void conv_layer(tab_t TAB, LAS unsigned char* lds, int l, int gw, int NGW, int gt, int NGT, int wave, int lane) {
    unsigned char* ws = TABWS();
    bf16_t* Wqkv_t = (bf16_t*)(ws + W_QKV); bf16_t* Wuq_t = (bf16_t*)(ws + W_UQ); bf16_t* Wukv_t = (bf16_t*)(ws + W_UKV);
    LAS float* scr = (LAS float*)(lds + wave * 8704);
    { const float* win = TABF(5) + (size_t)l * DM * INC;
      transpose_mat(win, DM, 4000, INC, 0, nullptr, Wqkv_t, DM, scr, gw, NGW, lane);
      transpose_mat(win, DM, 4096, INC, C_G, nullptr, (bf16_t*)(ws + W_G), DM, scr, gw, NGW, lane); }
    transpose_mat(TABF(16) + (size_t)l * DM * FF, DM, FF, FF, 0, nullptr, (bf16_t*)(ws + W_FF1), DM, scr, gw, NGW, lane);
    transpose_mat(TABF(17) + (size_t)l * FF * DM, FF, DM, DM, 0, nullptr, (bf16_t*)(ws + W_FF2), FF, scr, gw, NGW, lane);
    for (int n = 0; n < 4; ++n) transpose_mat(TABF(12) + ((size_t)l * 4 + n) * 256 * DM, 256, DM, DM, 0, nullptr, (bf16_t*)(ws + W_B) + (size_t)n * DM * 256, 256, scr, gw, NGW, lane);
    transpose_mat(TABF(13) + (size_t)l * DM * DM, DM, DM, DM, 0, nullptr, (bf16_t*)(ws + W_OUT), DM, scr, gw, NGW, lane);
    transpose_mat(TABF(19) + (size_t)l * DM * DM, DM, DM, DM, 0, nullptr, (bf16_t*)(ws + W_PG), DM, scr, gw, NGW, lane);
    transpose_mat(TABF(18) + (size_t)l * 256 * DM, 256, DM, DM, 0, nullptr, (bf16_t*)(ws + W_PLE), 256, scr, gw, NGW, lane);
    transpose_mat(TABF(7) + (size_t)l * 256 * 384, 256, 384, 384, 0, TABF(6) + l * 256, Wuq_t, 256, scr, gw, NGW, lane);
    transpose_mat(TABF(9) + (size_t)l * 128 * 512, 128, 512, 512, 0, TABF(8) + l * 128, Wukv_t, 256, scr, gw, NGW, lane);
    for (int i = gt; i < 96 * DM / 2; i += NGT) ((unsigned*)(Wqkv_t + (size_t)4000 * DM))[i] = 0u;
    for (int i = gt; i < 128 * 256 / 2; i += NGT) ((unsigned*)(Wuq_t + (size_t)384 * 256))[i] = 0u;
    for (int i = gt; i < 512 * 64; i += NGT) { const int rr = i >> 6, cc = i & 63; ((unsigned*)(Wukv_t + (size_t)rr * 256 + 128))[cc] = 0u; }
    const float* pl = TABF(1) + (size_t)l * T * 256; bf16_t* PB = (bf16_t*)(ws + WS_PB);
    for (int i = gt; i < T * 256 / 8; i += NGT) {
        const f32x4 v0 = ((const f32x4*)pl)[2 * i], v1 = ((const f32x4*)pl)[2 * i + 1];
        u32x4 o; o.x = cvt_pk(v0.x, v0.y); o.y = cvt_pk(v0.z, v0.w); o.z = cvt_pk(v1.x, v1.y); o.w = cvt_pk(v1.z, v1.w);
        ((u32x4*)PB)[i] = o;
    }
}

__global__ void __launch_bounds__(512) fwd_kernel(Args a) {
    extern __shared__ __attribute__((aligned(16))) unsigned char lds_raw[];
    LAS unsigned char* lds = (LAS unsigned char*)lds_raw;
    cg::grid_group grid = cg::this_grid();
    tab_t TAB = (tab_t)(lds + TAB_OFF);
    if (threadIdx.x == 0) {
#pragma unroll
        for (int i = 0; i < 22; ++i) TAB[i] = (unsigned long long)a.in[i];
        TAB[22] = (unsigned long long)a.out; TAB[23] = (unsigned long long)a.ws;
    }
    volatile LAS unsigned* BST = (volatile LAS unsigned*)(lds + TAB_OFF + 256);
    if (threadIdx.x < 2) BST[threadIdx.x] = 0u;
    if (blockIdx.x == 0) { unsigned* bw = (unsigned*)a.ws; for (int i = threadIdx.x; i < XCD_BAR_WORDS; i += 512) bw[i] = 0u; }
    __syncthreads();
    const int ph_lo = a.ph_lo, ph_hi = a.ph_hi;
    const int wave_s = __builtin_amdgcn_readfirstlane((int)threadIdx.x >> 6);
#define TIDS int tid_ = wave_s * 64 + lane_id(); asm volatile("" : "+v"(tid_)); const int tid = tid_, lane = tid & 63, wave = __builtin_amdgcn_readfirstlane(tid >> 6); int G_ = gridDim.x, bid_ = blockIdx.x; asm volatile("" : "+s"(G_), "+s"(bid_)); const int G = G_, bid = bid_; \
             const int gw = bid * 8 + wave, NGW = G * 8; const int gt = bid * 512 + tid, NGT = G * 512; (void)lane; (void)gw; (void)NGW; (void)gt; (void)NGT; (void)wave;
#define GRIDX opaque_s((int)gridDim.x)
#define BIDX opaque_s((int)blockIdx.x)
#define PHASE(k) asm volatile("" ::: "memory"); if (ph_lo <= (k) && (k) < ph_hi)
#define SEAM0(k) do { if (ph_lo <= (k) && (k) + 1 < ph_hi) { grid.sync(); if (wave_s == 0 && lane_id() == 0) (void)xb_add(&((unsigned*)TABWS())[XB_XCNT(xb_xcc_id())], 1u); } } while (0)
#define SEAM(k) do { if (ph_lo <= (k) && (k) + 1 < ph_hi) xcd_barrier((unsigned*)TABWS(), BST, wave_s == 0 && lane_id() == 0); } while (0)

    PHASE(0) {
        TIDS
        conv_layer(TAB, lds, 0, gw, NGW, gt, NGT, wave, lane);
        unsigned char* ws = TABWS();
        float* COS = (float*)(ws + WS_ROPE); float* SIN = COS + S * 16;
        for (int i = gt; i < S * 16; i += NGT) {
            const int pos = i >> 4, f = i & 15;
            const double b4 = (f & 3) == 0 ? 1.0 : ((f & 3) == 1 ? 0.5623413251903491 : ((f & 3) == 2 ? 0.31622776601683794 : 0.1778279410038923));
            const double p10 = (f >> 2) == 0 ? 1.0 : ((f >> 2) == 1 ? 0.1 : ((f >> 2) == 2 ? 0.01 : 0.001));
            const float inv = (float)(b4 * p10);
            const float ang = (float)pos * inv;
            double rev = (double)ang * 0.15915494309189535; rev -= floor(rev);
            COS[i] = __builtin_amdgcn_cosf((float)rev); SIN[i] = __builtin_amdgcn_sinf((float)rev);
        }
        const float* rel_bias = TABF(4); float* LUTS = (float*)(ws + WS_LUTS); float* LUTD = (float*)(ws + WS_LUTD);
        for (int i = gt; i < 4 * 257; i += NGT) { const int hh = i / 257, rl = i % 257 - 128; LUTS[hh * 260 + rl + 128] = rel_bias[t5_bucket(rl) * 16 + hh] * LOG2E; }
        for (int i = gt; i < 12 * 129; i += NGT) { const int gh = i / 129, rl = i % 129 - 64, gg = gh >> 2; const int rr = gg == 0 ? 1 : (gg == 1 ? 4 : 16);
            LUTD[gh * 132 + rl + 64] = rel_bias[t5_bucket(rl * rr) * 16 + 4 + gh] * LOG2E; }
        const float* x = TABF(0); float* H = TABOUT(); bf16_t* HB = (bf16_t*)(ws + WS_HB); const float* eg = TABF(2); const float* eb = TABF(3);
        float* ST = (float*)(ws + WS_STATS); (void)H;
        for (int m = gw * 8; m < T; m += NGW * 8) ln_rows<8>(x + (size_t)m * DM, nullptr, HB + (size_t)m * DM, ST + (size_t)m * 2, eg, eb, lane);
    }
    SEAM0(0);

    for (int l = 0; l < NL; ++l) {
        const int P0 = 1 + l * PH_PER_LAYER;
        PHASE(P0 + 0) {
            unsigned char* ws = TABWS();
            pg8::Gemm g{(const bf16_t*)(ws + WS_HB), (const bf16_t*)(ws + W_QKV), DM, DM}; pg8::StaticOrder so; so.init(T, ZC, GRIDX, BIDX);
            pg8::EpiStore<0> E{(bf16_t*)(ws + WS_Z), ZC, ZC, nullptr, 0, 1.0f};
            pg8::gemm_phase(lds, g, so, E, wave_s);
        }
        SEAM(P0 + 0);
        PHASE(P0 + 1) {
            { TIDS
              unsigned char* ws = TABWS();
              const bf16_t* ZQ = (const bf16_t*)(ws + WS_Z); float* RSTD = (float*)(ws + WS_RSTD); bf16_t* KR = (bf16_t*)(ws + WS_KR);
              const float* COS = (const float*)(ws + WS_ROPE); const float* SIN = COS + S * 16;
              pg8::StaticOrder so; so.init(T, 512, G, bid); pg8::Unit uu;
              for (int i = 0; so.tile(i, uu); ++i) {
                  const int ch = lane & 7;
#pragma unroll 1
                  for (int it = 0; it < 4; ++it) {
                      const int m = uu.pm * 256 + wave * 32 + it * 8 + (lane >> 3);
                      const bf16_t* zr = ZQ + (size_t)m * ZC;
                      float sq = 0.f, sk = 0.f;
#pragma unroll
                      for (int j = 0; j < 4; ++j) { const u32x4 q = *(const u32x4*)(zr + C_AQ + ch * 32 + 8 * j);
                          sq += bf_lo(q.x) * bf_lo(q.x) + bf_hi(q.x) * bf_hi(q.x) + bf_lo(q.y) * bf_lo(q.y) + bf_hi(q.y) * bf_hi(q.y)
                              + bf_lo(q.z) * bf_lo(q.z) + bf_hi(q.z) * bf_hi(q.z) + bf_lo(q.w) * bf_lo(q.w) + bf_hi(q.w) * bf_hi(q.w); }
#pragma unroll
                      for (int j = 0; j < 2; ++j) { const u32x4 q = *(const u32x4*)(zr + C_AKV + ch * 16 + 8 * j);
                          sk += bf_lo(q.x) * bf_lo(q.x) + bf_hi(q.x) * bf_hi(q.x) + bf_lo(q.y) * bf_lo(q.y) + bf_hi(q.y) * bf_hi(q.y)
                              + bf_lo(q.z) * bf_lo(q.z) + bf_hi(q.z) * bf_hi(q.z) + bf_lo(q.w) * bf_lo(q.w) + bf_hi(q.w) * bf_hi(q.w); }
                      sq += shx<1>(sq); sk += shx<1>(sk); sq += shx<2>(sq); sk += shx<2>(sk); sq += shx<4>(sq); sk += shx<4>(sk);
                      if (ch == 0) { RSTD[(size_t)m * 2] = 1.0f / sqrtf(sq * (1.f / 256.f) + 1e-6f); RSTD[(size_t)m * 2 + 1] = 1.0f / sqrtf(sk * (1.f / 128.f) + 1e-6f); }
                      if (ch < 4 && uu.pn == 0) {
                          const int pos = m & (S - 1);
                          const u32x2 a1 = *(const u32x2*)(zr + C_AKR + 4 * ch), a2 = *(const u32x2*)(zr + C_AKR + 16 + 4 * ch);
                          const f32x4 c = *(const f32x4*)(COS + pos * 16 + 4 * ch), sn = *(const f32x4*)(SIN + pos * 16 + 4 * ch);
                          const float x10 = bf_lo(a1.x), x11 = bf_hi(a1.x), x12 = bf_lo(a1.y), x13 = bf_hi(a1.y), x20 = bf_lo(a2.x), x21 = bf_hi(a2.x), x22 = bf_lo(a2.y), x23 = bf_hi(a2.y);
                          u32x2 o1, o2;
                          o1.x = cvt_pk(x10 * c.x - x20 * sn.x, x11 * c.y - x21 * sn.y); o1.y = cvt_pk(x12 * c.z - x22 * sn.z, x13 * c.w - x23 * sn.w);
                          o2.x = cvt_pk(x10 * sn.x + x20 * c.x, x11 * sn.y + x21 * c.y); o2.y = cvt_pk(x12 * sn.z + x22 * c.z, x13 * sn.w + x23 * c.w);
                          *(u32x2*)(KR + (size_t)m * 32 + 4 * ch) = o1; *(u32x2*)(KR + (size_t)m * 32 + 16 + 4 * ch) = o2;
                      }
                  }
              }
              asm volatile("s_waitcnt vmcnt(0)" ::: "memory");
              __syncthreads();
            }
            asm volatile("" ::: "memory");
            { unsigned char* ws = TABWS();
              pg8::Gemm g{(const bf16_t*)(ws + WS_Z) + C_AQ, (const bf16_t*)(ws + W_UQ), ZC, 256}; pg8::StaticOrder so; so.init(T, 512, GRIDX, BIDX);
              pg8::EpiStore<0> E{(bf16_t*)(ws + WS_QM), 384, 384, (const float*)(ws + WS_RSTD), 2, 0.10206207261596575f * LOG2E};
              pg8::gemm_phase(lds, g, so, E, wave_s); }
            asm volatile("" ::: "memory");
            { unsigned char* ws = TABWS();
              pg8::Gemm g{(const bf16_t*)(ws + WS_Z) + C_AKV, (const bf16_t*)(ws + W_UKV), ZC, 256}; pg8::StaticOrder so; so.init(T, 512, GRIDX, BIDX);
              pg8::EpiStore<0> E{(bf16_t*)(ws + WS_KVM), 512, 512, (const float*)(ws + WS_RSTD) + 1, 2, 1.0f};
              pg8::gemm_phase(lds, g, so, E, wave_s); }
        }
        SEAM(P0 + 1);
        PHASE(P0 + 2) {
            unsigned char* ws = TABWS(); const int G = GRIDX, bid = BIDX;
            bf16_t* ZQ = (bf16_t*)(ws + WS_Z);
            AttnP AP{ZQ, (const bf16_t*)(ws + WS_QM), (const bf16_t*)(ws + WS_KVM), (const bf16_t*)(ws + WS_KR), (bf16_t*)(ws + WS_Y), ZQ, (float*)(ws + WS_LSE),
                     (const float*)(ws + WS_LUTS), (const float*)(ws + WS_LUTD), TABF(11) + (size_t)l * 4 * 465, TABF(10) + l * 4, (const float*)(ws + WS_ROPE)};
            const int xq = bid & 7, jq = bid >> 3, Gq = (G + 7 - xq) >> 3;
            for (int j = jq; j < 32; j += Gq) attn_unit<0>(lds, AP, xq * 32 + j, wave_s);
            for (int j = jq; j < 64; j += Gq) attn_unit<1>(lds, AP, xq * 64 + j, wave_s);
            for (int j = jq; j < 64; j += Gq) attn_unit<2>(lds, AP, xq * 64 + j, wave_s);
            for (int j = jq; j < 192; j += Gq) attn_unit<3>(lds, AP, xq * 192 + j, wave_s);
        }
        SEAM(P0 + 2);
        PHASE(P0 + 3) {
            TIDS
            unsigned char* ws = TABWS();
            const bf16_t* ZQ = (const bf16_t*)(ws + WS_Z); const float* LSE = (const float*)(ws + WS_LSE); bf16_t* Y = (bf16_t*)(ws + WS_Y);
            for (int i = gt; i < T * 32; i += NGT) {
                const int m = i >> 5, hh = (i >> 3) & 3, ch = i & 7;
                const float l0 = LSE[(size_t)m * 12 + hh], l1 = LSE[(size_t)m * 12 + 4 + hh], l2 = LSE[(size_t)m * 12 + 8 + hh];
                const float mx = fmaxf(l0, fmaxf(l1, l2));
                float w0 = __builtin_amdgcn_exp2f(l0 - mx), w1 = __builtin_amdgcn_exp2f(l1 - mx), w2 = __builtin_amdgcn_exp2f(l2 - mx);
                const float inv = 1.0f / (w0 + w1 + w2); w0 *= inv; w1 *= inv; w2 *= inv;
                const bf16_t* zp = ZQ + (size_t)m * ZC + C_DQ + hh * 64 + ch * 8;
                const u32x4 a0 = *(const u32x4*)zp, a1 = *(const u32x4*)(zp + 256), a2 = *(const u32x4*)(zp + 512);
                u32x4 o;
                o.x = cvt_pk(w0 * bf_lo(a0.x) + w1 * bf_lo(a1.x) + w2 * bf_lo(a2.x), w0 * bf_hi(a0.x) + w1 * bf_hi(a1.x) + w2 * bf_hi(a2.x));
                o.y = cvt_pk(w0 * bf_lo(a0.y) + w1 * bf_lo(a1.y) + w2 * bf_lo(a2.y), w0 * bf_hi(a0.y) + w1 * bf_hi(a1.y) + w2 * bf_hi(a2.y));
                o.z = cvt_pk(w0 * bf_lo(a0.z) + w1 * bf_lo(a1.z) + w2 * bf_lo(a2.z), w0 * bf_hi(a0.z) + w1 * bf_hi(a1.z) + w2 * bf_hi(a2.z));
                o.w = cvt_pk(w0 * bf_lo(a0.w) + w1 * bf_lo(a1.w) + w2 * bf_lo(a2.w), w0 * bf_hi(a0.w) + w1 * bf_hi(a1.w) + w2 * bf_hi(a2.w));
                *(u32x4*)(Y + (size_t)m * DM + 768 + hh * 64 + ch * 8) = o;
            }
        }
        SEAM(P0 + 3);
        PHASE(P0 + 4) {
            unsigned char* ws = TABWS();
            pg8::Gemm g{(const bf16_t*)(ws + WS_HB), (const bf16_t*)(ws + W_G), DM, DM}; pg8::StaticOrder so; so.init(T, ZC, GRIDX, BIDX);
            pg8::EpiStore<1> E{(bf16_t*)(ws + WS_Z), ZC, ZC, nullptr, 0, 1.0f};
            pg8::gemm_phase(lds, g, so, E, wave_s);
        }
        SEAM(P0 + 4);
        PHASE(P0 + 5) {
            unsigned char* ws = TABWS();
            pg8::Gemm g{(const bf16_t*)(ws + WS_Y), (const bf16_t*)(ws + W_B), DM, 256}; pg8::MergeOrder mo; mo.s.init(T, DM, GRIDX, BIDX);
            pg8::EpiMerge E{(bf16_t*)(ws + WS_MG), (const bf16_t*)(ws + WS_Z)};
            pg8::gemm_phase(lds, g, mo, E, wave_s);
        }
        SEAM(P0 + 5);
        PHASE(P0 + 6) {
            unsigned char* ws = TABWS();
            pg8::Gemm g{(const bf16_t*)(ws + WS_MG), (const bf16_t*)(ws + W_OUT), DM, DM}; pg8::StaticOrder so; so.init(T, DM, GRIDX, BIDX);
            float* Hout = TABOUT();
            pg8::EpiResid<false> E{l == 0 ? TABF(0) : (const float*)Hout, Hout, nullptr, (const float*)(ws + WS_STATS), l == 0 ? TABF(2) : TABF(20) + (l - 1) * DM, l == 0 ? TABF(3) : TABF(21) + (l - 1) * DM};
            pg8::gemm_phase(lds, g, so, E, wave_s);
        }
        SEAM(P0 + 6);
        PHASE(P0 + 7) {
            TIDS
            unsigned char* ws = TABWS(); float* H = TABOUT(); bf16_t* HB = (bf16_t*)(ws + WS_HB); const float* gg = TABF(14) + l * DM; const float* bb = TABF(15) + l * DM;
            float* ST = (float*)(ws + WS_STATS);
            for (int m = gw * 8; m < T; m += NGW * 8) ln_rows<8>(H + (size_t)m * DM, nullptr, HB + (size_t)m * DM, ST + (size_t)m * 2, gg, bb, lane);
        }
        SEAM(P0 + 7);
        PHASE(P0 + 8) {
            { unsigned char* ws = TABWS();
              pg8::Gemm g{(const bf16_t*)(ws + WS_HB), (const bf16_t*)(ws + W_FF1), DM, DM}; pg8::StaticOrder so; so.init(T, FF, GRIDX, BIDX);
              pg8::EpiStore<2> E{(bf16_t*)(ws + WS_Z), FF, FF, nullptr, 0, 1.0f};
              pg8::gemm_phase(lds, g, so, E, wave_s); }
            asm volatile("" ::: "memory");
            { unsigned char* ws = TABWS();
              pg8::Gemm g{(const bf16_t*)(ws + WS_HB), (const bf16_t*)(ws + W_PG), DM, DM}; pg8::StaticOrder so; so.init(T, DM, GRIDX, BIDX);
              pg8::EpiStore<1> E{(bf16_t*)(ws + WS_Y), DM, DM, nullptr, 0, 1.0f};
              pg8::gemm_phase(lds, g, so, E, wave_s); }
            asm volatile("" ::: "memory");
            { unsigned char* ws = TABWS();
              pg8::Gemm g{(const bf16_t*)(ws + WS_PB), (const bf16_t*)(ws + W_PLE), 256, 256}; pg8::StaticOrder so; so.init(T, DM, GRIDX, BIDX);
              pg8::EpiMulInto E{(bf16_t*)(ws + WS_Y)};
              pg8::gemm_phase(lds, g, so, E, wave_s); }
        }
        SEAM(P0 + 8);
        PHASE(P0 + 9) {
            unsigned char* ws = TABWS();
            pg8::Gemm g{(const bf16_t*)(ws + WS_Z), (const bf16_t*)(ws + W_FF2), FF, FF}; pg8::StaticOrder so; so.init(T, DM, GRIDX, BIDX);
            float* Hout = TABOUT();
            pg8::EpiResid<true> E{(const float*)Hout, Hout, (const bf16_t*)(ws + WS_Y), (const float*)(ws + WS_STATS), TABF(14) + l * DM, TABF(15) + l * DM};
            pg8::gemm_phase(lds, g, so, E, wave_s);
        }
        SEAM(P0 + 9);
        PHASE(P0 + 10) {
            TIDS
            unsigned char* ws = TABWS(); float* H = TABOUT(); bf16_t* HB = (bf16_t*)(ws + WS_HB); const float* gg = TABF(20) + l * DM; const float* bb = TABF(21) + l * DM;
            float* ST = (float*)(ws + WS_STATS);
            if (l + 1 < NL) { for (int m = gw * 8; m < T; m += NGW * 8) ln_rows<8>(H + (size_t)m * DM, nullptr, HB + (size_t)m * DM, ST + (size_t)m * 2, gg, bb, lane); }
            else { for (int m = gw * 8; m < T; m += NGW * 8) ln_rows<8>(H + (size_t)m * DM, H + (size_t)m * DM, nullptr, nullptr, gg, bb, lane); }
            if (l + 1 < NL) conv_layer(TAB, lds, l + 1, gw, NGW, gt, NGT, wave, lane);
        }
        if (l + 1 < NL) SEAM(P0 + 10);
    }
}

extern "C" void kernel_launch(void* const* d_in, const int* in_sizes, int n_in, void* d_out, int out_size, void* d_ws, size_t ws_size, hipStream_t stream) {
    static int grid = 0;
    if (grid == 0) {
        if (n_in != 22 || out_size != T * DM || ws_size < WS_END) { fprintf(stderr, "kernel_launch: unexpected shapes (n_in %d out %d ws %zu)\n", n_in, out_size, ws_size); grid = -1; return; }
        int dev = 0, cus = 0, per = 0;
        (void)hipGetDevice(&dev); (void)hipDeviceGetAttribute(&cus, hipDeviceAttributeMultiprocessorCount, dev);
        (void)hipFuncSetAttribute((const void*)fwd_kernel, hipFuncAttributeMaxDynamicSharedMemorySize, LDS_BYTES);
        (void)hipOccupancyMaxActiveBlocksPerMultiprocessor(&per, (const void*)fwd_kernel, 512, LDS_BYTES);
        if (per < 1) per = 1;
        grid = cus * per;
        fprintf(stderr, "kernel_launch: grid %d (cus %d x %d)\n", grid, cus, per);
    }
    if (grid < 0) return;
    Args a{};
    for (int i = 0; i < 22; ++i) a.in[i] = (const float*)d_in[i];
    a.out = (float*)d_out; a.ws = (unsigned char*)d_ws;
#if N_LAUNCH_MODE == 1
    a.ph_lo = 0; a.ph_hi = N_PHASES;
    void* args[] = {&a};
    hipError_t e = hipLaunchCooperativeKernel((void*)fwd_kernel, dim3(grid), dim3(512), args, LDS_BYTES, stream);
    if (e != hipSuccess) fprintf(stderr, "cooperative launch failed: %s (grid %d)\n", hipGetErrorString(e), grid);
#else
    for (int k = 0; k < N_PHASES; ++k) { a.ph_lo = k; a.ph_hi = k + 1; hipLaunchKernelGGL(fwd_kernel, dim3(grid), dim3(512), LDS_BYTES, stream, a); }
#endif
}
```
